# Optimizing an MI355X kernel written in HIP

```python
import jax, jax.numpy as jnp
from jax import lax
import numpy as np

D_MODEL = 2048
BATCH = 1
SEQ = 8192
DEPTH = 1

N_META = 16
MIX = D_MODEL
RET_WIDTH = MIX // 2
RET_HEADS = 4
RET_HEAD_DIM = RET_WIDTH // RET_HEADS
CONV_WIDTH = MIX - RET_WIDTH
CONV_GROUPS = 4
CONV_K = 31
CHUNK = 128
ROPE_BASE = 10000.0
EPS = 1e-6
IN_SPLITS = (RET_WIDTH, RET_WIDTH, RET_WIDTH, RET_WIDTH, CONV_WIDTH, CONV_WIDTH, CONV_WIDTH)
IN_WIDTH = sum(IN_SPLITS)

kernel_name = "hybrid_retention_conformer_block"


def rms_norm(x, g):
    xf = x.astype(jnp.float32)
    y = xf * lax.rsqrt(jnp.mean(xf * xf, axis=-1, keepdims=True) + EPS)
    return (y * g.astype(jnp.float32)).astype(x.dtype)


def rotary(x, pos):
    half = x.shape[-1] // 2
    inv_freq = ROPE_BASE ** (-jnp.arange(half, dtype=jnp.float32) / half)
    ang = pos[:, None] * inv_freq[None, :]
    cos = jnp.cos(ang)[None, :, None, :]
    sin = jnp.sin(ang)[None, :, None, :]
    x1, x2 = x[..., :half], x[..., half:]
    return jnp.concatenate([x1 * cos - x2 * sin, x1 * sin + x2 * cos], axis=-1)


def chunkwise_retention(q, k, v):
    b, l, h, d = q.shape
    n = l // CHUNK
    to_chunks = lambda t: t.reshape(b, n, CHUNK, h, t.shape[-1]).transpose(1, 0, 3, 2, 4)
    qc, kc, vc = to_chunks(q), to_chunks(k), to_chunks(v)
    gamma = 1.0 - jnp.exp2(-5.0 - jnp.arange(h, dtype=jnp.float32))
    log_g = jnp.log(gamma)
    idx = jnp.arange(CHUNK, dtype=jnp.float32)
    rel = idx[:, None] - idx[None, :]
    decay_mask = jnp.where(rel[None] >= 0,
                           jnp.exp(jnp.maximum(rel, 0.0)[None] * log_g[:, None, None]),
                           0.0)
    q_decay = jnp.exp((idx[None, :] + 1.0) * log_g[:, None])
    k_decay = jnp.exp((CHUNK - 1.0 - idx[None, :]) * log_g[:, None])
    chunk_decay = jnp.exp(CHUNK * log_g)

    def step(state, inp):
        qi, ki, vi = inp
        scores = jnp.einsum('bhqd,bhkd->bhqk', qi, ki) * decay_mask[None]
        inner = jnp.einsum('bhqk,bhkv->bhqv', scores, vi)
        cross = jnp.einsum('bhqd,bhdv->bhqv', qi * q_decay[None, :, :, None], state)
        new_state = state * chunk_decay[None, :, None, None] + jnp.einsum(
            'bhkd,bhkv->bhdv', ki * k_decay[None, :, :, None], vi)
        return new_state, inner + cross

    state0 = jnp.zeros((b, h, d, v.shape[-1]), jnp.float32)
    _, out = lax.scan(step, state0, (qc, kc, vc))
    return out.transpose(1, 0, 3, 2, 4).reshape(b, l, h, v.shape[-1])


def retention_group(q_in, k_in, v_in, g_in, gn_g):
    b, l, _ = q_in.shape
    pos = jnp.arange(l, dtype=jnp.float32)
    shp = (b, l, RET_HEADS, RET_HEAD_DIM)
    q = rotary(q_in.astype(jnp.float32).reshape(shp), pos)
    k = rotary(k_in.astype(jnp.float32).reshape(shp), pos) * (RET_HEAD_DIM ** -0.5)
    v = v_in.astype(jnp.float32).reshape(shp)
    lead = (-N_META) % CHUNK
    padw = ((0, 0), (lead, 0), (0, 0), (0, 0))
    y = chunkwise_retention(jnp.pad(q, padw), jnp.pad(k, padw), jnp.pad(v, padw))[:, lead:]
    mu = jnp.mean(y, axis=-1, keepdims=True)
    var = jnp.mean(jnp.square(y - mu), axis=-1, keepdims=True)
    y = ((y - mu) * lax.rsqrt(var + EPS)).reshape(b, l, RET_WIDTH) * gn_g.astype(jnp.float32)
    return (y * jax.nn.silu(g_in.astype(jnp.float32))).astype(q_in.dtype)


def conformer_conv_group(a_in, b_in, g_in, dw_w, dw_b, ln_g, ln_b, pw_w, pw_b):
    u = a_in * jax.nn.sigmoid(b_in)
    u = lax.conv_general_dilated(u, dw_w[:, None, :].astype(u.dtype), window_strides=(1,),
                                 padding=[(CONV_K - 1, 0)],
                                 dimension_numbers=('NWC', 'WIO', 'NWC'),
                                 feature_group_count=CONV_WIDTH) + dw_b
    uf = u.astype(jnp.float32)
    mu = jnp.mean(uf, axis=-1, keepdims=True)
    var = jnp.mean(jnp.square(uf - mu), axis=-1, keepdims=True)
    uf = (uf - mu) * lax.rsqrt(var + EPS) * ln_g.astype(jnp.float32) + ln_b.astype(jnp.float32)
    u = jax.nn.silu(uf).astype(a_in.dtype)
    u = jnp.einsum('blc,cd->bld', u, pw_w) + pw_b
    return u * jax.nn.silu(g_in)


def setup_inputs(seed: int = 0) -> dict:
    key = jax.random.key(seed)
    ks = jax.random.split(key, 14)
    f32 = jnp.float32
    nrm = lambda k, s, sc: jax.random.normal(k, s, f32) * sc
    return {
        "x": nrm(ks[0], (BATCH, SEQ, D_MODEL), 1.0),
        "meta_tokens": nrm(ks[1], (N_META, D_MODEL), 1.0),
        "ln_g": 1.0 + nrm(ks[2], (DEPTH, D_MODEL), 0.02),
        "w_in": nrm(ks[3], (DEPTH, D_MODEL, IN_WIDTH), D_MODEL ** -0.5),
        "ret_gn_g": 1.0 + nrm(ks[4], (DEPTH, RET_WIDTH), 0.02),
        "conv_dw_w": nrm(ks[5], (DEPTH, CONV_K, CONV_WIDTH), CONV_K ** -0.5),
        "conv_dw_b": nrm(ks[6], (DEPTH, CONV_WIDTH), 0.01),
        "conv_ln_g": 1.0 + nrm(ks[7], (DEPTH, CONV_WIDTH), 0.02),
        "conv_ln_b": nrm(ks[8], (DEPTH, CONV_WIDTH), 0.01),
        "conv_pw_w": nrm(ks[9], (DEPTH, CONV_WIDTH, CONV_WIDTH), CONV_WIDTH ** -0.5),
        "conv_pw_b": nrm(ks[10], (DEPTH, CONV_WIDTH), 0.01),
        "w_out": nrm(ks[11], (DEPTH, MIX, D_MODEL), MIX ** -0.5),
        "final_g": 1.0 + nrm(ks[12], (D_MODEL,), 0.02),
    }


def reference(x, meta_tokens, ln_g, w_in, ret_gn_g, conv_dw_w, conv_dw_b, conv_ln_g,
              conv_ln_b, conv_pw_w, conv_pw_b, w_out, final_g):
    b = x.shape[0]
    meta = jnp.broadcast_to(meta_tokens[None].astype(x.dtype), (b, N_META, D_MODEL))
    h = jnp.concatenate([meta, x], axis=1)
    offs = np.cumsum(IN_SPLITS)[:-1].tolist()
    for l in range(DEPTH):
        hn = rms_norm(h, ln_g[l])
        proj = jnp.einsum('bld,de->ble', hn, w_in[l])
        q_in, k_in, v_in, gr_in, a_in, b_in, gc_in = jnp.split(proj, offs, axis=-1)
        y_ret = retention_group(q_in, k_in, v_in, gr_in, ret_gn_g[l])
        y_conv = conformer_conv_group(a_in, b_in, gc_in, conv_dw_w[l], conv_dw_b[l],
                                      conv_ln_g[l], conv_ln_b[l], conv_pw_w[l], conv_pw_b[l])
        y = jnp.concatenate([y_ret, y_conv], axis=-1)
        h = h + jnp.einsum('ble,ed->bld', y, w_out[l])
    h = rms_norm(h, final_g)
    return h[:, N_META:]
```

```cpp
#include <hip/hip_runtime.h>
#include <cstdio>
#include <cstdint>
namespace pg8 {
#define PG8_LAS __attribute__((address_space(3)))
typedef unsigned short bf16_t;
typedef short bf16x8 __attribute__((ext_vector_type(8)));
typedef float f32x4 __attribute__((ext_vector_type(4)));
typedef unsigned u32x4 __attribute__((ext_vector_type(4)));
constexpr int BM = 256, BK = 64, HALF = 128, HTB = HALF * BK * 2  , STAGE_BYTES = 8 * HTB, NXCD = 8, WGM = 8;

__host__ __device__ __forceinline__ int lds_byte(int r, int c) { const int st = (r >> 4) * 2 + (c >> 5), rr = r & 15, cc = c & 31, ob = rr * 64 + cc * 2; return st * 1024 + (ob ^ (((ob >> 9) & 1) << 5)); }
__host__ __device__ __forceinline__ void stage_rc(int b, int& R, int& C) { const int st = b / 1024, sb = b % 1024, swz = sb ^ (((sb >> 9) & 1) << 5); R = (st >> 1) * 16 + swz / 64; C = (st & 1) * 32 + (swz % 64) / 2; }
__host__ __device__ __forceinline__ int perm32(int rho) { const int n = rho >> 4, i = rho & 15; return 8 * (i >> 2) + 4 * n + (i & 3); }

struct Unit { int pm, pn; };
struct Gemm { const bf16_t* A; const bf16_t* Bt; int M, N, K; };

__device__ __forceinline__ unsigned cvt_pk_bf16(float lo, float hi) { unsigned r; asm volatile("v_cvt_pk_bf16_f32 %0, %1, %2" : "=v"(r) : "v"(lo), "v"(hi)); return r; }
typedef float f32x2 __attribute__((ext_vector_type(2)));
template <class Epi, class Sched, bool ALIGN_EPI = false, bool SP2 = false>
__device__ __forceinline__ void gemm_phase(PG8_LAS unsigned char* lds, const Gemm g, const Sched& S, const Epi& E) {
    int tid = threadIdx.x; asm volatile("" : "+v"(tid));
    const int wid = __builtin_amdgcn_readfirstlane(tid >> 6), lane = tid & 63, wr = wid >> 2, wc = wid & 3, fr = lane & 15, fq = lane >> 4;
    const int K = g.K, nt = K / BK;
    unsigned voffA[2], voffB[2];
#pragma unroll
    for (int i = 0; i < 2; ++i) { int R, C; stage_rc(tid * 16 + i * 8192, R, C); const int Rb = Epi::PERM ? ((R & ~31) + perm32(R & 31)) : R;
        voffA[i] = (unsigned)(R * K + C) * 2u; voffB[i] = (unsigned)(Rb * K + C) * 2u; }
    const size_t kstep = (size_t)(BK * 2);
    const size_t hstep = (size_t)HALF * K * 2;
    const size_t tstep = 2 * hstep;
    const unsigned ldsw = (unsigned)wid * 1024u;
    const int aoff = lds_byte(wr * 64 + fr, fq * 8), boff = lds_byte(wc * 32 + fr, fq * 8);
#define PG8_SA(b, h) (((b) * 2 + (h)) * HTB)
#define PG8_SB(b, h) ((4 + (b) * 2 + (h)) * HTB)
#define PG8_STAGE(bufoff, gbase, voff) do { _Pragma("unroll") for (int _i = 0; _i < 2; ++_i) \
        __builtin_amdgcn_global_load_lds((const unsigned*)((const char*)(gbase) + (voff)[_i]), (PG8_LAS unsigned*)(lds + (bufoff) + ldsw + _i * 8192), 16, 0, 0); } while (0)
#define PG8_LDA(dst, b, h) do { _Pragma("unroll") for (int m = 0; m < 4; ++m) _Pragma("unroll") for (int k = 0; k < 2; ++k) dst[m][k] = *(const PG8_LAS bf16x8*)(lds + PG8_SA(b, h) + aoff + m * 2048 + k * 1024); } while (0)
#define PG8_LDB(dst, b, h) do { _Pragma("unroll") for (int n = 0; n < 2; ++n) _Pragma("unroll") for (int k = 0; k < 2; ++k) dst[n][k] = *(const PG8_LAS bf16x8*)(lds + PG8_SB(b, h) + boff + n * 2048 + k * 1024); } while (0)
#define PG8_MMA(ai, bj, At, Bt) do { __builtin_amdgcn_s_setprio(1); _Pragma("unroll") for (int m = 0; m < 4; ++m) _Pragma("unroll") for (int n = 0; n < 2; ++n) _Pragma("unroll") for (int k = 0; k < 2; ++k) \
        acc[ai][bj][m][n] = __builtin_amdgcn_mfma_f32_16x16x32_bf16(Bt[n][k], At[m][k], acc[ai][bj][m][n], 0, 0, 0); __builtin_amdgcn_s_setprio(0); } while (0)
#define PG8_WAIT_V(n) asm volatile("s_waitcnt vmcnt(" #n ")" ::: "memory")
#define PG8_WAIT_L(n) asm volatile("s_waitcnt lgkmcnt(" #n ")" ::: "memory")
#define PG8_BAR __builtin_amdgcn_s_barrier()
#define PG8_SCHED __builtin_amdgcn_sched_barrier(0)
    Unit cur, nxt; int ui = 0;
    if (!S.next(0, cur)) return;
    f32x4 acc[2][2][4][2];
    if constexpr (Epi::INIT) E.init(acc, cur, wr, wc, fr, fq);
    else {
#pragma unroll
    for (int a = 0; a < 2; ++a)
#pragma unroll
        for (int b = 0; b < 2; ++b)
#pragma unroll
            for (int m = 0; m < 4; ++m)
#pragma unroll
                for (int n = 0; n < 2; ++n) acc[a][b][m][n] = (f32x4){0.f, 0.f, 0.f, 0.f};
    }
    bf16x8 At[4][2], B0[2][2], B1[2][2];
    const char* cA = (const char*)g.A + (size_t)cur.pm * tstep; const char* cB = (const char*)g.Bt + (size_t)cur.pn * tstep;
    S.a_ready(cur);
    if constexpr (SP2) {
        PG8_STAGE(PG8_SB(0, 0), cB, voffB); PG8_STAGE(PG8_SB(0, 1), cB + hstep, voffB); PG8_STAGE(PG8_SA(0, 0), cA, voffA); PG8_STAGE(PG8_SA(0, 1), cA + hstep, voffA);
        if (wr == 1) PG8_BAR;
        PG8_WAIT_V(2); PG8_BAR;
        PG8_STAGE(PG8_SB(1, 0), cB + kstep, voffB); PG8_STAGE(PG8_SA(1, 0), cA + kstep, voffA); PG8_STAGE(PG8_SB(1, 1), cB + hstep + kstep, voffB);
        PG8_WAIT_V(6); PG8_BAR;
    } else {
        PG8_STAGE(PG8_SB(0, 0), cB, voffB); PG8_STAGE(PG8_SA(0, 0), cA, voffA); PG8_STAGE(PG8_SB(0, 1), cB + hstep, voffB); PG8_STAGE(PG8_SA(0, 1), cA + hstep, voffA);
        if (wr == 1) PG8_BAR;
        PG8_WAIT_V(4); PG8_BAR;
        PG8_STAGE(PG8_SB(1, 0), cB + kstep, voffB); PG8_STAGE(PG8_SA(1, 0), cA + kstep, voffA); PG8_STAGE(PG8_SB(1, 1), cB + hstep + kstep, voffB);
        PG8_WAIT_V(6); PG8_BAR;
    }
    for (;;) {
        const bool has_next = S.next(ui + 1, nxt);
        const char* nA = has_next ? (const char*)g.A + (size_t)nxt.pm * tstep : cA; const char* nB = has_next ? (const char*)g.Bt + (size_t)nxt.pn * tstep : cB;
        for (int t = 0; t < nt; t += 2) {
            const bool last = (t == nt - 2);
            const char* a1 = cA + (size_t)(t + 1) * kstep;
            const char* a2 = last ? nA : cA + (size_t)(t + 2) * kstep; const char* b2 = last ? nB : cB + (size_t)(t + 2) * kstep;
            const char* a3 = a2 + kstep; const char* b3 = b2 + kstep;
            if (last && has_next) S.a_ready(nxt);
            if constexpr (SP2) {
            PG8_LDB(B0, 0, 0); PG8_LDB(B1, 0, 1); PG8_SCHED; PG8_LDA(At, 0, 0); PG8_STAGE(PG8_SA(1, 1), a1 + hstep, voffA);
            PG8_WAIT_V(8); PG8_WAIT_L(0); PG8_BAR; PG8_MMA(0, 0, At, B0); PG8_MMA(0, 1, At, B1); PG8_BAR; PG8_SCHED;
            PG8_LDA(At, 0, 1); PG8_STAGE(PG8_SB(0, 0), b2, voffB); PG8_STAGE(PG8_SB(0, 1), b2 + hstep, voffB); PG8_STAGE(PG8_SA(0, 0), a2, voffA);
            PG8_WAIT_V(8); PG8_WAIT_L(0); PG8_BAR; PG8_MMA(1, 0, At, B0); PG8_MMA(1, 1, At, B1); PG8_BAR; PG8_SCHED;
            PG8_LDB(B0, 1, 0); PG8_LDB(B1, 1, 1); PG8_SCHED; PG8_LDA(At, 1, 0); PG8_STAGE(PG8_SA(0, 1), a2 + hstep, voffA);
            PG8_WAIT_V(8); PG8_WAIT_L(0); PG8_BAR; PG8_MMA(0, 0, At, B0); PG8_MMA(0, 1, At, B1); PG8_BAR; PG8_SCHED;
            PG8_LDA(At, 1, 1); PG8_STAGE(PG8_SB(1, 0), b3, voffB); PG8_STAGE(PG8_SB(1, 1), b3 + hstep, voffB); PG8_STAGE(PG8_SA(1, 0), a3, voffA);
            PG8_WAIT_V(8); PG8_WAIT_L(0); PG8_BAR; PG8_MMA(1, 0, At, B0); PG8_MMA(1, 1, At, B1); PG8_BAR; PG8_SCHED;
            } else {
            PG8_LDB(B0, 0, 0); PG8_SCHED; PG8_LDA(At, 0, 0); PG8_STAGE(PG8_SA(1, 1), a1 + hstep, voffA);
            PG8_WAIT_L(8); PG8_BAR; PG8_WAIT_L(0); PG8_MMA(0, 0, At, B0); PG8_BAR; PG8_SCHED;
            PG8_LDB(B1, 0, 1); PG8_STAGE(PG8_SB(0, 0), b2, voffB);
            PG8_BAR; PG8_WAIT_L(0); PG8_MMA(0, 1, At, B1); PG8_BAR;
            PG8_LDA(At, 0, 1); PG8_STAGE(PG8_SA(0, 0), a2, voffA);
            PG8_BAR; PG8_WAIT_L(0); PG8_MMA(1, 0, At, B0); PG8_BAR; PG8_SCHED;
            PG8_STAGE(PG8_SB(0, 1), b2 + hstep, voffB);
            PG8_WAIT_V(6); PG8_BAR; PG8_MMA(1, 1, At, B1); PG8_BAR;
            PG8_LDB(B0, 1, 0); PG8_SCHED; PG8_LDA(At, 1, 0); PG8_STAGE(PG8_SA(0, 1), a2 + hstep, voffA);
            PG8_WAIT_L(8); PG8_BAR; PG8_WAIT_L(0); PG8_MMA(0, 0, At, B0); PG8_BAR; PG8_SCHED;
            PG8_LDB(B1, 1, 1); PG8_STAGE(PG8_SB(1, 0), b3, voffB);
            PG8_BAR; PG8_WAIT_L(0); PG8_MMA(0, 1, At, B1); PG8_BAR;
            PG8_LDA(At, 1, 1); PG8_STAGE(PG8_SA(1, 0), a3, voffA);
            PG8_BAR; PG8_WAIT_L(0); PG8_MMA(1, 0, At, B0); PG8_BAR; PG8_SCHED;
            PG8_STAGE(PG8_SB(1, 1), b3 + hstep, voffB);
            PG8_WAIT_V(6); PG8_BAR; PG8_MMA(1, 1, At, B1); PG8_BAR;
            }
        }
        if constexpr (ALIGN_EPI) { if (wr == 0) PG8_BAR; }
        if constexpr (!Epi::AFTER_DRAIN) { E(acc, cur, wr, wc, fr, fq); S.done(cur); }
        if (!has_next) break;
#pragma unroll
        for (int a = 0; a < 2; ++a)
#pragma unroll
            for (int b = 0; b < 2; ++b)
#pragma unroll
                for (int m = 0; m < 4; ++m)
#pragma unroll
                    for (int n = 0; n < 2; ++n) acc[a][b][m][n] = (f32x4){0.f, 0.f, 0.f, 0.f};
        cur = nxt; cA = nA; cB = nB; ++ui;
        if constexpr (ALIGN_EPI) { if (wr == 1) PG8_BAR; }
    }
    PG8_WAIT_V(0);
    if constexpr (!ALIGN_EPI) { if (wr == 0) PG8_BAR; }
    PG8_BAR;
    if constexpr (Epi::AFTER_DRAIN) { E.fused(acc, cur, wr, wc, fr, fq, lds, wid, lane); S.done(cur); }
#undef PG8_SA
#undef PG8_SB
#undef PG8_STAGE
#undef PG8_LDA
#undef PG8_LDB
#undef PG8_MMA
#undef PG8_WAIT_V
#undef PG8_WAIT_L
#undef PG8_BAR
#undef PG8_SCHED
}
}

namespace mk {
using pg8::bf16_t; using pg8::bf16x8; using pg8::f32x4; using pg8::u32x4; using pg8::Unit;
#define LAS __attribute__((address_space(3)))
typedef float f32x16 __attribute__((ext_vector_type(16)));
typedef float f32x2 __attribute__((ext_vector_type(2)));
typedef float f32x2_ __attribute__((ext_vector_type(2)));
typedef short s16x4 __attribute__((ext_vector_type(4)));
typedef unsigned u32x2 __attribute__((ext_vector_type(2)));
typedef __bf16 bf16x2_t __attribute__((ext_vector_type(2)));
__device__ __forceinline__ unsigned cvt_pk_bf16(float lo, float hi) { const f32x2_ v = {lo, hi}; return __builtin_bit_cast(unsigned, __builtin_convertvector(v, bf16x2_t)); }

constexpr int DM = 2048, SEQ = 8192, NMETA = 16, LTOK = SEQ + NMETA, MPAD = 8448;
constexpr int RW = 1024, RH = 4, RD = 256, CW = 1024, CK = 31, INW = 7168;
constexpr float EPS = 1e-6f;
constexpr int NTHREADS = 512, GRID = 256;
constexpr size_t MiB = 1u << 20;
constexpr size_t WS_CTL = 0, CTL_ZERO_BYTES = 1 * MiB;
constexpr size_t WS_RSTD = 1 * MiB;
constexpr size_t WS_PSUM = 1 * MiB + 64 * 1024;
constexpr size_t WS_WOUT = 2 * MiB;
constexpr size_t WS_WPW = 10 * MiB;
constexpr size_t WS_WIN = 12 * MiB;
constexpr size_t WS_HB = 40 * MiB;
constexpr size_t WS_COS = 73 * MiB;
constexpr size_t WS_SIN = 77 * MiB + 256 * 1024;
constexpr size_t WS_QT = 82 * MiB;
constexpr size_t WS_KT = 98 * MiB;
constexpr size_t WS_V = 115 * MiB;
constexpr size_t WS_U = 132 * MiB;
constexpr size_t WS_GY = 149 * MiB;
constexpr size_t WS_CB = 181 * MiB;
constexpr size_t WS_ST = 197 * MiB;
constexpr size_t WS_END = 229 * MiB;
static_assert(WS_COS + (size_t)LTOK * 128 * 4 <= WS_SIN && WS_SIN + (size_t)LTOK * 128 * 4 <= WS_QT && WS_HB + (size_t)MPAD * DM * 2 <= WS_COS, "ws map");
__device__ __forceinline__ bf16_t* kvt_tile(unsigned char* ws, int t) { return (bf16_t*)(ws + WS_ST + (size_t)t * 131072); }
constexpr int CW_BAR = 4096;
constexpr int CW_YR = 14656;
constexpr int CW_PANEL = 12544;
constexpr int CW_CONV = 8448, CW_GC = 10496;
constexpr int CW_MID = 8192, CW_META = 8256, CW_Q = 8320;
constexpr int LDS_MAIN = 147456, MISC_OFF = LDS_MAIN, LDS_BYTES = LDS_MAIN + 1024;

__device__ __constant__ const float kLog2G[4] = {-0.045803689613124755f, -0.022720076500083796f, -0.011315313227834148f, -0.005646563141142062f};

#define LDS_WAIT() asm volatile("s_waitcnt lgkmcnt(0)" ::: "memory")
#define MFMA32(a, b, c) __builtin_amdgcn_mfma_f32_32x32x16_bf16((a), (b), (c), 0, 0, 0)
template <int CTRL> __device__ __forceinline__ float dpp_mov(float x) { return __builtin_bit_cast(float, __builtin_amdgcn_update_dpp(0, __builtin_bit_cast(int, x), CTRL, 0xF, 0xF, true)); }
__device__ __forceinline__ float sum16(float x) { x += dpp_mov<0xB1>(x); x += dpp_mov<0x4E>(x); x += dpp_mov<0x141>(x); x += dpp_mov<0x140>(x); return x; }
__device__ __forceinline__ float sum32(float x) { x = sum16(x); x += __builtin_bit_cast(float, __builtin_amdgcn_ds_swizzle(__builtin_bit_cast(int, x), 0x401F)); return x; }
__device__ __forceinline__ float wave_sum(float v) { v = sum32(v); return v + __shfl_xor(v, 32); }
__device__ __forceinline__ float sigmoid_f(float x) { return __builtin_amdgcn_rcpf(1.0f + __expf(-x)); }
__device__ __forceinline__ float silu_f(float x) { return x * sigmoid_f(x); }
__device__ __forceinline__ float bf_lo(unsigned w) { return __uint_as_float(w << 16); }
__device__ __forceinline__ float bf_hi(unsigned w) { return __uint_as_float(w & 0xffff0000u); }
__device__ __forceinline__ u32x4 pack8(const f32x4 a, const f32x4 b) { u32x4 w; w.x = cvt_pk_bf16(a[0], a[1]); w.y = cvt_pk_bf16(a[2], a[3]); w.z = cvt_pk_bf16(b[0], b[1]); w.w = cvt_pk_bf16(b[2], b[3]); return w; }
__device__ __forceinline__ void st8_sc1(void* p, u32x2 v) { asm volatile("global_store_dwordx2 %0, %1, off sc1\n\ts_nop 1" :: "v"(p), "v"(v) : "memory"); }
__device__ __forceinline__ void st16_sc1(void* p, u32x4 v) { asm volatile("global_store_dwordx4 %0, %1, off sc1\n\ts_nop 1" :: "v"(p), "v"(v) : "memory"); }
__device__ __forceinline__ int crow(int reg, int hh) { return (reg & 3) + 8 * (reg >> 2) + 4 * hh; }
__device__ __forceinline__ s16x4 tr_read(LAS unsigned char* p) { return __builtin_amdgcn_ds_read_tr16_b64_v4i16((LAS s16x4*)p); }

#define XB_TMO      128
#define XB_XCNT(j)  (256  + 64 * (j))
#define XB_XSUB(j)  (1280 + 64 * (j))
#define XB_XGEN(j)  (2304 + 64 * (j))
#define XB_TOP      3328
#define XB_TOPGEN   3392
#define XCD_BAR_WORDS 3456
#define XB_SPIN_CAP (1u << 18)
__device__ __forceinline__ unsigned xb_ld(unsigned* p)              { return __hip_atomic_load(p, __ATOMIC_RELAXED, __HIP_MEMORY_SCOPE_AGENT); }
__device__ __forceinline__ unsigned xb_add(unsigned* p, unsigned v) { return __hip_atomic_fetch_add(p, v, __ATOMIC_RELAXED, __HIP_MEMORY_SCOPE_AGENT); }
__device__ __forceinline__ unsigned xb_xcc_id() { return (unsigned)__builtin_amdgcn_s_getreg((3 << 11) | 20) & 0xFu; }
#define XB_SPIN(cond, bar) do { unsigned _sp = 0; while (cond) { __builtin_amdgcn_s_sleep(1); \
    if ((++_sp & 255u) == 0u) { if (xb_ld(&(bar)[XB_TMO])) break; if (_sp > XB_SPIN_CAP) { atomicAdd(&(bar)[XB_TMO], 1u); break; } } } } while (0)
struct XcdBarrier { unsigned* bar; unsigned x; volatile LAS unsigned* st; };
__device__ __forceinline__ XcdBarrier xcd_barrier_post(unsigned* bar, volatile LAS unsigned* st) {
    XcdBarrier b; b.bar = bar; b.x = xb_xcc_id(); b.st = st;
    if (threadIdx.x == 0) (void)xb_add(&bar[XB_XCNT(b.x)], 1u);
    return b;
}
__device__ __forceinline__ void xcd_barrier_complete(unsigned* bar, unsigned x, unsigned& nloc, unsigned& nx) {
    const unsigned G = gridDim.x * gridDim.y * gridDim.z;
    unsigned sum, cnt, mine, sp = 0u;
    for (;;) {
        sum = 0u; cnt = 0u; mine = 0u;
#pragma unroll
        for (unsigned j = 0; j < 16; ++j) { const unsigned c = xb_ld(&bar[XB_XCNT(j)]); sum += c; cnt += (c > 0u) ? 1u : 0u; mine = (j == x) ? c : mine; }
        if (sum == G) break;
        __builtin_amdgcn_s_sleep(1);
        if ((++sp & 255u) == 0u) { if (xb_ld(&bar[XB_TMO])) break; if (sp > XB_SPIN_CAP) { atomicAdd(&bar[XB_TMO], 1u); break; } }
    }
    nloc = mine > 0u ? mine : 1u; nx = cnt > 0u ? cnt : 1u;
}
__device__ __forceinline__ void xcd_barrier(const XcdBarrier& b) {
    asm volatile("s_waitcnt vmcnt(0)" ::: "memory");
    __syncthreads();
    if (threadIdx.x == 0) {
        unsigned* bar = b.bar;
        __builtin_amdgcn_s_waitcnt(0);
        unsigned nloc = b.st[0], nx = b.st[1];
        if (nloc == 0u) { xcd_barrier_complete(bar, b.x, nloc, nx); b.st[0] = nloc; b.st[1] = nx; }
        const unsigned old = xb_add(&bar[XB_XSUB(b.x)], 1u);
        const unsigned gen = old / nloc;
        if (old + 1u == (gen + 1u) * nloc) {
            __builtin_amdgcn_fence(__ATOMIC_RELEASE, "agent");
            asm volatile("s_waitcnt vmcnt(0)" ::: "memory");
            const unsigned og = xb_add(&bar[XB_TOP], 1u);
            const unsigned tg = og / nx;
            if (og + 1u == (tg + 1u) * nx) xb_add(&bar[XB_TOPGEN], 1u);
            else XB_SPIN(xb_ld(&bar[XB_TOPGEN]) == tg, bar);
            __builtin_amdgcn_fence(__ATOMIC_ACQUIRE, "agent");
            xb_add(&bar[XB_XGEN(b.x)], 1u);
            asm volatile("s_waitcnt vmcnt(0)" ::: "memory");
        } else {
            XB_SPIN(xb_ld(&bar[XB_XGEN(b.x)]) == gen, bar);
            __builtin_amdgcn_fence(__ATOMIC_ACQUIRE, "agent");
            asm volatile("s_waitcnt vmcnt(0)" ::: "memory");
        }
    }
    __syncthreads();
}

__device__ __forceinline__ void xcd_barrier_arrive(const XcdBarrier& b, unsigned& tok, unsigned& tok2) {
    asm volatile("s_waitcnt vmcnt(0)" ::: "memory");
    __syncthreads();
    tok = 0u; tok2 = 0u;
    if (threadIdx.x == 0) {
        unsigned* bar = b.bar;
        __builtin_amdgcn_s_waitcnt(0);
        unsigned nloc = b.st[0], nx = b.st[1];
        if (nloc == 0u) { xcd_barrier_complete(bar, b.x, nloc, nx); b.st[0] = nloc; b.st[1] = nx; }
        const unsigned old = xb_add(&bar[XB_XSUB(b.x)], 1u);
        const unsigned gen = old / nloc;
        tok = gen & 0x3FFFFFFFu;
        if (old + 1u == (gen + 1u) * nloc) {
            __builtin_amdgcn_fence(__ATOMIC_RELEASE, "agent");
            asm volatile("s_waitcnt vmcnt(0)" ::: "memory");
            const unsigned og = xb_add(&bar[XB_TOP], 1u);
            const unsigned tg = og / nx;
            tok |= 1u << 30; tok2 = tg;
            if (og + 1u == (tg + 1u) * nx) { xb_add(&bar[XB_TOPGEN], 1u); tok |= 1u << 31; }
        }
    }
}
__device__ __forceinline__ void xcd_barrier_wait_t0(const XcdBarrier& b, unsigned tok, unsigned tok2) {
    unsigned* bar = b.bar;
    const unsigned gen = tok & 0x3FFFFFFFu;
    if (tok & (1u << 30)) {
        if (!(tok & (1u << 31))) XB_SPIN(xb_ld(&bar[XB_TOPGEN]) == tok2, bar);
        __builtin_amdgcn_fence(__ATOMIC_ACQUIRE, "agent");
        xb_add(&bar[XB_XGEN(b.x)], 1u);
        asm volatile("s_waitcnt vmcnt(0)" ::: "memory");
    } else {
        XB_SPIN(xb_ld(&bar[XB_XGEN(b.x)]) == gen, bar);
        __builtin_amdgcn_fence(__ATOMIC_ACQUIRE, "agent");
        asm volatile("s_waitcnt vmcnt(0)" ::: "memory");
    }
}

__host__ __device__ __forceinline__ int win_src_col(int nd) {
    if (nd < 4096 || nd >= 6144) return nd;
    const int t = (nd - 4096) >> 8, jj = (nd - 4096) & 255;
    return jj < 128 ? 4096 + 128 * t + jj : 5120 + 128 * t + (jj - 128);
}
__device__ __forceinline__ void p0_transpose_item(const float* __restrict__ W, int K, int N, bf16_t* __restrict__ WT, LAS float* scr, int kb, int n_src0, int n_dst0, int lane) {
    const int k0 = 64 * kb;
    float w[32];
#pragma unroll
    for (int i = 0; i < 32; ++i) w[i] = __builtin_nontemporal_load(W + (size_t)(k0 + 2 * i + (lane >> 5)) * N + n_src0 + (lane & 31));
#pragma unroll
    for (int i = 0; i < 32; ++i) scr[(2 * i + (lane >> 5)) * 33 + (lane & 31)] = w[i];
    LDS_WAIT(); asm volatile("" ::: "memory");
    const int c = lane & 7;
#pragma unroll
    for (int j = 0; j < 4; ++j) { const int n = (lane >> 3) + 8 * j; const LAS float* s = scr + (8 * c) * 33 + n;
        u32x4 o; o.x = cvt_pk_bf16(s[0 * 33], s[1 * 33]); o.y = cvt_pk_bf16(s[2 * 33], s[3 * 33]); o.z = cvt_pk_bf16(s[4 * 33], s[5 * 33]); o.w = cvt_pk_bf16(s[6 * 33], s[7 * 33]);
        st16_sc1(WT + (size_t)(n_dst0 + n) * K + k0 + 8 * c, o); }
    LDS_WAIT(); asm volatile("" ::: "memory");
}
__device__ __forceinline__ void p0_row(const float* __restrict__ src, bf16_t* __restrict__ dst, float* rstd_out, const f32x4 (&g)[8], int lane) {
    f32x4 v[8]; float s = 0.f;
#pragma unroll
    for (int j = 0; j < 8; ++j) v[j] = src ? __builtin_nontemporal_load((const f32x4*)src + lane + 64 * j) : (f32x4){0.f, 0.f, 0.f, 0.f};
#pragma unroll
    for (int j = 0; j < 8; ++j) s += (v[j][0] * v[j][0] + v[j][1] * v[j][1]) + (v[j][2] * v[j][2] + v[j][3] * v[j][3]);
    s = wave_sum(s);
    const float rs = src ? 1.0f / sqrtf(s * (1.0f / DM) + EPS) : 0.f;
    if (lane == 0) *rstd_out = rs;
#pragma unroll
    for (int j = 0; j < 8; ++j) { const f32x4 y = v[j] * g[j] * rs; u32x2 o; o.x = cvt_pk_bf16(y[0], y[1]); o.y = cvt_pk_bf16(y[2], y[3]); st8_sc1((u32x2*)dst + lane + 64 * j, o); }
}
__device__ __forceinline__ void p0_prologue(LAS unsigned char* lds, const float* x, const float* meta, const float* ln_g, const float* w_in, const float* pw_w, const float* w_out,
                                            unsigned char* ws, int b, int tid, int wid, int lane) {
    LAS float* scr = (LAS float*)(lds + wid * 16384);
    const int gw = b * 8 + wid, NGW = GRID * 8;
    bf16_t* Win = (bf16_t*)(ws + WS_WIN); bf16_t* Wout = (bf16_t*)(ws + WS_WOUT); bf16_t* Wpw = (bf16_t*)(ws + WS_WPW);
    constexpr int I_IN = 32 * 224, I_OUT = 32 * 64, I_PW = 16 * 32;
    for (int it = gw; it < I_IN + I_OUT + I_PW; it += NGW) {
        int r = it;
        if (r < I_IN) { const int kb = r / 224, nb = r % 224; p0_transpose_item(w_in, DM, INW, Win, scr, kb, win_src_col(32 * nb), 32 * nb, lane); continue; } r -= I_IN;
        if (r < I_OUT) { const int kb = r / 64, nb = r % 64; p0_transpose_item(w_out, DM, DM, Wout, scr, kb, 32 * nb, 32 * nb, lane); continue; } r -= I_OUT;
        { const int kb = r / 32, nb = r % 32; p0_transpose_item(pw_w, CW, CW, Wpw, scr, kb, 32 * nb, 32 * nb, lane); }
    }
    bf16_t* HB = (bf16_t*)(ws + WS_HB); float* rstd = (float*)(ws + WS_RSTD);
    f32x4 gl[8];
#pragma unroll
    for (int j = 0; j < 8; ++j) gl[j] = ((const f32x4*)ln_g)[lane + 64 * j];
    for (int r = gw; r < MPAD; r += NGW) {
        const float* src = r < SEQ ? x + (size_t)r * DM : (r < LTOK ? meta + (size_t)(r - SEQ) * DM : nullptr);
        p0_row(src, HB + (size_t)r * DM, rstd + r, gl, lane);
    }
    float* cosT = (float*)(ws + WS_COS); float* sinT = (float*)(ws + WS_SIN);
    const int gid = b * NTHREADS + tid, i = gid & 127;
    const double inv = exp2(-(double)i * 0.10381025296523007);
    for (int pos = gid >> 7; pos < LTOK; pos += (GRID * NTHREADS) >> 7) {
        const double a = (double)pos * inv;
        const double n = rint(a * 0.15915494309189535);
        const float rr = (float)fma(-n, 6.283185307179586, a);
        float sn, cs; sincosf(rr, &sn, &cs);
        cosT[(size_t)pos * 128 + i] = cs; sinT[(size_t)pos * 128 + i] = sn;
    }
}

__device__ __forceinline__ void wait_count(unsigned* p, unsigned want) {
    unsigned sp = 0;
    while (__hip_atomic_load(p, __ATOMIC_RELAXED, __HIP_MEMORY_SCOPE_AGENT) < want) { __builtin_amdgcn_s_sleep(2); if (++sp > (1u << 20)) break; }
}
struct Sched1 { int c; unsigned* ctl;
    __device__ __forceinline__ bool next(int i, Unit& u) const {
        const int L = i * GRID + c;
        if (L < 896) { const int xcd = L & 7, off = L >> 3, wg = xcd * 112 + off, gid = wg / 224, rem = wg % 224; u.pm = gid * 8 + (rem & 7); u.pn = rem >> 3; return true; }
        if (L < 912) { const int t = L - 896; u.pm = 32; u.pn = t < 8 ? 4 + t : 8 + t; return true; }
        return false;
    }
    __device__ __forceinline__ void a_ready(const Unit&) const {}
    __device__ __forceinline__ void done(const Unit& u) const {
        Unit t3; (void)next(2, t3);
        const bool third = (u.pm == t3.pm && u.pn == t3.pn), meta = (u.pm == 32), gc = (u.pn >= 24);
        if (third || meta || gc) {
            asm volatile("s_waitcnt vmcnt(0)" ::: "memory");
            __syncthreads();
            if (threadIdx.x == 0) {
                if (third || meta) __hip_atomic_fetch_add(ctl + (meta ? CW_META : CW_MID), 1u, __ATOMIC_RELAXED, __HIP_MEMORY_SCOPE_AGENT);
                if (gc) __hip_atomic_fetch_add(ctl + CW_GC + 64 * u.pm, 1u, __ATOMIC_RELAXED, __HIP_MEMORY_SCOPE_AGENT);
            }
        }
    }
};
struct Epi1 {
    static constexpr bool PERM = true, AFTER_DRAIN = false, INIT = false;
    bf16_t *Qt, *Kt, *V, *U, *GY; const float *rstd, *cosT, *sinT;
    __device__ __forceinline__ void operator()(const f32x4 (&acc)[2][2][4][2], const Unit& u, int wr, int wc, int fr, int fq) const {
        const int pn = u.pn; const bool meta = (u.pm == 32);
        if (meta && wr != 0) return;
        const int cl = wc * 32 + 8 * fq;
        if (pn < 8 && !meta) {
            asm volatile("" : "+v"(fr));
            const int head = pn & 3; const bool isk = pn >= 4;
            const float l2g = kLog2G[head];
            bf16_t* base = (isk ? Kt : Qt) + head * 256 + cl;
            f32x4 c[2][2], sn[2][2];
            const unsigned toff = (unsigned)(((wr * 64 + fr) * 128 + cl) * 4), ooff = (unsigned)(((wr * 64 + fr) * RW) * 2);
            const char* cb = (const char*)cosT + (size_t)(u.pm * 256 + NMETA) * 512; const char* sb = (const char*)sinT + (size_t)(u.pm * 256 + NMETA) * 512;
            char* ob = (char*)base + (size_t)(u.pm * 256) * RW * 2;
            auto ld = [&](int g) {
                const size_t go = (size_t)((g >> 2) * 128 + (g & 3) * 16) * 512;
#pragma unroll
                for (int n = 0; n < 2; ++n) { c[g & 1][n] = *(const f32x4*)(cb + go + toff + 16 * n); sn[g & 1][n] = *(const f32x4*)(sb + go + toff + 16 * n); }
            };
            ld(0); ld(1);
#pragma unroll
            for (int g = 0; g < 8; ++g) {
                const int ai = g >> 2, m = g & 3, il = (ai * 128 + wr * 64 + m * 16 + fr) & 127;
                const float dec = isk ? 0.0625f * exp2f((float)(127 - il) * l2g) : exp2f((float)(il + 1) * l2g);
                f32x4 o1[2], o2[2];
#pragma unroll
                for (int n = 0; n < 2; ++n) { const f32x4 x1 = acc[ai][0][m][n], x2 = acc[ai][1][m][n];
                    o1[n] = (x1 * c[g & 1][n] - x2 * sn[g & 1][n]) * dec; o2[n] = (x1 * sn[g & 1][n] + x2 * c[g & 1][n]) * dec; }
                const u32x4 w1 = pack8(o1[0], o1[1]), w2 = pack8(o2[0], o2[1]);
                if (g + 2 < 8) ld(g + 2);
                bf16_t* dst = (bf16_t*)(ob + (size_t)(ai * 128 + m * 16) * RW * 2 + ooff);
                if (isk) { st16_sc1(dst, w1); st16_sc1(dst + 128, w2); } else { *(u32x4*)dst = w1; *(u32x4*)(dst + 128) = w2; }
            }
            return;
        }
#pragma unroll
        for (int ai = 0; ai < 2; ++ai)
#pragma unroll
            for (int m = 0; m < 4; ++m) {
                if (meta && (ai | m)) continue;
                const int r = u.pm * 256 + ai * 128 + wr * 64 + m * 16 + fr;
                if (pn < 8) {
                    const int head = pn & 3; const bool isk = pn >= 4;
                    const int pos = meta ? (r - SEQ) : (r + NMETA);
                    const int il = meta ? (112 + r - SEQ) : (r & 127);
                    const float l2g = kLog2G[head];
                    const float dec = isk ? 0.0625f * exp2f((float)(127 - il) * l2g) : exp2f((float)(il + 1) * l2g);
                    const f32x4* cp = (const f32x4*)(cosT + (size_t)pos * 128 + cl); const f32x4* sp = (const f32x4*)(sinT + (size_t)pos * 128 + cl);
                    f32x4 o1[2], o2[2];
#pragma unroll
                    for (int n = 0; n < 2; ++n) { const f32x4 c = cp[n], s = sp[n], x1 = acc[ai][0][m][n], x2 = acc[ai][1][m][n];
                        o1[n] = (x1 * c - x2 * s) * dec; o2[n] = (x1 * s + x2 * c) * dec; }
                    bf16_t* dst = (isk ? Kt : Qt) + (size_t)r * RW + head * 256 + cl;
                    if (isk) { st16_sc1(dst, pack8(o1[0], o1[1])); st16_sc1(dst + 128, pack8(o2[0], o2[1])); }
                    else { *(u32x4*)dst = pack8(o1[0], o1[1]); *(u32x4*)(dst + 128) = pack8(o2[0], o2[1]); }
                } else if (pn < 12) {
                    bf16_t* dst = V + (size_t)r * RW + (pn - 8) * 256 + cl;
#pragma unroll
                    for (int bj = 0; bj < 2; ++bj) st16_sc1(dst + 128 * bj, pack8(acc[ai][bj][m][0], acc[ai][bj][m][1]));
                } else if (pn < 16 || pn >= 24) {
                    bf16_t* dst = GY + (size_t)r * DM + (pn < 16 ? (pn - 12) * 256 : 1024 + (pn - 24) * 256) + cl;
#pragma unroll
                    for (int bj = 0; bj < 2; ++bj) { f32x4 g0 = acc[ai][bj][m][0], g1 = acc[ai][bj][m][1];
#pragma unroll
                        for (int e = 0; e < 4; ++e) { g0[e] = silu_f(g0[e]); g1[e] = silu_f(g1[e]); }
                        if (pn >= 24) st16_sc1(dst + 128 * bj, pack8(g0, g1)); else *(u32x4*)(dst + 128 * bj) = pack8(g0, g1); }
                } else {
                    f32x4 u0 = acc[ai][0][m][0], u1 = acc[ai][0][m][1]; const f32x4 b0 = acc[ai][1][m][0], b1 = acc[ai][1][m][1];
#pragma unroll
                    for (int e = 0; e < 4; ++e) { u0[e] *= sigmoid_f(b0[e]); u1[e] *= sigmoid_f(b1[e]); }
                    st16_sc1(U + (size_t)r * CW + (pn - 16) * 128 + cl, pack8(u0, u1));
                }
            }
    }
};

__device__ __forceinline__ void p2a_kv(LAS unsigned char* lds, const bf16_t* __restrict__ Kt, const bf16_t* __restrict__ V, bf16_t* __restrict__ KVT, int c, int h, int tid, int wid, int lane) {
    constexpr int PT = 576, PR = 528;
    LAS unsigned char* imgK = lds; LAS unsigned char* imgV = lds + 128 * PT;
    {
        u32x4 kreg[8], vreg[8];
#pragma unroll
        for (int it = 0; it < 8; ++it) {
            const int ci = tid + NTHREADS * it, row = ci >> 5, cc = ci & 31;
            const size_t grow = c > 0 ? (size_t)(c - 1) * 128 + row : (size_t)(SEQ + (row >= 112 ? row - 112 : 0));
            kreg[it] = *(const u32x4*)(Kt + grow * RW + h * 256 + cc * 8); vreg[it] = *(const u32x4*)(V + grow * RW + h * 256 + cc * 8);
        }
#pragma unroll
        for (int it = 0; it < 8; ++it) {
            const int ci = tid + NTHREADS * it, row = ci >> 5, cc = ci & 31;
            const bool valid = (c > 0) || (row >= 112);
            u32x4 kv = kreg[it], vv = vreg[it];
            if (!valid) { kv = (u32x4){0u, 0u, 0u, 0u}; vv = kv; }
            *(LAS u32x4*)(imgK + row * PT + cc * 16) = kv; *(LAS u32x4*)(imgV + row * PT + cc * 16) = vv;
        }
    }
    __syncthreads();
    const int w2 = wid >> 2, w4 = wid & 3, n31 = lane & 31, i16 = lane & 15, q4 = i16 >> 2, p4 = i16 & 3, blk = (lane >> 4) & 1, hh = lane >> 5;
    f32x16 acc[4][2];
#pragma unroll
    for (int a = 0; a < 4; ++a)
#pragma unroll
        for (int b2 = 0; b2 < 2; ++b2)
#pragma unroll
            for (int e = 0; e < 16; ++e) acc[a][b2][e] = 0.f;
#pragma unroll
    for (int ks = 0; ks < 8; ++ks) {
        const int tok = 16 * ks + 8 * hh + q4;
        bf16x8 af[4], bf[2];
#pragma unroll
        for (int a = 0; a < 4; ++a) { const int col0 = 128 * w2 + 32 * a + 16 * blk + 4 * p4;
            const s16x4 lo = tr_read(imgK + tok * PT + col0 * 2), hi = tr_read(imgK + (tok + 4) * PT + col0 * 2);
            af[a] = __builtin_shufflevector(lo, hi, 0, 1, 2, 3, 4, 5, 6, 7); }
#pragma unroll
        for (int b2 = 0; b2 < 2; ++b2) { const int col0 = 64 * w4 + 32 * b2 + 16 * blk + 4 * p4;
            const s16x4 lo = tr_read(imgV + tok * PT + col0 * 2), hi = tr_read(imgV + (tok + 4) * PT + col0 * 2);
            bf[b2] = __builtin_shufflevector(lo, hi, 0, 1, 2, 3, 4, 5, 6, 7); }
#pragma unroll
        for (int a = 0; a < 4; ++a)
#pragma unroll
            for (int b2 = 0; b2 < 2; ++b2) acc[a][b2] = MFMA32(af[a], bf[b2], acc[a][b2]);
    }
    __syncthreads();
#pragma unroll
    for (int a = 0; a < 4; ++a)
#pragma unroll
        for (int b2 = 0; b2 < 2; ++b2)
#pragma unroll
            for (int g = 0; g < 4; ++g) { u32x2 o; o.x = cvt_pk_bf16(acc[a][b2][4 * g], acc[a][b2][4 * g + 1]); o.y = cvt_pk_bf16(acc[a][b2][4 * g + 2], acc[a][b2][4 * g + 3]);
                *(LAS u32x2*)(lds + (64 * w4 + 32 * b2 + n31) * PR + (128 * w2 + 32 * a + 8 * g + 4 * hh) * 2) = o; }
    __syncthreads();
    bf16_t* dst = KVT;
#pragma unroll
    for (int it = 0; it < 16; ++it) {
        const int ci = tid + NTHREADS * it, row = ci >> 5, cc = ci & 31;
        *(u32x4*)(dst + (size_t)row * 256 + cc * 8) = *(LAS u32x4*)(lds + row * PR + cc * 16);
    }
    __syncthreads();
}
__device__ __forceinline__ void p2a_conv(LAS unsigned char* lds, const bf16_t* __restrict__ U, const float* __restrict__ dw_w, const float* __restrict__ dw_b, const float* __restrict__ ln_g, const float* __restrict__ ln_b,
                                         bf16_t* __restrict__ CB, int ct, int tid, int wid, int lane) {
    {
        f32x2 w[CK];
#pragma unroll
        for (int j = 0; j < CK; ++j) w[j] = *(const f32x2*)(dw_w + j * CW + 2 * tid);
        const f32x2 bias = *(const f32x2*)(dw_b + 2 * tid);
        f32x2 acc[32];
#pragma unroll
        for (int t = 0; t < 32; ++t) acc[t] = bias;
        const int p0 = 32 * ct + NMETA - (CK - 1);
#pragma unroll
        for (int s = 0; s < 32 + CK - 1; ++s) {
            const int p = p0 + s, pc = p < 0 ? 0 : p, row = pc >= NMETA ? pc - NMETA : SEQ + pc;
            unsigned raw = *(const unsigned*)(U + (size_t)row * CW + 2 * tid);
            if (p < 0) raw = 0u;
            const f32x2 uv = {bf_lo(raw), bf_hi(raw)};
#pragma unroll
            for (int t = (s - (CK - 1) > 0 ? s - (CK - 1) : 0); t <= (s < 31 ? s : 31); ++t) acc[t] = __builtin_elementwise_fma(uv, w[s - t], acc[t]);
        }
#pragma unroll
        for (int t = 0; t < 32; ++t) *(LAS f32x2*)(lds + (t * CW + 2 * tid) * 4) = acc[t];
    }
    __syncthreads();
    {
        f32x4 gg[2][2], bb[2][2];
#pragma unroll
        for (int i = 0; i < 2; ++i)
#pragma unroll
            for (int q = 0; q < 2; ++q) { gg[i][q] = *(const f32x4*)(ln_g + 512 * i + 8 * lane + 4 * q); bb[i][q] = *(const f32x4*)(ln_b + 512 * i + 8 * lane + 4 * q); }
#pragma unroll
        for (int k = 0; k < 4; ++k) {
            const int t = 4 * wid + k;
            f32x4 v[2][2]; float s = 0.f;
#pragma unroll
            for (int i = 0; i < 2; ++i)
#pragma unroll
                for (int q = 0; q < 2; ++q) { v[i][q] = *(LAS f32x4*)(lds + (t * CW + 512 * i + 8 * lane + 4 * q) * 4); s += (v[i][q][0] + v[i][q][1]) + (v[i][q][2] + v[i][q][3]); }
            const float mu = wave_sum(s) * (1.0f / CW);
            float qq = 0.f;
#pragma unroll
            for (int i = 0; i < 2; ++i)
#pragma unroll
                for (int q = 0; q < 2; ++q) { v[i][q] = v[i][q] - mu; qq += (v[i][q][0] * v[i][q][0] + v[i][q][1] * v[i][q][1]) + (v[i][q][2] * v[i][q][2] + v[i][q][3] * v[i][q][3]); }
            const float rs = 1.0f / sqrtf(wave_sum(qq) * (1.0f / CW) + EPS);
#pragma unroll
            for (int i = 0; i < 2; ++i) { f32x4 y0 = v[i][0] * rs * gg[i][0] + bb[i][0], y1 = v[i][1] * rs * gg[i][1] + bb[i][1];
#pragma unroll
                for (int e = 0; e < 4; ++e) { y0[e] = silu_f(y0[e]); y1[e] = silu_f(y1[e]); }
                st16_sc1(CB + (size_t)(32 * ct + t) * CW + 512 * i + 8 * lane, pack8(y0, y1)); }
        }
    }
    asm volatile("s_waitcnt vmcnt(0)" ::: "memory");
    __syncthreads();
}

__device__ __forceinline__ void p2b_scan(bf16_t* ST, int sb, int tid) {
    const int e2 = sb * NTHREADS + tid, h = e2 >> 15;
    const float cd = exp2f(128.0f * kLog2G[h]);
    f32x2 S = {0.f, 0.f};
    unsigned* p = (unsigned*)ST + e2;
#pragma unroll 1
    for (int c0 = 0; c0 < 64; c0 += 16) {
        unsigned kv[16];
#pragma unroll
        for (int j = 0; j < 16; ++j) kv[j] = __builtin_nontemporal_load(p + (size_t)(c0 + j) * 131072);
#pragma unroll
        for (int j = 0; j < 16; ++j) {
            const f32x2 k2 = {bf_lo(kv[j]), bf_hi(kv[j])};
            S = S * cd + k2;
            p[(size_t)(c0 + j) * 131072] = cvt_pk_bf16(S[0], S[1]);
        }
    }
}
struct SchedOne { int pm, pn; bool on;
    __device__ __forceinline__ bool next(int i, Unit& u) const { if (i > 0 || !on) return false; u.pm = pm; u.pn = pn; return true; }
    __device__ __forceinline__ void a_ready(const Unit&) const {}
    __device__ __forceinline__ void done(const Unit&) const {}
};
struct EpiPw {
    static constexpr bool PERM = true, AFTER_DRAIN = false, INIT = false;
    bf16_t* GY; const float* pw_b;
    __device__ __forceinline__ void operator()(const f32x4 (&acc)[2][2][4][2], const Unit& u, int wr, int wc, int fr, int fq) const {
        const int cl = wc * 32 + 8 * fq;
#pragma unroll
        for (int bj = 0; bj < 2; ++bj) {
            const int col = u.pn * 256 + bj * 128 + cl;
            const f32x4 b0 = *(const f32x4*)(pw_b + col), b1 = *(const f32x4*)(pw_b + col + 4);
#pragma unroll
            for (int ai = 0; ai < 2; ++ai)
#pragma unroll
                for (int m = 0; m < 4; ++m) {
                    const int r = u.pm * 256 + ai * 128 + wr * 64 + m * 16 + fr;
                    bf16_t* p = GY + (size_t)r * DM + 1024 + col;
                    const u32x4 g = *(const u32x4*)p;
                    const f32x4 g0 = {bf_lo(g.x), bf_hi(g.x), bf_lo(g.y), bf_hi(g.y)}, g1 = {bf_lo(g.z), bf_hi(g.z), bf_lo(g.w), bf_hi(g.w)};
                    *(u32x4*)p = pack8((acc[ai][bj][m][0] + b0) * g0, (acc[ai][bj][m][1] + b1) * g1);
                }
        }
    }
};

__device__ __forceinline__ void p2c_images(LAS unsigned char* lds, const bf16_t* __restrict__ Qt, const bf16_t* __restrict__ Kt, int xc, int h, int tid) {
    constexpr int PR = 528;
    LAS unsigned char* imgQ = lds; LAS unsigned char* imgK = lds + 73728;
    const size_t row0 = (size_t)xc * 128;
#pragma unroll
    for (int it = 0; it < 8; ++it) {
        const int ci = tid + NTHREADS * it, row = ci >> 5, cc = ci & 31;
        const u32x4 q = __builtin_nontemporal_load((const u32x4*)(Qt + (row0 + row) * RW + h * 256 + cc * 8)), k = __builtin_nontemporal_load((const u32x4*)(Kt + (row0 + row) * RW + h * 256 + cc * 8));
        *(LAS u32x4*)(imgQ + row * PR + cc * 16) = q; *(LAS u32x4*)(imgK + row * PR + cc * 16) = k;
    }
}
__device__ __forceinline__ void p2c_item(LAS unsigned char* lds, const bf16_t* __restrict__ Qt, const bf16_t* __restrict__ Kt, const bf16_t* __restrict__ V, const bf16_t* __restrict__ ST, bf16_t* __restrict__ GY,
                                         const float* __restrict__ gn_g, int xc, int h, int tid, int wid, int lane, const XcdBarrier& bar, bool pending, unsigned tok, unsigned tok2, bool preloaded) {
    constexpr int PR = 528, PT = 576, PF = 1040;
    LAS unsigned char* imgQ = lds; LAS unsigned char* imgK = lds + 73728; LAS unsigned char* imgV = lds + 73728; LAS unsigned char* imgS = lds;
    LAS float* ex = (LAS float*)(lds + 135168);
    const int wr = wid >> 1, wc = wid & 1, n31 = lane & 31, hh = lane >> 5, i16 = lane & 15, q4 = i16 >> 2, p4 = i16 & 3, blk = (lane >> 4) & 1;
    const size_t row0 = (size_t)xc * 128;
    if (!preloaded) p2c_images(lds, Qt, Kt, xc, h, tid);
    u32x4 vreg[8];
#pragma unroll
    for (int it = 0; it < 8; ++it) { const int ci = tid + NTHREADS * it, row = ci >> 5, cc = ci & 31; vreg[it] = __builtin_nontemporal_load((const u32x4*)(V + (row0 + row) * RW + h * 256 + cc * 8)); }
    __syncthreads();
    const float ginv = exp2f(-128.0f * kLog2G[h]);
    bf16x8 pf[4][2];
    {
        bf16x8 qf[16];
#pragma unroll
        for (int ks = 0; ks < 16; ++ks) qf[ks] = *(LAS bf16x8*)(imgQ + (32 * wr + n31) * PR + (16 * ks + 8 * hh) * 2);
#pragma unroll
        for (int jb = 0; jb < 4; ++jb) {
            if (jb <= wr) {
                f32x16 X;
#pragma unroll
                for (int e = 0; e < 16; ++e) X[e] = 0.f;
#pragma unroll
                for (int ks = 0; ks < 16; ++ks) { const bf16x8 kf = *(LAS bf16x8*)(imgK + (32 * jb + n31) * PR + (16 * ks + 8 * hh) * 2); X = MFMA32(kf, qf[ks], X); }
#pragma unroll
                for (int e = 0; e < 16; ++e) { const bool keep = (jb < wr) || (crow(e, hh) <= n31); X[e] = keep ? X[e] * ginv : 0.f; }
#pragma unroll
                for (int s2 = 0; s2 < 2; ++s2) { u32x4 p; p.x = cvt_pk_bf16(X[8 * s2], X[8 * s2 + 1]); p.y = cvt_pk_bf16(X[8 * s2 + 2], X[8 * s2 + 3]); p.z = cvt_pk_bf16(X[8 * s2 + 4], X[8 * s2 + 5]); p.w = cvt_pk_bf16(X[8 * s2 + 6], X[8 * s2 + 7]);
                    pf[jb][s2] = __builtin_bit_cast(bf16x8, p); }
            } else { pf[jb][0] = (bf16x8){0, 0, 0, 0, 0, 0, 0, 0}; pf[jb][1] = pf[jb][0]; }
        }
    }
    if (pending && tid == 0) xcd_barrier_wait_t0(bar, tok, tok2);
    __syncthreads();
#pragma unroll
    for (int it = 0; it < 8; ++it) { const int ci = tid + NTHREADS * it, row = ci >> 5, cc = ci & 31; *(LAS u32x4*)(imgV + row * PT + cc * 16) = vreg[it]; }
    const bf16_t* Ssrc = ST + (size_t)(xc * 4 + h) * 65536;
    u32x4 sreg[8];
#pragma unroll
    for (int it = 0; it < 8; ++it) { const int ci = tid + NTHREADS * it, row = ci >> 5, cc = ci & 31; sreg[it] = __builtin_nontemporal_load((const u32x4*)(Ssrc + (size_t)row * 256 + cc * 8)); }
    __syncthreads();
    f32x16 acc[4];
#pragma unroll
    for (int nb = 0; nb < 4; ++nb)
#pragma unroll
        for (int e = 0; e < 16; ++e) acc[nb][e] = 0.f;
#pragma unroll
    for (int jb = 0; jb < 4; ++jb) {
        if (jb <= wr) {
#pragma unroll
            for (int s2 = 0; s2 < 2; ++s2) {
                const int tok = 32 * jb + 16 * s2 + 4 * hh + q4;
#pragma unroll
                for (int nb = 0; nb < 4; ++nb) { const int col0 = 128 * wc + 32 * nb + 16 * blk + 4 * p4;
                    const s16x4 lo = tr_read(imgV + tok * PT + col0 * 2), hi = tr_read(imgV + (tok + 8) * PT + col0 * 2);
                    const bf16x8 vf = __builtin_shufflevector(lo, hi, 0, 1, 2, 3, 4, 5, 6, 7);
                    acc[nb] = MFMA32(pf[jb][s2], vf, acc[nb]); }
            }
        }
    }
    bf16x8 qf[16];
#pragma unroll
    for (int ks = 0; ks < 16; ++ks) qf[ks] = *(LAS bf16x8*)(imgQ + (32 * wr + n31) * PR + (16 * ks + 8 * hh) * 2);
    __syncthreads();
    {
        u32x4 sreg2[8];
#pragma unroll
        for (int it = 0; it < 8; ++it) { const int ci = tid + NTHREADS * (it + 8), row = ci >> 5, cc = ci & 31; sreg2[it] = __builtin_nontemporal_load((const u32x4*)(Ssrc + (size_t)row * 256 + cc * 8)); }
#pragma unroll
        for (int it = 0; it < 8; ++it) { const int ci = tid + NTHREADS * it, row = ci >> 5, cc = ci & 31; *(LAS u32x4*)(imgS + row * PR + cc * 16) = sreg[it]; }
#pragma unroll
        for (int it = 0; it < 8; ++it) { const int ci = tid + NTHREADS * (it + 8), row = ci >> 5, cc = ci & 31; *(LAS u32x4*)(imgS + row * PR + cc * 16) = sreg2[it]; }
    }
    u32x4 greg[8];
#pragma unroll
    for (int it = 0; it < 8; ++it) { const int ci = tid + NTHREADS * it, row = ci >> 5, cc = ci & 31; greg[it] = __builtin_nontemporal_load((const u32x4*)(GY + (row0 + row) * DM + h * 256 + cc * 8)); }
    __syncthreads();
#pragma unroll
    for (int ks = 0; ks < 16; ++ks)
#pragma unroll
        for (int nb = 0; nb < 4; ++nb) { const bf16x8 sf = *(LAS bf16x8*)(imgS + (128 * wc + 32 * nb + n31) * PR + (16 * ks + 8 * hh) * 2); acc[nb] = MFMA32(qf[ks], sf, acc[nb]); }
    float sm[16], sq[16];
#pragma unroll
    for (int e = 0; e < 16; ++e) {
        float a = (acc[0][e] + acc[1][e]) + (acc[2][e] + acc[3][e]);
        float q = (acc[0][e] * acc[0][e] + acc[1][e] * acc[1][e]) + (acc[2][e] * acc[2][e] + acc[3][e] * acc[3][e]);
        a = sum32(a); q = sum32(q);
        sm[e] = a; sq[e] = q;
        if (n31 == e) { ex[(wid * 32 + crow(e, hh)) * 2] = a; ex[(wid * 32 + crow(e, hh)) * 2 + 1] = q; }
    }
    __syncthreads();
    float gng[4];
#pragma unroll
    for (int nb = 0; nb < 4; ++nb) gng[nb] = gn_g[h * 256 + 128 * wc + 32 * nb + n31];
#pragma unroll
    for (int e = 0; e < 16; ++e) {
        const int rl = crow(e, hh);
        const float ta = sm[e] + ex[((wid ^ 1) * 32 + rl) * 2], tq = sq[e] + ex[((wid ^ 1) * 32 + rl) * 2 + 1];
        const float mu = ta * (1.0f / RD), var = tq * (1.0f / RD) - mu * mu, rs = __builtin_amdgcn_rsqf(fmaxf(var, 0.f) + EPS);
#pragma unroll
        for (int nb = 0; nb < 4; ++nb) *(LAS float*)(lds + (32 * wr + rl) * PF + (128 * wc + 32 * nb + n31) * 4) = (acc[nb][e] - mu) * rs * gng[nb];
    }
    __syncthreads();
#pragma unroll
    for (int it = 0; it < 8; ++it) {
        const int ci = tid + NTHREADS * it, row = ci >> 5, cc = ci & 31;
        const f32x4 y0 = *(LAS f32x4*)(lds + row * PF + cc * 32), y1 = *(LAS f32x4*)(lds + row * PF + cc * 32 + 16);
        const u32x4 g = greg[it];
        const f32x4 g0 = {bf_lo(g.x), bf_hi(g.x), bf_lo(g.y), bf_hi(g.y)}, g1 = {bf_lo(g.z), bf_hi(g.z), bf_lo(g.w), bf_hi(g.w)};
        st16_sc1(GY + (row0 + row) * DM + h * 256 + cc * 8, pack8(y0 * g0, y1 * g1));
    }
    asm volatile("s_waitcnt vmcnt(0)" ::: "memory");
    __syncthreads();
}

struct SchedP3 { int pm, pn; unsigned* cnt; unsigned want;
    __device__ __forceinline__ bool next(int i, Unit& u) const { if (i > 0) return false; u.pm = pm; u.pn = pn; return true; }
    __device__ __forceinline__ void a_ready(const Unit&) const {
        if (threadIdx.x == 0) { wait_count(cnt + 64 * pm, want); __builtin_amdgcn_fence(__ATOMIC_ACQUIRE, "agent"); asm volatile("s_waitcnt vmcnt(0)" ::: "memory"); }
        __syncthreads();
    }
    __device__ __forceinline__ void done(const Unit&) const {}
};
struct Epi3 {
    static constexpr bool PERM = true, AFTER_DRAIN = true, INIT = true;
    const float* x; float* out; const float* final_g; float* psum; unsigned* panel;
    __device__ __forceinline__ void init(f32x4 (&acc)[2][2][4][2], const Unit& u, int wr, int wc, int fr, int fq) const {
        const int cl = wc * 32 + 8 * fq;
#pragma unroll
        for (int ai = 0; ai < 2; ++ai)
#pragma unroll
            for (int m = 0; m < 4; ++m) { const float* xr = x + ((size_t)u.pm * 256 + ai * 128 + wr * 64 + m * 16 + fr) * DM + u.pn * 256 + cl;
#pragma unroll
                for (int bj = 0; bj < 2; ++bj)
#pragma unroll
                    for (int n = 0; n < 2; ++n) acc[ai][bj][m][n] = __builtin_nontemporal_load((const f32x4*)(xr + bj * 128 + 4 * n)); }
    }
    __device__ __forceinline__ void fused(f32x4 (&acc)[2][2][4][2], const Unit& u, int wr, int wc, int fr, int fq, LAS unsigned char* lds, int wid, int lane) const {
        constexpr int PF = 1040;
        int ln = lane; asm volatile("" : "+v"(ln));
        const int cl = wc * 32 + 8 * fq, wv = wid;
        const size_t prow = (size_t)u.pn * SEQ + u.pm * 256;
        LAS float* red = (LAS float*)(lds + 135168);
#pragma unroll
        for (int ai = 0; ai < 2; ++ai)
#pragma unroll
            for (int m = 0; m < 4; ++m) {
                float sq = 0.f;
#pragma unroll
                for (int bj = 0; bj < 2; ++bj)
#pragma unroll
                    for (int n = 0; n < 2; ++n) { const f32x4 v = acc[ai][bj][m][n]; sq += (v[0] * v[0] + v[1] * v[1]) + (v[2] * v[2] + v[3] * v[3]); }
                sq += __builtin_bit_cast(float, __builtin_amdgcn_ds_swizzle(__builtin_bit_cast(int, sq), 0x401F)); sq += __shfl_xor(sq, 32);
                if (fq == 0) red[wc * 256 + ai * 128 + wr * 64 + m * 16 + fr] = sq;
            }
        __syncthreads();
        if (threadIdx.x < 256) { const int t = threadIdx.x; const float tot = (red[t] + red[256 + t]) + (red[512 + t] + red[768 + t]);
            __hip_atomic_store(psum + prow + t, tot, __ATOMIC_RELAXED, __HIP_MEMORY_SCOPE_AGENT); }
        asm volatile("s_waitcnt vmcnt(0)" ::: "memory");
        __syncthreads();
        if (threadIdx.x == 0) __hip_atomic_fetch_add(panel + 64 * u.pm, 1u, __ATOMIC_RELAXED, __HIP_MEMORY_SCOPE_AGENT);
        f32x4 hreg[2][16];
#pragma unroll
        for (int ai = 0; ai < 2; ++ai) {
            if (ai) __syncthreads();
#pragma unroll
            for (int m = 0; m < 4; ++m)
#pragma unroll
                for (int bj = 0; bj < 2; ++bj)
#pragma unroll
                    for (int n = 0; n < 2; ++n) *(LAS f32x4*)(lds + (wr * 64 + m * 16 + fr) * PF + (bj * 128 + cl + 4 * n) * 4) = acc[ai][bj][m][n];
            __syncthreads();
#pragma unroll
            for (int it = 0; it < 16; ++it) hreg[ai][it] = *(LAS f32x4*)(lds + (wv + 8 * it) * PF + ln * 16);
        }
        if (threadIdx.x == 0) {
            wait_count(panel + 64 * u.pm, 8u);
            __builtin_amdgcn_fence(__ATOMIC_ACQUIRE, "agent");
            asm volatile("s_waitcnt vmcnt(0)" ::: "memory");
        }
        __syncthreads();
        float rsl;
        { const size_t r = (size_t)u.pm * 256 + (ln >> 4 & 1) * 128 + wv + 8 * (ln & 15);
          float tot = 0.f;
#pragma unroll
          for (int p = 0; p < 8; ++p) tot += psum[(size_t)p * SEQ + r];
          rsl = 1.0f / sqrtf(tot * (1.0f / DM) + EPS); }
        const f32x4 g = *(const f32x4*)(final_g + u.pn * 256 + 4 * ln);
        float* ob = out + ((size_t)u.pm * 256 + wv) * DM + u.pn * 256 + 4 * ln;
#pragma unroll
        for (int ai = 0; ai < 2; ++ai)
#pragma unroll
            for (int it = 0; it < 16; ++it) {
                const float rs = __builtin_bit_cast(float, __builtin_amdgcn_readlane(__builtin_bit_cast(int, rsl), ai * 16 + it));
                __builtin_nontemporal_store(hreg[ai][it] * rs * g, (f32x4*)(ob + (size_t)(ai * 128 + 8 * it) * DM));
            }
    }
};

struct Args { const float* in[13]; float* out; unsigned char* ws; int ph_lo, ph_hi; };
__global__ void __launch_bounds__(NTHREADS, 2) mega(Args a) {
    extern __shared__ __attribute__((aligned(16))) unsigned char lds_[];
    LAS unsigned char* lds = (LAS unsigned char*)lds_;
    const int tid = threadIdx.x, lane = tid & 63, wid = __builtin_amdgcn_readfirstlane(tid >> 6), b = blockIdx.x;
    unsigned char* ws = a.ws;
    const float *x = a.in[0], *meta = a.in[1], *ln_g = a.in[2], *w_in = a.in[3], *gn_g = a.in[4], *dw_w = a.in[5], *dw_b = a.in[6], *cln_g = a.in[7], *cln_b = a.in[8],
                *pw_w = a.in[9], *pw_b = a.in[10], *w_out = a.in[11], *final_g = a.in[12];
    for (int u = tid; u < (LDS_BYTES - MISC_OFF) / 4; u += NTHREADS) ((LAS unsigned*)(lds + MISC_OFF))[u] = 0u;
    __syncthreads();
    XcdBarrier bar = xcd_barrier_post((unsigned*)(ws + WS_CTL) + CW_BAR, (volatile LAS unsigned*)(lds + MISC_OFF) + 8);
    const int lo = a.ph_lo, hi = a.ph_hi;
#define IN(k) (lo <= (k) && (k) < hi)
#define SEAM(k) do { if (IN(k) && IN((k) + 1)) xcd_barrier(bar); } while (0)
#define WS_LAUNDER() size_t wsz_ = 0; asm volatile("" : "+s"(wsz_)); unsigned char* wsl = ws + wsz_
    if (IN(0)) { p0_prologue(lds, x, meta, ln_g, w_in, pw_w, w_out, ws, b, tid, wid, lane); }
    SEAM(0);
    if (IN(1)) {
        unsigned* ctl = (unsigned*)(ws + WS_CTL);
        {
            WS_LAUNDER();
            pg8::Gemm g{(const bf16_t*)(wsl + WS_HB), (const bf16_t*)(wsl + WS_WIN), MPAD, INW, DM};
            Sched1 S{b, ctl};
            Epi1 E{(bf16_t*)(wsl + WS_QT), (bf16_t*)(wsl + WS_KT), (bf16_t*)(wsl + WS_V), (bf16_t*)(wsl + WS_U), (bf16_t*)(wsl + WS_GY), (const float*)(wsl + WS_RSTD), (const float*)(wsl + WS_COS), (const float*)(wsl + WS_SIN)};
            pg8::gemm_phase<Epi1, Sched1, true, true>(lds, g, S, E);
        }
        {
            WS_LAUNDER();
            volatile LAS unsigned* misc = (volatile LAS unsigned*)(lds + MISC_OFF);
            if (tid == 0) { wait_count(ctl + CW_MID, (unsigned)GRID); __builtin_amdgcn_fence(__ATOMIC_ACQUIRE, "agent"); asm volatile("s_waitcnt vmcnt(0)" ::: "memory"); }
            __syncthreads();
            bool meta_ok = false;
            for (;;) {
                if (tid == 0) misc[0] = __hip_atomic_fetch_add(ctl + CW_Q, 1u, __ATOMIC_RELAXED, __HIP_MEMORY_SCOPE_AGENT);
                __syncthreads();
                const int item = (int)misc[0];
                __syncthreads();
                if (item >= 640) break;
                if (item >= 256 && item < 384) {
                    const int pm = (item - 256) >> 2, pn = item & 3;
                    if (tid == 0) { wait_count(ctl + CW_CONV + 64 * pm, 8u); wait_count(ctl + CW_GC + 64 * pm, 4u); __builtin_amdgcn_fence(__ATOMIC_ACQUIRE, "agent"); asm volatile("s_waitcnt vmcnt(0)" ::: "memory"); }
                    __syncthreads();
                    size_t zp = 0; asm volatile("" : "+s"(zp));
                    pg8::Gemm g{(const bf16_t*)(wsl + WS_CB) + zp, (const bf16_t*)(wsl + WS_WPW) + zp, SEQ, CW, CW};
                    SchedOne S{pm, pn, true};
                    EpiPw E{(bf16_t*)(wsl + WS_GY) + zp, pw_b + zp};
                    pg8::gemm_phase<EpiPw, SchedOne, false, true>(lds, g, S, E);
                    continue;
                }
                const bool is_kv = item >= 384;
                const int j = is_kv ? item - 384 : item;
                const int c = j < 252 ? (j >> 2) + 1 : 0, hq = j & 3, ct = j < 255 ? j + 1 : 0;
                const bool needs_meta = is_kv ? (c == 0) : (ct == 0);
                if (needs_meta && !meta_ok) {
                    if (tid == 0) { wait_count(ctl + CW_META, 16u); __builtin_amdgcn_fence(__ATOMIC_ACQUIRE, "agent"); asm volatile("s_waitcnt vmcnt(0)" ::: "memory"); }
                    __syncthreads();
                    meta_ok = true;
                }
                size_t zi = 0; asm volatile("" : "+s"(zi));
                int tl = tid; asm volatile("" : "+v"(tl));
                const int ll = tl & 63, wl = __builtin_amdgcn_readfirstlane(tl >> 6);
                if (is_kv) p2a_kv(lds, (const bf16_t*)(wsl + WS_KT) + zi, (const bf16_t*)(wsl + WS_V) + zi, kvt_tile(wsl, c * 4 + hq) + zi, c, hq, tl, wl, ll);
                else { p2a_conv(lds, (const bf16_t*)(wsl + WS_U) + zi, dw_w + zi, dw_b + zi, cln_g + zi, cln_b + zi, (bf16_t*)(wsl + WS_CB) + zi, ct, tl, wl, ll);
                       if (tid == 0) __hip_atomic_fetch_add(ctl + CW_CONV + 64 * (ct >> 3), 1u, __ATOMIC_RELAXED, __HIP_MEMORY_SCOPE_AGENT); }
            }
        }
    }
    const bool preloaded = IN(1) && IN(3);
    {
        unsigned t1 = 0u, t1b = 0u;
        const bool pend1 = IN(1) && IN(2);
        if (pend1) xcd_barrier_arrive(bar, t1, t1b);
        if (preloaded) { WS_LAUNDER(); p2c_images(lds, (const bf16_t*)(wsl + WS_QT), (const bf16_t*)(wsl + WS_KT), b >> 2, b & 3, tid); }
        if (pend1) { if (tid == 0) xcd_barrier_wait_t0(bar, t1, t1b); __syncthreads(); }
    }
    if (IN(2)) {
        WS_LAUNDER();
        p2b_scan((bf16_t*)(wsl + WS_ST), b, tid);
    }
    unsigned tok = 0u, tok2 = 0u;
    const bool pending = IN(2) && IN(3);
    if (pending) xcd_barrier_arrive(bar, tok, tok2);
    if (IN(3)) {
        WS_LAUNDER();
        p2c_item(lds, (const bf16_t*)(wsl + WS_QT), (const bf16_t*)(wsl + WS_KT), (const bf16_t*)(wsl + WS_V), (const bf16_t*)(wsl + WS_ST), (bf16_t*)(wsl + WS_GY), gn_g, b >> 2, b & 3, tid, wid, lane, bar, pending, tok, tok2, preloaded);
        if (tid == 0) __hip_atomic_fetch_add((unsigned*)(ws + WS_CTL) + CW_YR + 64 * (b >> 3), 1u, __ATOMIC_RELAXED, __HIP_MEMORY_SCOPE_AGENT);
    }
    if (IN(4)) {
        WS_LAUNDER();
        pg8::Gemm g{(const bf16_t*)(wsl + WS_GY), (const bf16_t*)(wsl + WS_WOUT), SEQ, DM, DM};
        const int xcd = b & 7, off = b >> 3, wg = xcd * 32 + off;
        SchedP3 S{(wg >> 6) * 8 + (wg & 7), (wg & 63) >> 3, (unsigned*)(ws + WS_CTL) + CW_YR, IN(3) ? 8u : 0u};
        Epi3 E{x, a.out, final_g, (float*)(wsl + WS_PSUM), (unsigned*)(ws + WS_CTL) + CW_PANEL};
        pg8::gemm_phase<Epi3, SchedP3, false, true>(lds, g, S, E);
    }
#undef WS_LAUNDER
#undef IN
#undef SEAM
}
}

#ifndef LADDER
#define LADDER 0
#endif
#ifndef PROBE_K
#define PROBE_K 0
#endif
#ifndef PROBE_TAIL
#define PROBE_TAIL 0
#endif
#if LADDER > 0
namespace nt {
using namespace mk;
__device__ __forceinline__ float bf2f(bf16_t v) { return __uint_as_float((unsigned)v << 16); }
__device__ __forceinline__ bf16_t f2bf(float f) { unsigned u = __float_as_uint(f); return (bf16_t)((u + 0x7fffu + ((u >> 16) & 1u)) >> 16); }
__device__ __forceinline__ float sigm(float x) { return 1.f / (1.f + expf(-x)); }
__global__ void __launch_bounds__(64) t_retention(const bf16_t* Qt, const bf16_t* Kt, const bf16_t* V, float* yraw) {
    const int w = blockIdx.x, h = w >> 8, dv = w & 255, lane = threadIdx.x;
    const float gamma = 1.0f - exp2f(-5.0f - (float)h), l2g = log2f(gamma);
    float S[4] = {0.f, 0.f, 0.f, 0.f};
    for (int pos = 0; pos < LTOK; ++pos) {
        const int r = pos < NMETA ? SEQ + pos : pos - NMETA, il = pos < NMETA ? 112 + pos : (r & 127);
        const float v = bf2f(V[(size_t)r * RW + h * RD + dv]);
        const float kd = exp2f(-(float)(127 - il) * l2g), qd = exp2f(-(float)(il + 1) * l2g);
        float part = 0.f;
#pragma unroll
        for (int i = 0; i < 4; ++i) {
            const int d = lane + 64 * i;
            const float k = bf2f(Kt[(size_t)r * RW + h * RD + d]) * kd;
            const float q = r < SEQ ? bf2f(Qt[(size_t)r * RW + h * RD + d]) * qd : 0.f;
            S[i] = gamma * S[i] + k * v;
            part += q * S[i];
        }
        part = wave_sum(part);
        if (lane == 0 && r < SEQ) yraw[(size_t)r * RW + h * RD + dv] = part;
    }
}
__global__ void __launch_bounds__(256) t_chunk(const bf16_t* Qt, const bf16_t* Kt, const bf16_t* V, const bf16_t* ST, float* yraw) {
    __shared__ float sc[128];
    __shared__ float qs[256];
    const int xc = blockIdx.x >> 2, h = blockIdx.x & 3, dv = threadIdx.x;
    const float gamma = 1.0f - exp2f(-5.0f - (float)h), ginv = exp2f(-128.0f * log2f(gamma));
    const bf16_t* Sx = ST + (size_t)(xc * 4 + h) * 65536;
    for (int i = 0; i < 128; ++i) {
        const size_t ri = (size_t)xc * 128 + i;
        __syncthreads();
        qs[dv] = bf2f(Qt[ri * RW + h * RD + dv]);
        __syncthreads();
        if (dv < 128) { float s = 0.f; if (dv <= i) { const size_t rj = (size_t)xc * 128 + dv; for (int d = 0; d < 256; ++d) s += qs[d] * bf2f(Kt[rj * RW + h * RD + d]); } sc[dv] = s * ginv; }
        __syncthreads();
        float y = 0.f;
        for (int j = 0; j <= i; ++j) y += sc[j] * bf2f(V[((size_t)xc * 128 + j) * RW + h * RD + dv]);
        for (int d = 0; d < 256; ++d) y += qs[d] * bf2f(Sx[(size_t)dv * 256 + d]);
        yraw[ri * RW + h * RD + dv] = y;
    }
}
__global__ void t_groupnorm(const float* yraw, bf16_t* GY, const float* gn_g) {
    const int w = (blockIdx.x * blockDim.x + threadIdx.x) >> 6, lane = threadIdx.x & 63;
    if (w >= SEQ * RH) return;
    const int r = w >> 2, h = w & 3;
    float v[4], s = 0.f;
#pragma unroll
    for (int i = 0; i < 4; ++i) { v[i] = yraw[(size_t)r * RW + h * RD + lane + 64 * i]; s += v[i]; }
    const float mu = wave_sum(s) / RD;
    float q = 0.f;
#pragma unroll
    for (int i = 0; i < 4; ++i) { v[i] -= mu; q += v[i] * v[i]; }
    const float rs = 1.0f / sqrtf(wave_sum(q) / RD + EPS);
#pragma unroll
    for (int i = 0; i < 4; ++i) { const int c = h * RD + lane + 64 * i; bf16_t* p = GY + (size_t)r * DM + c; *p = f2bf(v[i] * rs * gn_g[c] * bf2f(*p)); }
}
__global__ void __launch_bounds__(256) t_conv(const bf16_t* U, const float* dw_w, const float* dw_b, const float* ln_g, const float* ln_b, bf16_t* CB) {
    __shared__ float red[8];
    const int r = blockIdx.x, pos = r + NMETA, tid = threadIdx.x, lane = tid & 63, wv = tid >> 6;
    float c[4];
#pragma unroll
    for (int i = 0; i < 4; ++i) {
        const int ch = tid + 256 * i;
        float a = dw_b[ch];
        for (int j = 0; j < CK; ++j) { const int p = pos - (CK - 1) + j; if (p >= 0) { const int row = p >= NMETA ? p - NMETA : SEQ + p; a += bf2f(U[(size_t)row * CW + ch]) * dw_w[j * CW + ch]; } }
        c[i] = a;
    }
    float s = wave_sum(c[0] + c[1] + c[2] + c[3]);
    if (lane == 0) red[wv] = s;
    __syncthreads();
    const float mu = (red[0] + red[1] + red[2] + red[3]) / CW;
    float q = 0.f;
#pragma unroll
    for (int i = 0; i < 4; ++i) { c[i] -= mu; q += c[i] * c[i]; }
    q = wave_sum(q);
    if (lane == 0) red[4 + wv] = q;
    __syncthreads();
    const float rs = 1.0f / sqrtf((red[4] + red[5] + red[6] + red[7]) / CW + EPS);
#pragma unroll
    for (int i = 0; i < 4; ++i) { const int ch = tid + 256 * i; const float y = c[i] * rs * ln_g[ch] + ln_b[ch]; CB[(size_t)r * CW + ch] = f2bf(y * sigm(y)); }
}
template <int M, int N, int K, class AL, class EP>
__global__ void __launch_bounds__(256) t_gemm(const float* B, AL al, EP ep) {
    __shared__ float As[16][68];
    __shared__ float Bs[16][68];
    const int tx = threadIdx.x & 15, ty = threadIdx.x >> 4;
    const int m0 = blockIdx.y * 64, n0 = blockIdx.x * 64;
    float acc[4][4];
#pragma unroll
    for (int i = 0; i < 4; ++i)
#pragma unroll
        for (int j = 0; j < 4; ++j) acc[i][j] = 0.f;
    for (int k0 = 0; k0 < K; k0 += 16) {
#pragma unroll
        for (int i = 0; i < 4; ++i) { const int idx = threadIdx.x + i * 256, mm = idx >> 4, kk = idx & 15, m = m0 + mm; As[kk][mm] = (m < M) ? al(m, k0 + kk) : 0.f; }
#pragma unroll
        for (int i = 0; i < 4; ++i) { const int idx = threadIdx.x + i * 256, kk = idx >> 6, nn = idx & 63; Bs[kk][nn] = B[(size_t)(k0 + kk) * N + n0 + nn]; }
        __syncthreads();
#pragma unroll
        for (int kk = 0; kk < 16; ++kk) {
            float a[4], b[4];
#pragma unroll
            for (int i = 0; i < 4; ++i) { a[i] = As[kk][ty * 4 + i]; b[i] = Bs[kk][tx * 4 + i]; }
#pragma unroll
            for (int i = 0; i < 4; ++i)
#pragma unroll
                for (int j = 0; j < 4; ++j) acc[i][j] += a[i] * b[j];
        }
        __syncthreads();
    }
#pragma unroll
    for (int i = 0; i < 4; ++i)
#pragma unroll
        for (int j = 0; j < 4; ++j) { const int m = m0 + ty * 4 + i, n = n0 + tx * 4 + j; if (m < M) ep(m, n, acc[i][j]); }
}
struct AL_CB { const bf16_t* CB; __device__ float operator()(int m, int k) const { return bf2f(CB[(size_t)m * CW + k]); } };
struct EP_PW { bf16_t* GY; const float* pw_b; __device__ void operator()(int m, int n, float v) const { bf16_t* p = GY + (size_t)m * DM + 1024 + n; *p = f2bf((v + pw_b[n]) * bf2f(*p)); } };
struct AL_GY { const bf16_t* GY; __device__ float operator()(int m, int k) const { return bf2f(GY[(size_t)m * DM + k]); } };
struct EP_OUT { float* out; const float* x; __device__ void operator()(int m, int n, float v) const { out[(size_t)m * DM + n] = v + x[(size_t)m * DM + n]; } };
__global__ void t_final(float* out, const float* g) {
    const int w = (blockIdx.x * blockDim.x + threadIdx.x) >> 6, lane = threadIdx.x & 63;
    if (w >= SEQ) return;
    float* r = out + (size_t)w * DM;
    float s = 0.f;
    for (int i = lane; i < DM; i += 64) { const float v = r[i]; s += v * v; }
    const float rs = 1.0f / sqrtf(wave_sum(s) / DM + EPS);
    for (int i = lane; i < DM; i += 64) r[i] = r[i] * rs * g[i];
}
}
#endif

extern "C" void kernel_launch(void* const* d_in, const int* in_sizes, int n_in, void* d_out, int out_size, void* d_ws, size_t ws_size, hipStream_t stream) {
    using namespace mk;
    static int ready = 0;
    if (ready == 0) {
        if (n_in != 13 || out_size != SEQ * DM || ws_size < WS_END) { fprintf(stderr, "kernel_launch: unexpected shapes (n_in %d, out %d, ws %zu)\n", n_in, out_size, ws_size); ready = -1; return; }
        int dev = 0, cus = 0;
        if (hipGetDevice(&dev) != hipSuccess || hipDeviceGetAttribute(&cus, hipDeviceAttributeMultiprocessorCount, dev) != hipSuccess) { ready = -1; return; }
        if (cus < GRID) { fprintf(stderr, "kernel_launch: %d CUs < %d\n", cus, GRID); ready = -1; return; }
        if (hipFuncSetAttribute((const void*)mega, hipFuncAttributeMaxDynamicSharedMemorySize, LDS_BYTES) != hipSuccess) { fprintf(stderr, "kernel_launch: hipFuncSetAttribute failed\n"); ready = -1; return; }
        int per_cu = 0;
        if (hipOccupancyMaxActiveBlocksPerMultiprocessor(&per_cu, (const void*)mega, NTHREADS, LDS_BYTES) != hipSuccess || per_cu < 1) fprintf(stderr, "kernel_launch: occupancy query says %d blocks/CU\n", per_cu);
        (void)hipGetLastError();
        ready = 1;
    }
    if (ready < 0) return;
    (void)hipMemsetAsync((char*)d_ws + WS_CTL, 0, CTL_ZERO_BYTES, stream);
    Args a{};
    for (int i = 0; i < 13; ++i) a.in[i] = (const float*)d_in[i];
    a.out = (float*)d_out; a.ws = (unsigned char*)d_ws;
#if LADDER == 0
#if PROBE_K > 0
    a.ph_lo = 0; a.ph_hi = PROBE_K;
    hipLaunchKernelGGL(mega, dim3(GRID), dim3(NTHREADS), LDS_BYTES, stream, a);
    (void)hipMemsetAsync((char*)d_ws + WS_CTL, 0, CTL_ZERO_BYTES, stream);
#endif
    a.ph_lo = 0; a.ph_hi = 5;
    hipLaunchKernelGGL(mega, dim3(GRID), dim3(NTHREADS), LDS_BYTES, stream, a);
#if PROBE_TAIL > 0
    (void)hipMemsetAsync((char*)d_ws + WS_CTL, 0, CTL_ZERO_BYTES, stream);
    a.ph_lo = PROBE_TAIL; a.ph_hi = 5;
    hipLaunchKernelGGL(mega, dim3(GRID), dim3(NTHREADS), LDS_BYTES, stream, a);
#endif
#else
    using namespace nt;
    unsigned char* ws = (unsigned char*)d_ws;
    bf16_t *Qt = (bf16_t*)(ws + WS_QT), *Kt = (bf16_t*)(ws + WS_KT), *V = (bf16_t*)(ws + WS_V), *U = (bf16_t*)(ws + WS_U), *GY = (bf16_t*)(ws + WS_GY), *CB = (bf16_t*)(ws + WS_CB), *ST = (bf16_t*)(ws + WS_ST);
    const float *x = a.in[0], *gn_g = a.in[4], *dw_w = a.in[5], *dw_b = a.in[6], *cln_g = a.in[7], *cln_b = a.in[8], *pw_w = a.in[9], *pw_b = a.in[10], *w_out = a.in[11], *final_g = a.in[12];
    float* out = (float*)d_out; float* yraw = (float*)d_out;
    a.ph_lo = 0; a.ph_hi = (LADDER == 1 ? 2 : LADDER == 2 ? 3 : 4);
    hipLaunchKernelGGL(mega, dim3(GRID), dim3(NTHREADS), LDS_BYTES, stream, a);
#if LADDER == 1
    t_retention<<<RH * RD, 64, 0, stream>>>(Qt, Kt, V, yraw);
    t_groupnorm<<<(SEQ * RH * 64 + 255) / 256, 256, 0, stream>>>(yraw, GY, gn_g);
    t_conv<<<SEQ, 256, 0, stream>>>(U, dw_w, dw_b, cln_g, cln_b, CB);
    t_gemm<SEQ, CW, CW><<<dim3(CW / 64, SEQ / 64), 256, 0, stream>>>(pw_w, AL_CB{CB}, EP_PW{GY, pw_b});
#elif LADDER == 2
    t_chunk<<<64 * 4, 256, 0, stream>>>(Qt, Kt, V, ST, yraw);
    t_groupnorm<<<(SEQ * RH * 64 + 255) / 256, 256, 0, stream>>>(yraw, GY, gn_g);
#endif
    t_gemm<SEQ, DM, DM><<<dim3(DM / 64, SEQ / 64), 256, 0, stream>>>(w_out, AL_GY{GY}, EP_OUT{out, x});
    t_final<<<(SEQ * 64 + 255) / 256, 256, 0, stream>>>(out, final_g);
#endif
}
```

```cpp
#include <hip/hip_runtime.h>
#include <cstdio>
#include <cstdint>
namespace pg8 {
#define PG8_LAS __attribute__((address_space(3)))
typedef unsigned short bf16_t;
typedef short bf16x8 __attribute__((ext_vector_type(8)));
typedef float f32x4 __attribute__((ext_vector_type(4)));
typedef unsigned u32x4 __attribute__((ext_vector_type(4)));
constexpr int BM = 256, BK = 64, HALF = 128, HTB = HALF * BK * 2  , STAGE_BYTES = 8 * HTB, NXCD = 8, WGM = 8;

__host__ __device__ __forceinline__ int lds_byte(int r, int c) { const int st = (r >> 4) * 2 + (c >> 5), rr = r & 15, cc = c & 31, ob = rr * 64 + cc * 2; return st * 1024 + (ob ^ (((ob >> 9) & 1) << 5)); }
__host__ __device__ __forceinline__ void stage_rc(int b, int& R, int& C) { const int st = b / 1024, sb = b % 1024, swz = sb ^ (((sb >> 9) & 1) << 5); R = (st >> 1) * 16 + swz / 64; C = (st & 1) * 32 + (swz % 64) / 2; }
__host__ __device__ __forceinline__ int perm32(int rho) { const int n = rho >> 4, i = rho & 15; return 8 * (i >> 2) + 4 * n + (i & 3); }

struct Unit { int pm, pn; };
struct Gemm { const bf16_t* A; const bf16_t* Bt; int M, N, K; };

__device__ __forceinline__ unsigned cvt_pk_bf16(float lo, float hi) { unsigned r; asm volatile("v_cvt_pk_bf16_f32 %0, %1, %2" : "=v"(r) : "v"(lo), "v"(hi)); return r; }
typedef float f32x2 __attribute__((ext_vector_type(2)));
template <class Epi, class Sched, bool ALIGN_EPI = false, bool SP2 = false>
__device__ __forceinline__ void gemm_phase(PG8_LAS unsigned char* lds, const Gemm g, const Sched& S, const Epi& E) {
    int tid = threadIdx.x; asm volatile("" : "+v"(tid));
    const int wid = __builtin_amdgcn_readfirstlane(tid >> 6), lane = tid & 63, wr = wid >> 2, wc = wid & 3, fr = lane & 15, fq = lane >> 4;
    const int K = g.K, nt = K / BK;
    unsigned voffA[2], voffB[2];
#pragma unroll
    for (int i = 0; i < 2; ++i) { int R, C; stage_rc(tid * 16 + i * 8192, R, C); const int Rb = Epi::PERM ? ((R & ~31) + perm32(R & 31)) : R;
        voffA[i] = (unsigned)(R * K + C) * 2u; voffB[i] = (unsigned)(Rb * K + C) * 2u; }
    const size_t kstep = (size_t)(BK * 2);
    const size_t hstep = (size_t)HALF * K * 2;
    const size_t tstep = 2 * hstep;
    const unsigned ldsw = (unsigned)wid * 1024u;
    const int aoff = lds_byte(wr * 64 + fr, fq * 8), boff = lds_byte(wc * 32 + fr, fq * 8);
#define PG8_SA(b, h) (((b) * 2 + (h)) * HTB)
#define PG8_SB(b, h) ((4 + (b) * 2 + (h)) * HTB)
#define PG8_STAGE(bufoff, gbase, voff) do { _Pragma("unroll") for (int _i = 0; _i < 2; ++_i) \
        __builtin_amdgcn_global_load_lds((const unsigned*)((const char*)(gbase) + (voff)[_i]), (PG8_LAS unsigned*)(lds + (bufoff) + ldsw + _i * 8192), 16, 0, 0); } while (0)
#define PG8_LDA(dst, b, h) do { _Pragma("unroll") for (int m = 0; m < 4; ++m) _Pragma("unroll") for (int k = 0; k < 2; ++k) dst[m][k] = *(const PG8_LAS bf16x8*)(lds + PG8_SA(b, h) + aoff + m * 2048 + k * 1024); } while (0)
#define PG8_LDB(dst, b, h) do { _Pragma("unroll") for (int n = 0; n < 2; ++n) _Pragma("unroll") for (int k = 0; k < 2; ++k) dst[n][k] = *(const PG8_LAS bf16x8*)(lds + PG8_SB(b, h) + boff + n * 2048 + k * 1024); } while (0)
#define PG8_MMA(ai, bj, At, Bt) do { __builtin_amdgcn_s_setprio(1); _Pragma("unroll") for (int m = 0; m < 4; ++m) _Pragma("unroll") for (int n = 0; n < 2; ++n) _Pragma("unroll") for (int k = 0; k < 2; ++k) \
        acc[ai][bj][m][n] = __builtin_amdgcn_mfma_f32_16x16x32_bf16(Bt[n][k], At[m][k], acc[ai][bj][m][n], 0, 0, 0); __builtin_amdgcn_s_setprio(0); } while (0)
#define PG8_WAIT_V(n) asm volatile("s_waitcnt vmcnt(" #n ")" ::: "memory")
#define PG8_WAIT_L(n) asm volatile("s_waitcnt lgkmcnt(" #n ")" ::: "memory")
#define PG8_BAR __builtin_amdgcn_s_barrier()
#define PG8_SCHED __builtin_amdgcn_sched_barrier(0)
    Unit cur, nxt; int ui = 0;
    if (!S.next(0, cur)) return;
    f32x4 acc[2][2][4][2];
    if constexpr (Epi::INIT) E.init(acc, cur, wr, wc, fr, fq);
    else {
#pragma unroll
    for (int a = 0; a < 2; ++a)
#pragma unroll
        for (int b = 0; b < 2; ++b)
#pragma unroll
            for (int m = 0; m < 4; ++m)
#pragma unroll
                for (int n = 0; n < 2; ++n) acc[a][b][m][n] = (f32x4){0.f, 0.f, 0.f, 0.f};
    }
    bf16x8 At[4][2], B0[2][2], B1[2][2];
    const char* cA = (const char*)g.A + (size_t)cur.pm * tstep; const char* cB = (const char*)g.Bt + (size_t)cur.pn * tstep;
    S.a_ready(cur);
    if constexpr (SP2) {
        PG8_STAGE(PG8_SB(0, 0), cB, voffB); PG8_STAGE(PG8_SB(0, 1), cB + hstep, voffB); PG8_STAGE(PG8_SA(0, 0), cA, voffA); PG8_STAGE(PG8_SA(0, 1), cA + hstep, voffA);
        if (wr == 1) PG8_BAR;
        PG8_WAIT_V(2); PG8_BAR;
        PG8_STAGE(PG8_SB(1, 0), cB + kstep, voffB); PG8_STAGE(PG8_SA(1, 0), cA + kstep, voffA); PG8_STAGE(PG8_SB(1, 1), cB + hstep + kstep, voffB);
        PG8_WAIT_V(6); PG8_BAR;
    } else {
        PG8_STAGE(PG8_SB(0, 0), cB, voffB); PG8_STAGE(PG8_SA(0, 0), cA, voffA); PG8_STAGE(PG8_SB(0, 1), cB + hstep, voffB); PG8_STAGE(PG8_SA(0, 1), cA + hstep, voffA);
        if (wr == 1) PG8_BAR;
        PG8_WAIT_V(4); PG8_BAR;
        PG8_STAGE(PG8_SB(1, 0), cB + kstep, voffB); PG8_STAGE(PG8_SA(1, 0), cA + kstep, voffA); PG8_STAGE(PG8_SB(1, 1), cB + hstep + kstep, voffB);
        PG8_WAIT_V(6); PG8_BAR;
    }
    for (;;) {
        const bool has_next = S.next(ui + 1, nxt);
        const char* nA = has_next ? (const char*)g.A + (size_t)nxt.pm * tstep : cA; const char* nB = has_next ? (const char*)g.Bt + (size_t)nxt.pn * tstep : cB;
        for (int t = 0; t < nt; t += 2) {
            const bool last = (t == nt - 2);
            const char* a1 = cA + (size_t)(t + 1) * kstep;
            const char* a2 = last ? nA : cA + (size_t)(t + 2) * kstep; const char* b2 = last ? nB : cB + (size_t)(t + 2) * kstep;
            const char* a3 = a2 + kstep; const char* b3 = b2 + kstep;
            if (last && has_next) S.a_ready(nxt);
            if constexpr (SP2) {
            PG8_LDB(B0, 0, 0); PG8_LDB(B1, 0, 1); PG8_SCHED; PG8_LDA(At, 0, 0); PG8_STAGE(PG8_SA(1, 1), a1 + hstep, voffA);
            PG8_WAIT_V(8); PG8_WAIT_L(0); PG8_BAR; PG8_MMA(0, 0, At, B0); PG8_MMA(0, 1, At, B1); PG8_BAR; PG8_SCHED;
            PG8_LDA(At, 0, 1); PG8_STAGE(PG8_SB(0, 0), b2, voffB); PG8_STAGE(PG8_SB(0, 1), b2 + hstep, voffB); PG8_STAGE(PG8_SA(0, 0), a2, voffA);
            PG8_WAIT_V(8); PG8_WAIT_L(0); PG8_BAR; PG8_MMA(1, 0, At, B0); PG8_MMA(1, 1, At, B1); PG8_BAR; PG8_SCHED;
            PG8_LDB(B0, 1, 0); PG8_LDB(B1, 1, 1); PG8_SCHED; PG8_LDA(At, 1, 0); PG8_STAGE(PG8_SA(0, 1), a2 + hstep, voffA);
            PG8_WAIT_V(8); PG8_WAIT_L(0); PG8_BAR; PG8_MMA(0, 0, At, B0); PG8_MMA(0, 1, At, B1); PG8_BAR; PG8_SCHED;
            PG8_LDA(At, 1, 1); PG8_STAGE(PG8_SB(1, 0), b3, voffB); PG8_STAGE(PG8_SB(1, 1), b3 + hstep, voffB); PG8_STAGE(PG8_SA(1, 0), a3, voffA);
            PG8_WAIT_V(8); PG8_WAIT_L(0); PG8_BAR; PG8_MMA(1, 0, At, B0); PG8_MMA(1, 1, At, B1); PG8_BAR; PG8_SCHED;
            } else {
            PG8_LDB(B0, 0, 0); PG8_SCHED; PG8_LDA(At, 0, 0); PG8_STAGE(PG8_SA(1, 1), a1 + hstep, voffA);
            PG8_WAIT_L(8); PG8_BAR; PG8_WAIT_L(0); PG8_MMA(0, 0, At, B0); PG8_BAR; PG8_SCHED;
            PG8_LDB(B1, 0, 1); PG8_STAGE(PG8_SB(0, 0), b2, voffB);
            PG8_BAR; PG8_WAIT_L(0); PG8_MMA(0, 1, At, B1); PG8_BAR;
            PG8_LDA(At, 0, 1); PG8_STAGE(PG8_SA(0, 0), a2, voffA);
            PG8_BAR; PG8_WAIT_L(0); PG8_MMA(1, 0, At, B0); PG8_BAR; PG8_SCHED;
            PG8_STAGE(PG8_SB(0, 1), b2 + hstep, voffB);
            PG8_WAIT_V(6); PG8_BAR; PG8_MMA(1, 1, At, B1); PG8_BAR;
            PG8_LDB(B0, 1, 0); PG8_SCHED; PG8_LDA(At, 1, 0); PG8_STAGE(PG8_SA(0, 1), a2 + hstep, voffA);
            PG8_WAIT_L(8); PG8_BAR; PG8_WAIT_L(0); PG8_MMA(0, 0, At, B0); PG8_BAR; PG8_SCHED;
            PG8_LDB(B1, 1, 1); PG8_STAGE(PG8_SB(1, 0), b3, voffB);
            PG8_BAR; PG8_WAIT_L(0); PG8_MMA(0, 1, At, B1); PG8_BAR;
            PG8_LDA(At, 1, 1); PG8_STAGE(PG8_SA(1, 0), a3, voffA);
            PG8_BAR; PG8_WAIT_L(0); PG8_MMA(1, 0, At, B0); PG8_BAR; PG8_SCHED;
            PG8_STAGE(PG8_SB(1, 1), b3 + hstep, voffB);
            PG8_WAIT_V(6); PG8_BAR; PG8_MMA(1, 1, At, B1); PG8_BAR;
            }
        }
        if constexpr (ALIGN_EPI) { if (wr == 0) PG8_BAR; }
        if constexpr (!Epi::AFTER_DRAIN) { E(acc, cur, wr, wc, fr, fq); S.done(cur); }
        if (!has_next) break;
#pragma unroll
        for (int a = 0; a < 2; ++a)
#pragma unroll
            for (int b = 0; b < 2; ++b)
#pragma unroll
                for (int m = 0; m < 4; ++m)
#pragma unroll
                    for (int n = 0; n < 2; ++n) acc[a][b][m][n] = (f32x4){0.f, 0.f, 0.f, 0.f};
        cur = nxt; cA = nA; cB = nB; ++ui;
        if constexpr (ALIGN_EPI) { if (wr == 1) PG8_BAR; }
    }
    PG8_WAIT_V(0);
    if constexpr (!ALIGN_EPI) { if (wr == 0) PG8_BAR; }
    PG8_BAR;
    if constexpr (Epi::AFTER_DRAIN) { E.fused(acc, cur, wr, wc, fr, fq, lds, wid, lane); S.done(cur); }
#undef PG8_SA
#undef PG8_SB
#undef PG8_STAGE
#undef PG8_LDA
#undef PG8_LDB
#undef PG8_MMA
#undef PG8_WAIT_V
#undef PG8_WAIT_L
#undef PG8_BAR
#undef PG8_SCHED
}
}

namespace mk {
using pg8::bf16_t; using pg8::bf16x8; using pg8::f32x4; using pg8::u32x4; using pg8::Unit;
#define LAS __attribute__((address_space(3)))
typedef float f32x16 __attribute__((ext_vector_type(16)));
typedef float f32x2 __attribute__((ext_vector_type(2)));
typedef float f32x2_ __attribute__((ext_vector_type(2)));
typedef short s16x4 __attribute__((ext_vector_type(4)));
typedef unsigned u32x2 __attribute__((ext_vector_type(2)));
typedef __bf16 bf16x2_t __attribute__((ext_vector_type(2)));
__device__ __forceinline__ unsigned cvt_pk_bf16(float lo, float hi) { const f32x2_ v = {lo, hi}; return __builtin_bit_cast(unsigned, __builtin_convertvector(v, bf16x2_t)); }

constexpr int DM = 2048, SEQ = 8192, NMETA = 16, LTOK = SEQ + NMETA, MPAD = 8448;
constexpr int RW = 1024, RH = 4, RD = 256, CW = 1024, CK = 31, INW = 7168;
constexpr float EPS = 1e-6f;
constexpr int NTHREADS = 512, GRID = 256;
constexpr size_t MiB = 1u << 20;
constexpr size_t WS_CTL = 0, CTL_ZERO_BYTES = 1 * MiB;
constexpr size_t WS_RSTD = 1 * MiB;
constexpr size_t WS_PSUM = 1 * MiB + 64 * 1024;
constexpr size_t WS_WOUT = 2 * MiB;
constexpr size_t WS_WPW = 10 * MiB;
constexpr size_t WS_WIN = 12 * MiB;
constexpr size_t WS_HB = 40 * MiB;
constexpr size_t WS_COS = 73 * MiB;
constexpr size_t WS_SIN = 77 * MiB + 256 * 1024;
constexpr size_t WS_QT = 82 * MiB;
constexpr size_t WS_KT = 98 * MiB;
constexpr size_t WS_V = 115 * MiB;
constexpr size_t WS_U = 132 * MiB;
constexpr size_t WS_GY = 149 * MiB;
constexpr size_t WS_CB = 181 * MiB;
constexpr size_t WS_ST = 197 * MiB;
constexpr size_t WS_END = 229 * MiB;
static_assert(WS_COS + (size_t)LTOK * 128 * 4 <= WS_SIN && WS_SIN + (size_t)LTOK * 128 * 4 <= WS_QT && WS_HB + (size_t)MPAD * DM * 2 <= WS_COS, "ws map");
__device__ __forceinline__ bf16_t* kvt_tile(unsigned char* ws, int t) { return (bf16_t*)(ws + WS_ST + (size_t)t * 131072); }
constexpr int CW_BAR = 4096;
constexpr int CW_YR = 14656;
constexpr int CW_PANEL = 12544;
constexpr int CW_CONV = 8448, CW_GC = 10496;
constexpr int CW_MID = 8192, CW_META = 8256, CW_Q = 8320;
constexpr int LDS_MAIN = 147456, MISC_OFF = LDS_MAIN, LDS_BYTES = LDS_MAIN + 1024;

__device__ __constant__ const float kLog2G[4] = {-0.045803689613124755f, -0.022720076500083796f, -0.011315313227834148f, -0.005646563141142062f};

#define LDS_WAIT() asm volatile("s_waitcnt lgkmcnt(0)" ::: "memory")
#define MFMA32(a, b, c) __builtin_amdgcn_mfma_f32_32x32x16_bf16((a), (b), (c), 0, 0, 0)
template <int CTRL> __device__ __forceinline__ float dpp_mov(float x) { return __builtin_bit_cast(float, __builtin_amdgcn_update_dpp(0, __builtin_bit_cast(int, x), CTRL, 0xF, 0xF, true)); }
__device__ __forceinline__ float sum16(float x) { x += dpp_mov<0xB1>(x); x += dpp_mov<0x4E>(x); x += dpp_mov<0x141>(x); x += dpp_mov<0x140>(x); return x; }
__device__ __forceinline__ float sum32(float x) { x = sum16(x); x += __builtin_bit_cast(float, __builtin_amdgcn_ds_swizzle(__builtin_bit_cast(int, x), 0x401F)); return x; }
__device__ __forceinline__ float wave_sum(float v) { v = sum32(v); return v + __shfl_xor(v, 32); }
__device__ __forceinline__ float sigmoid_f(float x) { return __builtin_amdgcn_rcpf(1.0f + __expf(-x)); }
__device__ __forceinline__ float silu_f(float x) { return x * sigmoid_f(x); }
__device__ __forceinline__ float bf_lo(unsigned w) { return __uint_as_float(w << 16); }
__device__ __forceinline__ float bf_hi(unsigned w) { return __uint_as_float(w & 0xffff0000u); }
__device__ __forceinline__ u32x4 pack8(const f32x4 a, const f32x4 b) { u32x4 w; w.x = cvt_pk_bf16(a[0], a[1]); w.y = cvt_pk_bf16(a[2], a[3]); w.z = cvt_pk_bf16(b[0], b[1]); w.w = cvt_pk_bf16(b[2], b[3]); return w; }
__device__ __forceinline__ void st8_sc1(void* p, u32x2 v) { asm volatile("global_store_dwordx2 %0, %1, off sc1\n\ts_nop 1" :: "v"(p), "v"(v) : "memory"); }
__device__ __forceinline__ void st16_sc1(void* p, u32x4 v) { asm volatile("global_store_dwordx4 %0, %1, off sc1\n\ts_nop 1" :: "v"(p), "v"(v) : "memory"); }
__device__ __forceinline__ int crow(int reg, int hh) { return (reg & 3) + 8 * (reg >> 2) + 4 * hh; }
__device__ __forceinline__ s16x4 tr_read(LAS unsigned char* p) { return __builtin_amdgcn_ds_read_tr16_b64_v4i16((LAS s16x4*)p); }

#define XB_TMO      128
#define XB_XCNT(j)  (256  + 64 * (j))
#define XB_XSUB(j)  (1280 + 64 * (j))
#define XB_XGEN(j)  (2304 + 64 * (j))
#define XB_TOP      3328
#define XB_TOPGEN   3392
#define XCD_BAR_WORDS 3456
#define XB_SPIN_CAP (1u << 18)
__device__ __forceinline__ unsigned xb_ld(unsigned* p)              { return __hip_atomic_load(p, __ATOMIC_RELAXED, __HIP_MEMORY_SCOPE_AGENT); }
__device__ __forceinline__ unsigned xb_add(unsigned* p, unsigned v) { return __hip_atomic_fetch_add(p, v, __ATOMIC_RELAXED, __HIP_MEMORY_SCOPE_AGENT); }
__device__ __forceinline__ unsigned xb_xcc_id() { return (unsigned)__builtin_amdgcn_s_getreg((3 << 11) | 20) & 0xFu; }
#define XB_SPIN(cond, bar) do { unsigned _sp = 0; while (cond) { __builtin_amdgcn_s_sleep(1); \
    if ((++_sp & 255u) == 0u) { if (xb_ld(&(bar)[XB_TMO])) break; if (_sp > XB_SPIN_CAP) { atomicAdd(&(bar)[XB_TMO], 1u); break; } } } } while (0)
struct XcdBarrier { unsigned* bar; unsigned x; volatile LAS unsigned* st; };
__device__ __forceinline__ XcdBarrier xcd_barrier_post(unsigned* bar, volatile LAS unsigned* st) {
    XcdBarrier b; b.bar = bar; b.x = xb_xcc_id(); b.st = st;
    if (threadIdx.x == 0) (void)xb_add(&bar[XB_XCNT(b.x)], 1u);
    return b;
}
__device__ __forceinline__ void xcd_barrier_complete(unsigned* bar, unsigned x, unsigned& nloc, unsigned& nx) {
    const unsigned G = gridDim.x * gridDim.y * gridDim.z;
    unsigned sum, cnt, mine, sp = 0u;
    for (;;) {
        sum = 0u; cnt = 0u; mine = 0u;
#pragma unroll
        for (unsigned j = 0; j < 16; ++j) { const unsigned c = xb_ld(&bar[XB_XCNT(j)]); sum += c; cnt += (c > 0u) ? 1u : 0u; mine = (j == x) ? c : mine; }
        if (sum == G) break;
        __builtin_amdgcn_s_sleep(1);
        if ((++sp & 255u) == 0u) { if (xb_ld(&bar[XB_TMO])) break; if (sp > XB_SPIN_CAP) { atomicAdd(&bar[XB_TMO], 1u); break; } }
    }
    nloc = mine > 0u ? mine : 1u; nx = cnt > 0u ? cnt : 1u;
}
__device__ __forceinline__ void xcd_barrier(const XcdBarrier& b) {
    asm volatile("s_waitcnt vmcnt(0)" ::: "memory");
    __syncthreads();
    if (threadIdx.x == 0) {
        unsigned* bar = b.bar;
        __builtin_amdgcn_s_waitcnt(0);
        unsigned nloc = b.st[0], nx = b.st[1];
        if (nloc == 0u) { xcd_barrier_complete(bar, b.x, nloc, nx); b.st[0] = nloc; b.st[1] = nx; }
        const unsigned old = xb_add(&bar[XB_XSUB(b.x)], 1u);
        const unsigned gen = old / nloc;
        if (old + 1u == (gen + 1u) * nloc) {
            __builtin_amdgcn_fence(__ATOMIC_RELEASE, "agent");
            asm volatile("s_waitcnt vmcnt(0)" ::: "memory");
            const unsigned og = xb_add(&bar[XB_TOP], 1u);
            const unsigned tg = og / nx;
            if (og + 1u == (tg + 1u) * nx) xb_add(&bar[XB_TOPGEN], 1u);
            else XB_SPIN(xb_ld(&bar[XB_TOPGEN]) == tg, bar);
            __builtin_amdgcn_fence(__ATOMIC_ACQUIRE, "agent");
            xb_add(&bar[XB_XGEN(b.x)], 1u);
            asm volatile("s_waitcnt vmcnt(0)" ::: "memory");
        } else {
            XB_SPIN(xb_ld(&bar[XB_XGEN(b.x)]) == gen, bar);
            __builtin_amdgcn_fence(__ATOMIC_ACQUIRE, "agent");
            asm volatile("s_waitcnt vmcnt(0)" ::: "memory");
        }
    }
    __syncthreads();
}

__device__ __forceinline__ void xcd_barrier_arrive(const XcdBarrier& b, unsigned& tok, unsigned& tok2) {
    asm volatile("s_waitcnt vmcnt(0)" ::: "memory");
    __syncthreads();
    tok = 0u; tok2 = 0u;
    if (threadIdx.x == 0) {
        unsigned* bar = b.bar;
        __builtin_amdgcn_s_waitcnt(0);
        unsigned nloc = b.st[0], nx = b.st[1];
        if (nloc == 0u) { xcd_barrier_complete(bar, b.x, nloc, nx); b.st[0] = nloc; b.st[1] = nx; }
        const unsigned old = xb_add(&bar[XB_XSUB(b.x)], 1u);
        const unsigned gen = old / nloc;
        tok = gen & 0x3FFFFFFFu;
        if (old + 1u == (gen + 1u) * nloc) {
            __builtin_amdgcn_fence(__ATOMIC_RELEASE, "agent");
            asm volatile("s_waitcnt vmcnt(0)" ::: "memory");
            const unsigned og = xb_add(&bar[XB_TOP], 1u);
            const unsigned tg = og / nx;
            tok |= 1u << 30; tok2 = tg;
            if (og + 1u == (tg + 1u) * nx) { xb_add(&bar[XB_TOPGEN], 1u); tok |= 1u << 31; }
        }
    }
}
__device__ __forceinline__ void xcd_barrier_wait_t0(const XcdBarrier& b, unsigned tok, unsigned tok2) {
    unsigned* bar = b.bar;
    const unsigned gen = tok & 0x3FFFFFFFu;
    if (tok & (1u << 30)) {
        if (!(tok & (1u << 31))) XB_SPIN(xb_ld(&bar[XB_TOPGEN]) == tok2, bar);
        __builtin_amdgcn_fence(__ATOMIC_ACQUIRE, "agent");
        xb_add(&bar[XB_XGEN(b.x)], 1u);
        asm volatile("s_waitcnt vmcnt(0)" ::: "memory");
    } else {
        XB_SPIN(xb_ld(&bar[XB_XGEN(b.x)]) == gen, bar);
        __builtin_amdgcn_fence(__ATOMIC_ACQUIRE, "agent");
        asm volatile("s_waitcnt vmcnt(0)" ::: "memory");
    }
}

__host__ __device__ __forceinline__ int win_src_col(int nd) {
    if (nd < 4096 || nd >= 6144) return nd;
    const int t = (nd - 4096) >> 8, jj = (nd - 4096) & 255;
    return jj < 128 ? 4096 + 128 * t + jj : 5120 + 128 * t + (jj - 128);
}
__device__ __forceinline__ void p0_transpose_item(const float* __restrict__ W, int K, int N, bf16_t* __restrict__ WT, LAS float* scr, int kb, int n_src0, int n_dst0, int lane) {
    const int k0 = 64 * kb;
    float w[32];
#pragma unroll
    for (int i = 0; i < 32; ++i) w[i] = __builtin_nontemporal_load(W + (size_t)(k0 + 2 * i + (lane >> 5)) * N + n_src0 + (lane & 31));
#pragma unroll
    for (int i = 0; i < 32; ++i) scr[(2 * i + (lane >> 5)) * 33 + (lane & 31)] = w[i];
    LDS_WAIT(); asm volatile("" ::: "memory");
    const int c = lane & 7;
#pragma unroll
    for (int j = 0; j < 4; ++j) { const int n = (lane >> 3) + 8 * j; const LAS float* s = scr + (8 * c) * 33 + n;
        u32x4 o; o.x = cvt_pk_bf16(s[0 * 33], s[1 * 33]); o.y = cvt_pk_bf16(s[2 * 33], s[3 * 33]); o.z = cvt_pk_bf16(s[4 * 33], s[5 * 33]); o.w = cvt_pk_bf16(s[6 * 33], s[7 * 33]);
        st16_sc1(WT + (size_t)(n_dst0 + n) * K + k0 + 8 * c, o); }
    LDS_WAIT(); asm volatile("" ::: "memory");
}
__device__ __forceinline__ void p0_row(const float* __restrict__ src, bf16_t* __restrict__ dst, float* rstd_out, const f32x4 (&g)[8], int lane) {
    f32x4 v[8]; float s = 0.f;
#pragma unroll
    for (int j = 0; j < 8; ++j) v[j] = src ? __builtin_nontemporal_load((const f32x4*)src + lane + 64 * j) : (f32x4){0.f, 0.f, 0.f, 0.f};
#pragma unroll
    for (int j = 0; j < 8; ++j) s += (v[j][0] * v[j][0] + v[j][1] * v[j][1]) + (v[j][2] * v[j][2] + v[j][3] * v[j][3]);
    s = wave_sum(s);
    const float rs = src ? 1.0f / sqrtf(s * (1.0f / DM) + EPS) : 0.f;
    if (lane == 0) *rstd_out = rs;
#pragma unroll
    for (int j = 0; j < 8; ++j) { const f32x4 y = v[j] * g[j] * rs; u32x2 o; o.x = cvt_pk_bf16(y[0], y[1]); o.y = cvt_pk_bf16(y[2], y[3]); st8_sc1((u32x2*)dst + lane + 64 * j, o); }
}
__device__ __forceinline__ void p0_prologue(LAS unsigned char* lds, const float* x, const float* meta, const float* ln_g, const float* w_in, const float* pw_w, const float* w_out,
                                            unsigned char* ws, int b, int tid, int wid, int lane) {
    LAS float* scr = (LAS float*)(lds + wid * 16384);
    const int gw = b * 8 + wid, NGW = GRID * 8;
    bf16_t* Win = (bf16_t*)(ws + WS_WIN); bf16_t* Wout = (bf16_t*)(ws + WS_WOUT); bf16_t* Wpw = (bf16_t*)(ws + WS_WPW);
    constexpr int I_IN = 32 * 224, I_OUT = 32 * 64, I_PW = 16 * 32;
    for (int it = gw; it < I_IN + I_OUT + I_PW; it += NGW) {
        int r = it;
        if (r < I_IN) { const int kb = r / 224, nb = r % 224; p0_transpose_item(w_in, DM, INW, Win, scr, kb, win_src_col(32 * nb), 32 * nb, lane); continue; } r -= I_IN;
        if (r < I_OUT) { const int kb = r / 64, nb = r % 64; p0_transpose_item(w_out, DM, DM, Wout, scr, kb, 32 * nb, 32 * nb, lane); continue; } r -= I_OUT;
        { const int kb = r / 32, nb = r % 32; p0_transpose_item(pw_w, CW, CW, Wpw, scr, kb, 32 * nb, 32 * nb, lane); }
    }
    bf16_t* HB = (bf16_t*)(ws + WS_HB); float* rstd = (float*)(ws + WS_RSTD);
    f32x4 gl[8];
#pragma unroll
    for (int j = 0; j < 8; ++j) gl[j] = ((const f32x4*)ln_g)[lane + 64 * j];
    for (int r = gw; r < MPAD; r += NGW) {
        const float* src = r < SEQ ? x + (size_t)r * DM : (r < LTOK ? meta + (size_t)(r - SEQ) * DM : nullptr);
        p0_row(src, HB + (size_t)r * DM, rstd + r, gl, lane);
    }
    float* cosT = (float*)(ws + WS_COS); float* sinT = (float*)(ws + WS_SIN);
    const int gid = b * NTHREADS + tid, i = gid & 127;
    const double inv = exp2(-(double)i * 0.10381025296523007);
    for (int pos = gid >> 7; pos < LTOK; pos += (GRID * NTHREADS) >> 7) {
        const double a = (double)pos * inv;
        const double n = rint(a * 0.15915494309189535);
        const float rr = (float)fma(-n, 6.283185307179586, a);
        float sn, cs; sincosf(rr, &sn, &cs);
        cosT[(size_t)pos * 128 + i] = cs; sinT[(size_t)pos * 128 + i] = sn;
    }
}

__device__ __forceinline__ void wait_count(unsigned* p, unsigned want) {
    unsigned sp = 0;
    while (__hip_atomic_load(p, __ATOMIC_RELAXED, __HIP_MEMORY_SCOPE_AGENT) < want) { __builtin_amdgcn_s_sleep(2); if (++sp > (1u << 20)) break; }
}
struct Sched1 { int c; unsigned* ctl;
    __device__ __forceinline__ bool next(int i, Unit& u) const {
        const int L = i * GRID + c;
        if (L < 896) { const int xcd = L & 7, off = L >> 3, wg = xcd * 112 + off, gid = wg / 224, rem = wg % 224; u.pm = gid * 8 + (rem & 7); u.pn = rem >> 3; return true; }
        if (L < 912) { const int t = L - 896; u.pm = 32; u.pn = t < 8 ? 4 + t : 8 + t; return true; }
        return false;
    }
    __device__ __forceinline__ void a_ready(const Unit&) const {}
    __device__ __forceinline__ void done(const Unit& u) const {
        Unit t3; (void)next(2, t3);
        const bool third = (u.pm == t3.pm && u.pn == t3.pn), meta = (u.pm == 32), gc = (u.pn >= 24);
        if (third || meta || gc) {
            asm volatile("s_waitcnt vmcnt(0)" ::: "memory");
            __syncthreads();
            if (threadIdx.x == 0) {
                if (third || meta) __hip_atomic_fetch_add(ctl + (meta ? CW_META : CW_MID), 1u, __ATOMIC_RELAXED, __HIP_MEMORY_SCOPE_AGENT);
                if (gc) __hip_atomic_fetch_add(ctl + CW_GC + 64 * u.pm, 1u, __ATOMIC_RELAXED, __HIP_MEMORY_SCOPE_AGENT);
            }
        }
    }
};
struct Epi1 {
    static constexpr bool PERM = true, AFTER_DRAIN = false, INIT = false;
    bf16_t *Qt, *Kt, *V, *U, *GY; const float *rstd, *cosT, *sinT;
    __device__ __forceinline__ void operator()(const f32x4 (&acc)[2][2][4][2], const Unit& u, int wr, int wc, int fr, int fq) const {
        const int pn = u.pn; const bool meta = (u.pm == 32);
        if (meta && wr != 0) return;
        const int cl = wc * 32 + 8 * fq;
#pragma unroll
        for (int ai = 0; ai < 2; ++ai)
#pragma unroll
            for (int m = 0; m < 4; ++m) {
                if (meta && (ai | m)) continue;
                const int r = u.pm * 256 + ai * 128 + wr * 64 + m * 16 + fr;
                if (pn < 8) {
                    const int head = pn & 3; const bool isk = pn >= 4;
                    const int pos = meta ? (r - SEQ) : (r + NMETA);
                    const int il = meta ? (112 + r - SEQ) : (r & 127);
                    const float l2g = kLog2G[head];
                    const float dec = isk ? 0.0625f * exp2f((float)(127 - il) * l2g) : exp2f((float)(il + 1) * l2g);
                    const f32x4* cp = (const f32x4*)(cosT + (size_t)pos * 128 + cl); const f32x4* sp = (const f32x4*)(sinT + (size_t)pos * 128 + cl);
                    f32x4 o1[2], o2[2];
#pragma unroll
                    for (int n = 0; n < 2; ++n) { const f32x4 c = cp[n], s = sp[n], x1 = acc[ai][0][m][n], x2 = acc[ai][1][m][n];
                        o1[n] = (x1 * c - x2 * s) * dec; o2[n] = (x1 * s + x2 * c) * dec; }
                    bf16_t* dst = (isk ? Kt : Qt) + (size_t)r * RW + head * 256 + cl;
                    if (isk) { st16_sc1(dst, pack8(o1[0], o1[1])); st16_sc1(dst + 128, pack8(o2[0], o2[1])); }
                    else { *(u32x4*)dst = pack8(o1[0], o1[1]); *(u32x4*)(dst + 128) = pack8(o2[0], o2[1]); }
                } else if (pn < 12) {
                    bf16_t* dst = V + (size_t)r * RW + (pn - 8) * 256 + cl;
#pragma unroll
                    for (int bj = 0; bj < 2; ++bj) st16_sc1(dst + 128 * bj, pack8(acc[ai][bj][m][0], acc[ai][bj][m][1]));
                } else if (pn < 16 || pn >= 24) {
                    bf16_t* dst = GY + (size_t)r * DM + (pn < 16 ? (pn - 12) * 256 : 1024 + (pn - 24) * 256) + cl;
#pragma unroll
                    for (int bj = 0; bj < 2; ++bj) { f32x4 g0 = acc[ai][bj][m][0], g1 = acc[ai][bj][m][1];
#pragma unroll
                        for (int e = 0; e < 4; ++e) { g0[e] = silu_f(g0[e]); g1[e] = silu_f(g1[e]); }
                        if (pn >= 24) st16_sc1(dst + 128 * bj, pack8(g0, g1)); else *(u32x4*)(dst + 128 * bj) = pack8(g0, g1); }
                } else {
                    f32x4 u0 = acc[ai][0][m][0], u1 = acc[ai][0][m][1]; const f32x4 b0 = acc[ai][1][m][0], b1 = acc[ai][1][m][1];
#pragma unroll
                    for (int e = 0; e < 4; ++e) { u0[e] *= sigmoid_f(b0[e]); u1[e] *= sigmoid_f(b1[e]); }
                    st16_sc1(U + (size_t)r * CW + (pn - 16) * 128 + cl, pack8(u0, u1));
                }
            }
    }
};

__device__ __forceinline__ void p2a_kv(LAS unsigned char* lds, const bf16_t* __restrict__ Kt, const bf16_t* __restrict__ V, bf16_t* __restrict__ KVT, int c, int h, int tid, int wid, int lane) {
    constexpr int PT = 576, PR = 528;
    LAS unsigned char* imgK = lds; LAS unsigned char* imgV = lds + 128 * PT;
    {
        u32x4 kreg[8], vreg[8];
#pragma unroll
        for (int it = 0; it < 8; ++it) {
            const int ci = tid + NTHREADS * it, row = ci >> 5, cc = ci & 31;
            const size_t grow = c > 0 ? (size_t)(c - 1) * 128 + row : (size_t)(SEQ + (row >= 112 ? row - 112 : 0));
            kreg[it] = *(const u32x4*)(Kt + grow * RW + h * 256 + cc * 8); vreg[it] = *(const u32x4*)(V + grow * RW + h * 256 + cc * 8);
        }
#pragma unroll
        for (int it = 0; it < 8; ++it) {
            const int ci = tid + NTHREADS * it, row = ci >> 5, cc = ci & 31;
            const bool valid = (c > 0) || (row >= 112);
            u32x4 kv = kreg[it], vv = vreg[it];
            if (!valid) { kv = (u32x4){0u, 0u, 0u, 0u}; vv = kv; }
            *(LAS u32x4*)(imgK + row * PT + cc * 16) = kv; *(LAS u32x4*)(imgV + row * PT + cc * 16) = vv;
        }
    }
    __syncthreads();
    const int w2 = wid >> 2, w4 = wid & 3, n31 = lane & 31, i16 = lane & 15, q4 = i16 >> 2, p4 = i16 & 3, blk = (lane >> 4) & 1, hh = lane >> 5;
    f32x16 acc[4][2];
#pragma unroll
    for (int a = 0; a < 4; ++a)
#pragma unroll
        for (int b2 = 0; b2 < 2; ++b2)
#pragma unroll
            for (int e = 0; e < 16; ++e) acc[a][b2][e] = 0.f;
#pragma unroll
    for (int ks = 0; ks < 8; ++ks) {
        const int tok = 16 * ks + 8 * hh + q4;
        bf16x8 af[4], bf[2];
#pragma unroll
        for (int a = 0; a < 4; ++a) { const int col0 = 128 * w2 + 32 * a + 16 * blk + 4 * p4;
            const s16x4 lo = tr_read(imgK + tok * PT + col0 * 2), hi = tr_read(imgK + (tok + 4) * PT + col0 * 2);
            af[a] = __builtin_shufflevector(lo, hi, 0, 1, 2, 3, 4, 5, 6, 7); }
#pragma unroll
        for (int b2 = 0; b2 < 2; ++b2) { const int col0 = 64 * w4 + 32 * b2 + 16 * blk + 4 * p4;
            const s16x4 lo = tr_read(imgV + tok * PT + col0 * 2), hi = tr_read(imgV + (tok + 4) * PT + col0 * 2);
            bf[b2] = __builtin_shufflevector(lo, hi, 0, 1, 2, 3, 4, 5, 6, 7); }
#pragma unroll
        for (int a = 0; a < 4; ++a)
#pragma unroll
            for (int b2 = 0; b2 < 2; ++b2) acc[a][b2] = MFMA32(af[a], bf[b2], acc[a][b2]);
    }
    __syncthreads();
#pragma unroll
    for (int a = 0; a < 4; ++a)
#pragma unroll
        for (int b2 = 0; b2 < 2; ++b2)
#pragma unroll
            for (int g = 0; g < 4; ++g) { u32x2 o; o.x = cvt_pk_bf16(acc[a][b2][4 * g], acc[a][b2][4 * g + 1]); o.y = cvt_pk_bf16(acc[a][b2][4 * g + 2], acc[a][b2][4 * g + 3]);
                *(LAS u32x2*)(lds + (64 * w4 + 32 * b2 + n31) * PR + (128 * w2 + 32 * a + 8 * g + 4 * hh) * 2) = o; }
    __syncthreads();
    bf16_t* dst = KVT;
#pragma unroll
    for (int it = 0; it < 16; ++it) {
        const int ci = tid + NTHREADS * it, row = ci >> 5, cc = ci & 31;
        *(u32x4*)(dst + (size_t)row * 256 + cc * 8) = *(LAS u32x4*)(lds + row * PR + cc * 16);
    }
    __syncthreads();
}
__device__ __forceinline__ void p2a_conv(LAS unsigned char* lds, const bf16_t* __restrict__ U, const float* __restrict__ dw_w, const float* __restrict__ dw_b, const float* __restrict__ ln_g, const float* __restrict__ ln_b,
                                         bf16_t* __restrict__ CB, int ct, int tid, int wid, int lane) {
    {
        f32x2 w[CK];
#pragma unroll
        for (int j = 0; j < CK; ++j) w[j] = *(const f32x2*)(dw_w + j * CW + 2 * tid);
        const f32x2 bias = *(const f32x2*)(dw_b + 2 * tid);
        f32x2 acc[32];
#pragma unroll
        for (int t = 0; t < 32; ++t) acc[t] = bias;
        const int p0 = 32 * ct + NMETA - (CK - 1);
#pragma unroll
        for (int s = 0; s < 32 + CK - 1; ++s) {
            const int p = p0 + s, pc = p < 0 ? 0 : p, row = pc >= NMETA ? pc - NMETA : SEQ + pc;
            unsigned raw = *(const unsigned*)(U + (size_t)row * CW + 2 * tid);
            if (p < 0) raw = 0u;
            const f32x2 uv = {bf_lo(raw), bf_hi(raw)};
#pragma unroll
            for (int t = (s - (CK - 1) > 0 ? s - (CK - 1) : 0); t <= (s < 31 ? s : 31); ++t) acc[t] = __builtin_elementwise_fma(uv, w[s - t], acc[t]);
        }
#pragma unroll
        for (int t = 0; t < 32; ++t) *(LAS f32x2*)(lds + (t * CW + 2 * tid) * 4) = acc[t];
    }
    __syncthreads();
    {
        f32x4 gg[2][2], bb[2][2];
#pragma unroll
        for (int i = 0; i < 2; ++i)
#pragma unroll
            for (int q = 0; q < 2; ++q) { gg[i][q] = *(const f32x4*)(ln_g + 512 * i + 8 * lane + 4 * q); bb[i][q] = *(const f32x4*)(ln_b + 512 * i + 8 * lane + 4 * q); }
#pragma unroll
        for (int k = 0; k < 4; ++k) {
            const int t = 4 * wid + k;
            f32x4 v[2][2]; float s = 0.f;
#pragma unroll
            for (int i = 0; i < 2; ++i)
#pragma unroll
                for (int q = 0; q < 2; ++q) { v[i][q] = *(LAS f32x4*)(lds + (t * CW + 512 * i + 8 * lane + 4 * q) * 4); s += (v[i][q][0] + v[i][q][1]) + (v[i][q][2] + v[i][q][3]); }
            const float mu = wave_sum(s) * (1.0f / CW);
            float qq = 0.f;
#pragma unroll
            for (int i = 0; i < 2; ++i)
#pragma unroll
                for (int q = 0; q < 2; ++q) { v[i][q] = v[i][q] - mu; qq += (v[i][q][0] * v[i][q][0] + v[i][q][1] * v[i][q][1]) + (v[i][q][2] * v[i][q][2] + v[i][q][3] * v[i][q][3]); }
            const float rs = 1.0f / sqrtf(wave_sum(qq) * (1.0f / CW) + EPS);
#pragma unroll
            for (int i = 0; i < 2; ++i) { f32x4 y0 = v[i][0] * rs * gg[i][0] + bb[i][0], y1 = v[i][1] * rs * gg[i][1] + bb[i][1];
#pragma unroll
                for (int e = 0; e < 4; ++e) { y0[e] = silu_f(y0[e]); y1[e] = silu_f(y1[e]); }
                st16_sc1(CB + (size_t)(32 * ct + t) * CW + 512 * i + 8 * lane, pack8(y0, y1)); }
        }
    }
    asm volatile("s_waitcnt vmcnt(0)" ::: "memory");
    __syncthreads();
}

__device__ __forceinline__ void p2b_scan(bf16_t* ST, int sb, int tid) {
    const int e2 = sb * NTHREADS + tid, h = e2 >> 15;
    const float cd = exp2f(128.0f * kLog2G[h]);
    f32x2 S = {0.f, 0.f};
    unsigned* p = (unsigned*)ST + e2;
    unsigned kv[64];
#pragma unroll
    for (int j = 0; j < 64; ++j) kv[j] = __builtin_nontemporal_load(p + (size_t)j * 131072);
#pragma unroll
    for (int j = 0; j < 64; ++j) {
        const f32x2 k2 = {bf_lo(kv[j]), bf_hi(kv[j])};
        S = S * cd + k2;
        p[(size_t)j * 131072] = cvt_pk_bf16(S[0], S[1]);
    }
}
struct SchedOne { int pm, pn; bool on;
    __device__ __forceinline__ bool next(int i, Unit& u) const { if (i > 0 || !on) return false; u.pm = pm; u.pn = pn; return true; }
    __device__ __forceinline__ void a_ready(const Unit&) const {}
    __device__ __forceinline__ void done(const Unit&) const {}
};
struct EpiPw {
    static constexpr bool PERM = true, AFTER_DRAIN = false, INIT = false;
    bf16_t* GY; const float* pw_b;
    __device__ __forceinline__ void operator()(const f32x4 (&acc)[2][2][4][2], const Unit& u, int wr, int wc, int fr, int fq) const {
        const int cl = wc * 32 + 8 * fq;
#pragma unroll
        for (int bj = 0; bj < 2; ++bj) {
            const int col = u.pn * 256 + bj * 128 + cl;
            const f32x4 b0 = *(const f32x4*)(pw_b + col), b1 = *(const f32x4*)(pw_b + col + 4);
#pragma unroll
            for (int ai = 0; ai < 2; ++ai)
#pragma unroll
                for (int m = 0; m < 4; ++m) {
                    const int r = u.pm * 256 + ai * 128 + wr * 64 + m * 16 + fr;
                    bf16_t* p = GY + (size_t)r * DM + 1024 + col;
                    const u32x4 g = *(const u32x4*)p;
                    const f32x4 g0 = {bf_lo(g.x), bf_hi(g.x), bf_lo(g.y), bf_hi(g.y)}, g1 = {bf_lo(g.z), bf_hi(g.z), bf_lo(g.w), bf_hi(g.w)};
                    *(u32x4*)p = pack8((acc[ai][bj][m][0] + b0) * g0, (acc[ai][bj][m][1] + b1) * g1);
                }
        }
    }
};

__device__ __forceinline__ void p2c_images(LAS unsigned char* lds, const bf16_t* __restrict__ Qt, const bf16_t* __restrict__ Kt, int xc, int h, int tid) {
    constexpr int PR = 528;
    LAS unsigned char* imgQ = lds; LAS unsigned char* imgK = lds + 73728;
    const size_t row0 = (size_t)xc * 128;
#pragma unroll
    for (int it = 0; it < 8; ++it) {
        const int ci = tid + NTHREADS * it, row = ci >> 5, cc = ci & 31;
        const u32x4 q = __builtin_nontemporal_load((const u32x4*)(Qt + (row0 + row) * RW + h * 256 + cc * 8)), k = __builtin_nontemporal_load((const u32x4*)(Kt + (row0 + row) * RW + h * 256 + cc * 8));
        *(LAS u32x4*)(imgQ + row * PR + cc * 16) = q; *(LAS u32x4*)(imgK + row * PR + cc * 16) = k;
    }
}
__device__ __forceinline__ void p2c_item(LAS unsigned char* lds, const bf16_t* __restrict__ Qt, const bf16_t* __restrict__ Kt, const bf16_t* __restrict__ V, const bf16_t* __restrict__ ST, bf16_t* __restrict__ GY,
                                         const float* __restrict__ gn_g, int xc, int h, int tid, int wid, int lane, const XcdBarrier& bar, bool pending, unsigned tok, unsigned tok2, bool preloaded) {
    constexpr int PR = 528, PT = 576, PF = 1040;
    LAS unsigned char* imgQ = lds; LAS unsigned char* imgK = lds + 73728; LAS unsigned char* imgV = lds + 73728; LAS unsigned char* imgS = lds;
    LAS float* ex = (LAS float*)(lds + 135168);
    const int wr = wid >> 1, wc = wid & 1, n31 = lane & 31, hh = lane >> 5, i16 = lane & 15, q4 = i16 >> 2, p4 = i16 & 3, blk = (lane >> 4) & 1;
    const size_t row0 = (size_t)xc * 128;
    if (!preloaded) p2c_images(lds, Qt, Kt, xc, h, tid);
    u32x4 vreg[8];
#pragma unroll
    for (int it = 0; it < 8; ++it) { const int ci = tid + NTHREADS * it, row = ci >> 5, cc = ci & 31; vreg[it] = __builtin_nontemporal_load((const u32x4*)(V + (row0 + row) * RW + h * 256 + cc * 8)); }
    __syncthreads();
    const float ginv = exp2f(-128.0f * kLog2G[h]);
    bf16x8 pf[4][2];
    {
        bf16x8 qf[16];
#pragma unroll
        for (int ks = 0; ks < 16; ++ks) qf[ks] = *(LAS bf16x8*)(imgQ + (32 * wr + n31) * PR + (16 * ks + 8 * hh) * 2);
#pragma unroll
        for (int jb = 0; jb < 4; ++jb) {
            if (jb <= wr) {
                f32x16 X;
#pragma unroll
                for (int e = 0; e < 16; ++e) X[e] = 0.f;
#pragma unroll
                for (int ks = 0; ks < 16; ++ks) { const bf16x8 kf = *(LAS bf16x8*)(imgK + (32 * jb + n31) * PR + (16 * ks + 8 * hh) * 2); X = MFMA32(kf, qf[ks], X); }
#pragma unroll
                for (int e = 0; e < 16; ++e) { const bool keep = (jb < wr) || (crow(e, hh) <= n31); X[e] = keep ? X[e] * ginv : 0.f; }
#pragma unroll
                for (int s2 = 0; s2 < 2; ++s2) { u32x4 p; p.x = cvt_pk_bf16(X[8 * s2], X[8 * s2 + 1]); p.y = cvt_pk_bf16(X[8 * s2 + 2], X[8 * s2 + 3]); p.z = cvt_pk_bf16(X[8 * s2 + 4], X[8 * s2 + 5]); p.w = cvt_pk_bf16(X[8 * s2 + 6], X[8 * s2 + 7]);
                    pf[jb][s2] = __builtin_bit_cast(bf16x8, p); }
            } else { pf[jb][0] = (bf16x8){0, 0, 0, 0, 0, 0, 0, 0}; pf[jb][1] = pf[jb][0]; }
        }
    }
    if (pending && tid == 0) xcd_barrier_wait_t0(bar, tok, tok2);
    __syncthreads();
#pragma unroll
    for (int it = 0; it < 8; ++it) { const int ci = tid + NTHREADS * it, row = ci >> 5, cc = ci & 31; *(LAS u32x4*)(imgV + row * PT + cc * 16) = vreg[it]; }
    const bf16_t* Ssrc = ST + (size_t)(xc * 4 + h) * 65536;
    u32x4 sreg[8];
#pragma unroll
    for (int it = 0; it < 8; ++it) { const int ci = tid + NTHREADS * it, row = ci >> 5, cc = ci & 31; sreg[it] = __builtin_nontemporal_load((const u32x4*)(Ssrc + (size_t)row * 256 + cc * 8)); }
    __syncthreads();
    f32x16 acc[4];
#pragma unroll
    for (int nb = 0; nb < 4; ++nb)
#pragma unroll
        for (int e = 0; e < 16; ++e) acc[nb][e] = 0.f;
#pragma unroll
    for (int jb = 0; jb < 4; ++jb) {
        if (jb <= wr) {
#pragma unroll
            for (int s2 = 0; s2 < 2; ++s2) {
                const int tok = 32 * jb + 16 * s2 + 4 * hh + q4;
#pragma unroll
                for (int nb = 0; nb < 4; ++nb) { const int col0 = 128 * wc + 32 * nb + 16 * blk + 4 * p4;
                    const s16x4 lo = tr_read(imgV + tok * PT + col0 * 2), hi = tr_read(imgV + (tok + 8) * PT + col0 * 2);
                    const bf16x8 vf = __builtin_shufflevector(lo, hi, 0, 1, 2, 3, 4, 5, 6, 7);
                    acc[nb] = MFMA32(pf[jb][s2], vf, acc[nb]); }
            }
        }
    }
    bf16x8 qf[16];
#pragma unroll
    for (int ks = 0; ks < 16; ++ks) qf[ks] = *(LAS bf16x8*)(imgQ + (32 * wr + n31) * PR + (16 * ks + 8 * hh) * 2);
    __syncthreads();
    {
        u32x4 sreg2[8];
#pragma unroll
        for (int it = 0; it < 8; ++it) { const int ci = tid + NTHREADS * (it + 8), row = ci >> 5, cc = ci & 31; sreg2[it] = __builtin_nontemporal_load((const u32x4*)(Ssrc + (size_t)row * 256 + cc * 8)); }
#pragma unroll
        for (int it = 0; it < 8; ++it) { const int ci = tid + NTHREADS * it, row = ci >> 5, cc = ci & 31; *(LAS u32x4*)(imgS + row * PR + cc * 16) = sreg[it]; }
#pragma unroll
        for (int it = 0; it < 8; ++it) { const int ci = tid + NTHREADS * (it + 8), row = ci >> 5, cc = ci & 31; *(LAS u32x4*)(imgS + row * PR + cc * 16) = sreg2[it]; }
    }
    u32x4 greg[8];
#pragma unroll
    for (int it = 0; it < 8; ++it) { const int ci = tid + NTHREADS * it, row = ci >> 5, cc = ci & 31; greg[it] = __builtin_nontemporal_load((const u32x4*)(GY + (row0 + row) * DM + h * 256 + cc * 8)); }
    __syncthreads();
#pragma unroll
    for (int ks = 0; ks < 16; ++ks)
#pragma unroll
        for (int nb = 0; nb < 4; ++nb) { const bf16x8 sf = *(LAS bf16x8*)(imgS + (128 * wc + 32 * nb + n31) * PR + (16 * ks + 8 * hh) * 2); acc[nb] = MFMA32(qf[ks], sf, acc[nb]); }
    float sm[16], sq[16];
#pragma unroll
    for (int e = 0; e < 16; ++e) {
        float a = (acc[0][e] + acc[1][e]) + (acc[2][e] + acc[3][e]);
        float q = (acc[0][e] * acc[0][e] + acc[1][e] * acc[1][e]) + (acc[2][e] * acc[2][e] + acc[3][e] * acc[3][e]);
        a = sum32(a); q = sum32(q);
        sm[e] = a; sq[e] = q;
        if (n31 == e) { ex[(wid * 32 + crow(e, hh)) * 2] = a; ex[(wid * 32 + crow(e, hh)) * 2 + 1] = q; }
    }
    __syncthreads();
    float gng[4];
#pragma unroll
    for (int nb = 0; nb < 4; ++nb) gng[nb] = gn_g[h * 256 + 128 * wc + 32 * nb + n31];
#pragma unroll
    for (int e = 0; e < 16; ++e) {
        const int rl = crow(e, hh);
        const float ta = sm[e] + ex[((wid ^ 1) * 32 + rl) * 2], tq = sq[e] + ex[((wid ^ 1) * 32 + rl) * 2 + 1];
        const float mu = ta * (1.0f / RD), var = tq * (1.0f / RD) - mu * mu, rs = __builtin_amdgcn_rsqf(fmaxf(var, 0.f) + EPS);
#pragma unroll
        for (int nb = 0; nb < 4; ++nb) *(LAS float*)(lds + (32 * wr + rl) * PF + (128 * wc + 32 * nb + n31) * 4) = (acc[nb][e] - mu) * rs * gng[nb];
    }
    __syncthreads();
#pragma unroll
    for (int it = 0; it < 8; ++it) {
        const int ci = tid + NTHREADS * it, row = ci >> 5, cc = ci & 31;
        const f32x4 y0 = *(LAS f32x4*)(lds + row * PF + cc * 32), y1 = *(LAS f32x4*)(lds + row * PF + cc * 32 + 16);
        const u32x4 g = greg[it];
        const f32x4 g0 = {bf_lo(g.x), bf_hi(g.x), bf_lo(g.y), bf_hi(g.y)}, g1 = {bf_lo(g.z), bf_hi(g.z), bf_lo(g.w), bf_hi(g.w)};
        st16_sc1(GY + (row0 + row) * DM + h * 256 + cc * 8, pack8(y0 * g0, y1 * g1));
    }
    asm volatile("s_waitcnt vmcnt(0)" ::: "memory");
    __syncthreads();
}

struct SchedP3 { int pm, pn; unsigned* cnt; unsigned want;
    __device__ __forceinline__ bool next(int i, Unit& u) const { if (i > 0) return false; u.pm = pm; u.pn = pn; return true; }
    __device__ __forceinline__ void a_ready(const Unit&) const {
        if (threadIdx.x == 0) { wait_count(cnt + 64 * pm, want); __builtin_amdgcn_fence(__ATOMIC_ACQUIRE, "agent"); asm volatile("s_waitcnt vmcnt(0)" ::: "memory"); }
        __syncthreads();
    }
    __device__ __forceinline__ void done(const Unit&) const {}
};
struct Epi3 {
    static constexpr bool PERM = true, AFTER_DRAIN = true, INIT = true;
    const float* x; float* out; const float* final_g; float* psum; unsigned* panel;
    __device__ __forceinline__ void init(f32x4 (&acc)[2][2][4][2], const Unit& u, int wr, int wc, int fr, int fq) const {
        const int cl = wc * 32 + 8 * fq;
#pragma unroll
        for (int ai = 0; ai < 2; ++ai)
#pragma unroll
            for (int m = 0; m < 4; ++m) { const float* xr = x + ((size_t)u.pm * 256 + ai * 128 + wr * 64 + m * 16 + fr) * DM + u.pn * 256 + cl;
#pragma unroll
                for (int bj = 0; bj < 2; ++bj)
#pragma unroll
                    for (int n = 0; n < 2; ++n) acc[ai][bj][m][n] = __builtin_nontemporal_load((const f32x4*)(xr + bj * 128 + 4 * n)); }
    }
    __device__ __forceinline__ void fused(f32x4 (&acc)[2][2][4][2], const Unit& u, int wr, int wc, int fr, int fq, LAS unsigned char* lds, int wid, int lane) const {
        constexpr int PF = 1040;
        int ln = lane; asm volatile("" : "+v"(ln));
        const int cl = wc * 32 + 8 * fq, wv = wid;
        const size_t prow = (size_t)u.pn * SEQ + u.pm * 256;
        LAS float* red = (LAS float*)(lds + 135168);
#pragma unroll
        for (int ai = 0; ai < 2; ++ai)
#pragma unroll
            for (int m = 0; m < 4; ++m) {
                float sq = 0.f;
#pragma unroll
                for (int bj = 0; bj < 2; ++bj)
#pragma unroll
                    for (int n = 0; n < 2; ++n) { const f32x4 v = acc[ai][bj][m][n]; sq += (v[0] * v[0] + v[1] * v[1]) + (v[2] * v[2] + v[3] * v[3]); }
                sq += __builtin_bit_cast(float, __builtin_amdgcn_ds_swizzle(__builtin_bit_cast(int, sq), 0x401F)); sq += __shfl_xor(sq, 32);
                if (fq == 0) red[wc * 256 + ai * 128 + wr * 64 + m * 16 + fr] = sq;
            }
        __syncthreads();
        if (threadIdx.x < 256) { const int t = threadIdx.x; const float tot = (red[t] + red[256 + t]) + (red[512 + t] + red[768 + t]);
            __hip_atomic_store(psum + prow + t, tot, __ATOMIC_RELAXED, __HIP_MEMORY_SCOPE_AGENT); }
        asm volatile("s_waitcnt vmcnt(0)" ::: "memory");
        __syncthreads();
        if (threadIdx.x == 0) __hip_atomic_fetch_add(panel + 64 * u.pm, 1u, __ATOMIC_RELAXED, __HIP_MEMORY_SCOPE_AGENT);
        f32x4 hreg[2][16];
#pragma unroll
        for (int ai = 0; ai < 2; ++ai) {
            if (ai) __syncthreads();
#pragma unroll
            for (int m = 0; m < 4; ++m)
#pragma unroll
                for (int bj = 0; bj < 2; ++bj)
#pragma unroll
                    for (int n = 0; n < 2; ++n) *(LAS f32x4*)(lds + (wr * 64 + m * 16 + fr) * PF + (bj * 128 + cl + 4 * n) * 4) = acc[ai][bj][m][n];
            __syncthreads();
#pragma unroll
            for (int it = 0; it < 16; ++it) hreg[ai][it] = *(LAS f32x4*)(lds + (wv + 8 * it) * PF + ln * 16);
        }
        if (threadIdx.x == 0) {
            wait_count(panel + 64 * u.pm, 8u);
            __builtin_amdgcn_fence(__ATOMIC_ACQUIRE, "agent");
            asm volatile("s_waitcnt vmcnt(0)" ::: "memory");
        }
        __syncthreads();
        float rsl;
        { const size_t r = (size_t)u.pm * 256 + (ln >> 4 & 1) * 128 + wv + 8 * (ln & 15);
          float tot = 0.f;
#pragma unroll
          for (int p = 0; p < 8; ++p) tot += psum[(size_t)p * SEQ + r];
          rsl = 1.0f / sqrtf(tot * (1.0f / DM) + EPS); }
        const f32x4 g = *(const f32x4*)(final_g + u.pn * 256 + 4 * ln);
        float* ob = out + ((size_t)u.pm * 256 + wv) * DM + u.pn * 256 + 4 * ln;
#pragma unroll
        for (int ai = 0; ai < 2; ++ai)
#pragma unroll
            for (int it = 0; it < 16; ++it) {
                const float rs = __builtin_bit_cast(float, __builtin_amdgcn_readlane(__builtin_bit_cast(int, rsl), ai * 16 + it));
                __builtin_nontemporal_store(hreg[ai][it] * rs * g, (f32x4*)(ob + (size_t)(ai * 128 + 8 * it) * DM));
            }
    }
};

struct Args { const float* in[13]; float* out; unsigned char* ws; int ph_lo, ph_hi; };
__global__ void __launch_bounds__(NTHREADS, 2) mega(Args a) {
    extern __shared__ __attribute__((aligned(16))) unsigned char lds_[];
    LAS unsigned char* lds = (LAS unsigned char*)lds_;
    const int tid = threadIdx.x, lane = tid & 63, wid = __builtin_amdgcn_readfirstlane(tid >> 6), b = blockIdx.x;
    unsigned char* ws = a.ws;
    const float *x = a.in[0], *meta = a.in[1], *ln_g = a.in[2], *w_in = a.in[3], *gn_g = a.in[4], *dw_w = a.in[5], *dw_b = a.in[6], *cln_g = a.in[7], *cln_b = a.in[8],
                *pw_w = a.in[9], *pw_b = a.in[10], *w_out = a.in[11], *final_g = a.in[12];
    for (int u = tid; u < (LDS_BYTES - MISC_OFF) / 4; u += NTHREADS) ((LAS unsigned*)(lds + MISC_OFF))[u] = 0u;
    __syncthreads();
    XcdBarrier bar = xcd_barrier_post((unsigned*)(ws + WS_CTL) + CW_BAR, (volatile LAS unsigned*)(lds + MISC_OFF) + 8);
    const int lo = a.ph_lo, hi = a.ph_hi;
#define IN(k) (lo <= (k) && (k) < hi)
#define SEAM(k) do { if (IN(k) && IN((k) + 1)) xcd_barrier(bar); } while (0)
#define WS_LAUNDER() size_t wsz_ = 0; asm volatile("" : "+s"(wsz_)); unsigned char* wsl = ws + wsz_
    if (IN(0)) { p0_prologue(lds, x, meta, ln_g, w_in, pw_w, w_out, ws, b, tid, wid, lane); }
    SEAM(0);
    if (IN(1)) {
        unsigned* ctl = (unsigned*)(ws + WS_CTL);
        {
            WS_LAUNDER();
            pg8::Gemm g{(const bf16_t*)(wsl + WS_HB), (const bf16_t*)(wsl + WS_WIN), MPAD, INW, DM};
            Sched1 S{b, ctl};
            Epi1 E{(bf16_t*)(wsl + WS_QT), (bf16_t*)(wsl + WS_KT), (bf16_t*)(wsl + WS_V), (bf16_t*)(wsl + WS_U), (bf16_t*)(wsl + WS_GY), (const float*)(wsl + WS_RSTD), (const float*)(wsl + WS_COS), (const float*)(wsl + WS_SIN)};
            pg8::gemm_phase<Epi1, Sched1, true, true>(lds, g, S, E);
        }
        {
            WS_LAUNDER();
            volatile LAS unsigned* misc = (volatile LAS unsigned*)(lds + MISC_OFF);
            if (tid == 0) { wait_count(ctl + CW_MID, (unsigned)GRID); __builtin_amdgcn_fence(__ATOMIC_ACQUIRE, "agent"); asm volatile("s_waitcnt vmcnt(0)" ::: "memory"); }
            __syncthreads();
            bool meta_ok = false;
            for (;;) {
                if (tid == 0) misc[0] = __hip_atomic_fetch_add(ctl + CW_Q, 1u, __ATOMIC_RELAXED, __HIP_MEMORY_SCOPE_AGENT);
                __syncthreads();
                const int item = (int)misc[0];
                __syncthreads();
                if (item >= 640) break;
                if (item >= 256 && item < 384) {
                    const int pm = (item - 256) >> 2, pn = item & 3;
                    if (tid == 0) { wait_count(ctl + CW_CONV + 64 * pm, 8u); wait_count(ctl + CW_GC + 64 * pm, 4u); __builtin_amdgcn_fence(__ATOMIC_ACQUIRE, "agent"); asm volatile("s_waitcnt vmcnt(0)" ::: "memory"); }
                    __syncthreads();
                    size_t zp = 0; asm volatile("" : "+s"(zp));
                    pg8::Gemm g{(const bf16_t*)(wsl + WS_CB) + zp, (const bf16_t*)(wsl + WS_WPW) + zp, SEQ, CW, CW};
                    SchedOne S{pm, pn, true};
                    EpiPw E{(bf16_t*)(wsl + WS_GY) + zp, pw_b + zp};
                    pg8::gemm_phase<EpiPw, SchedOne, false, true>(lds, g, S, E);
                    continue;
                }
                const bool is_kv = item >= 384;
                const int j = is_kv ? item - 384 : item;
                const int c = j < 252 ? (j >> 2) + 1 : 0, hq = j & 3, ct = j < 255 ? j + 1 : 0;
                const bool needs_meta = is_kv ? (c == 0) : (ct == 0);
                if (needs_meta && !meta_ok) {
                    if (tid == 0) { wait_count(ctl + CW_META, 16u); __builtin_amdgcn_fence(__ATOMIC_ACQUIRE, "agent"); asm volatile("s_waitcnt vmcnt(0)" ::: "memory"); }
                    __syncthreads();
                    meta_ok = true;
                }
                size_t zi = 0; asm volatile("" : "+s"(zi));
                int tl = tid; asm volatile("" : "+v"(tl));
                const int ll = tl & 63, wl = __builtin_amdgcn_readfirstlane(tl >> 6);
                if (is_kv) p2a_kv(lds, (const bf16_t*)(wsl + WS_KT) + zi, (const bf16_t*)(wsl + WS_V) + zi, kvt_tile(wsl, c * 4 + hq) + zi, c, hq, tl, wl, ll);
                else { p2a_conv(lds, (const bf16_t*)(wsl + WS_U) + zi, dw_w + zi, dw_b + zi, cln_g + zi, cln_b + zi, (bf16_t*)(wsl + WS_CB) + zi, ct, tl, wl, ll);
                       if (tid == 0) __hip_atomic_fetch_add(ctl + CW_CONV + 64 * (ct >> 3), 1u, __ATOMIC_RELAXED, __HIP_MEMORY_SCOPE_AGENT); }
            }
        }
    }
    const bool preloaded = IN(1) && IN(3);
    {
        unsigned t1 = 0u, t1b = 0u;
        const bool pend1 = IN(1) && IN(2);
        if (pend1) xcd_barrier_arrive(bar, t1, t1b);
        if (preloaded) { WS_LAUNDER(); p2c_images(lds, (const bf16_t*)(wsl + WS_QT), (const bf16_t*)(wsl + WS_KT), b >> 2, b & 3, tid); }
        if (pend1) { if (tid == 0) xcd_barrier_wait_t0(bar, t1, t1b); __syncthreads(); }
    }
    if (IN(2)) {
        WS_LAUNDER();
        p2b_scan((bf16_t*)(wsl + WS_ST), b, tid);
    }
    unsigned tok = 0u, tok2 = 0u;
    const bool pending = IN(2) && IN(3);
    if (pending) xcd_barrier_arrive(bar, tok, tok2);
    if (IN(3)) {
        WS_LAUNDER();
        p2c_item(lds, (const bf16_t*)(wsl + WS_QT), (const bf16_t*)(wsl + WS_KT), (const bf16_t*)(wsl + WS_V), (const bf16_t*)(wsl + WS_ST), (bf16_t*)(wsl + WS_GY), gn_g, b >> 2, b & 3, tid, wid, lane, bar, pending, tok, tok2, preloaded);
        if (tid == 0) __hip_atomic_fetch_add((unsigned*)(ws + WS_CTL) + CW_YR + 64 * (b >> 3), 1u, __ATOMIC_RELAXED, __HIP_MEMORY_SCOPE_AGENT);
    }
    if (IN(4)) {
        WS_LAUNDER();
        pg8::Gemm g{(const bf16_t*)(wsl + WS_GY), (const bf16_t*)(wsl + WS_WOUT), SEQ, DM, DM};
        const int xcd = b & 7, off = b >> 3, wg = xcd * 32 + off;
        SchedP3 S{(wg >> 6) * 8 + (wg & 7), (wg & 63) >> 3, (unsigned*)(ws + WS_CTL) + CW_YR, IN(3) ? 8u : 0u};
        Epi3 E{x, a.out, final_g, (float*)(wsl + WS_PSUM), (unsigned*)(ws + WS_CTL) + CW_PANEL};
        pg8::gemm_phase<Epi3, SchedP3, false, true>(lds, g, S, E);
    }
#undef WS_LAUNDER
#undef IN
#undef SEAM
}
}

#ifndef LADDER
#define LADDER 0
#endif
#ifndef PROBE_K
#define PROBE_K 0
#endif
#ifndef PROBE_TAIL
#define PROBE_TAIL 0
#endif
#if LADDER > 0
namespace nt {
using namespace mk;
__device__ __forceinline__ float bf2f(bf16_t v) { return __uint_as_float((unsigned)v << 16); }
__device__ __forceinline__ bf16_t f2bf(float f) { unsigned u = __float_as_uint(f); return (bf16_t)((u + 0x7fffu + ((u >> 16) & 1u)) >> 16); }
__device__ __forceinline__ float sigm(float x) { return 1.f / (1.f + expf(-x)); }
__global__ void __launch_bounds__(64) t_retention(const bf16_t* Qt, const bf16_t* Kt, const bf16_t* V, float* yraw) {
    const int w = blockIdx.x, h = w >> 8, dv = w & 255, lane = threadIdx.x;
    const float gamma = 1.0f - exp2f(-5.0f - (float)h), l2g = log2f(gamma);
    float S[4] = {0.f, 0.f, 0.f, 0.f};
    for (int pos = 0; pos < LTOK; ++pos) {
        const int r = pos < NMETA ? SEQ + pos : pos - NMETA, il = pos < NMETA ? 112 + pos : (r & 127);
        const float v = bf2f(V[(size_t)r * RW + h * RD + dv]);
        const float kd = exp2f(-(float)(127 - il) * l2g), qd = exp2f(-(float)(il + 1) * l2g);
        float part = 0.f;
#pragma unroll
        for (int i = 0; i < 4; ++i) {
            const int d = lane + 64 * i;
            const float k = bf2f(Kt[(size_t)r * RW + h * RD + d]) * kd;
            const float q = r < SEQ ? bf2f(Qt[(size_t)r * RW + h * RD + d]) * qd : 0.f;
            S[i] = gamma * S[i] + k * v;
            part += q * S[i];
        }
        part = wave_sum(part);
        if (lane == 0 && r < SEQ) yraw[(size_t)r * RW + h * RD + dv] = part;
    }
}
__global__ void __launch_bounds__(256) t_chunk(const bf16_t* Qt, const bf16_t* Kt, const bf16_t* V, const bf16_t* ST, float* yraw) {
    __shared__ float sc[128];
    __shared__ float qs[256];
    const int xc = blockIdx.x >> 2, h = blockIdx.x & 3, dv = threadIdx.x;
    const float gamma = 1.0f - exp2f(-5.0f - (float)h), ginv = exp2f(-128.0f * log2f(gamma));
    const bf16_t* Sx = ST + (size_t)(xc * 4 + h) * 65536;
    for (int i = 0; i < 128; ++i) {
        const size_t ri = (size_t)xc * 128 + i;
        __syncthreads();
        qs[dv] = bf2f(Qt[ri * RW + h * RD + dv]);
        __syncthreads();
        if (dv < 128) { float s = 0.f; if (dv <= i) { const size_t rj = (size_t)xc * 128 + dv; for (int d = 0; d < 256; ++d) s += qs[d] * bf2f(Kt[rj * RW + h * RD + d]); } sc[dv] = s * ginv; }
        __syncthreads();
        float y = 0.f;
        for (int j = 0; j <= i; ++j) y += sc[j] * bf2f(V[((size_t)xc * 128 + j) * RW + h * RD + dv]);
        for (int d = 0; d < 256; ++d) y += qs[d] * bf2f(Sx[(size_t)dv * 256 + d]);
        yraw[ri * RW + h * RD + dv] = y;
    }
}
__global__ void t_groupnorm(const float* yraw, bf16_t* GY, const float* gn_g) {
    const int w = (blockIdx.x * blockDim.x + threadIdx.x) >> 6, lane = threadIdx.x & 63;
    if (w >= SEQ * RH) return;
    const int r = w >> 2, h = w & 3;
    float v[4], s = 0.f;
#pragma unroll
    for (int i = 0; i < 4; ++i) { v[i] = yraw[(size_t)r * RW + h * RD + lane + 64 * i]; s += v[i]; }
    const float mu = wave_sum(s) / RD;
    float q = 0.f;
#pragma unroll
    for (int i = 0; i < 4; ++i) { v[i] -= mu; q += v[i] * v[i]; }
    const float rs = 1.0f / sqrtf(wave_sum(q) / RD + EPS);
#pragma unroll
    for (int i = 0; i < 4; ++i) { const int c = h * RD + lane + 64 * i; bf16_t* p = GY + (size_t)r * DM + c; *p = f2bf(v[i] * rs * gn_g[c] * bf2f(*p)); }
}
__global__ void __launch_bounds__(256) t_conv(const bf16_t* U, const float* dw_w, const float* dw_b, const float* ln_g, const float* ln_b, bf16_t* CB) {
    __shared__ float red[8];
    const int r = blockIdx.x, pos = r + NMETA, tid = threadIdx.x, lane = tid & 63, wv = tid >> 6;
    float c[4];
#pragma unroll
    for (int i = 0; i < 4; ++i) {
        const int ch = tid + 256 * i;
        float a = dw_b[ch];
        for (int j = 0; j < CK; ++j) { const int p = pos - (CK - 1) + j; if (p >= 0) { const int row = p >= NMETA ? p - NMETA : SEQ + p; a += bf2f(U[(size_t)row * CW + ch]) * dw_w[j * CW + ch]; } }
        c[i] = a;
    }
    float s = wave_sum(c[0] + c[1] + c[2] + c[3]);
    if (lane == 0) red[wv] = s;
    __syncthreads();
    const float mu = (red[0] + red[1] + red[2] + red[3]) / CW;
    float q = 0.f;
#pragma unroll
    for (int i = 0; i < 4; ++i) { c[i] -= mu; q += c[i] * c[i]; }
    q = wave_sum(q);
    if (lane == 0) red[4 + wv] = q;
    __syncthreads();
    const float rs = 1.0f / sqrtf((red[4] + red[5] + red[6] + red[7]) / CW + EPS);
#pragma unroll
    for (int i = 0; i < 4; ++i) { const int ch = tid + 256 * i; const float y = c[i] * rs * ln_g[ch] + ln_b[ch]; CB[(size_t)r * CW + ch] = f2bf(y * sigm(y)); }
}
template <int M, int N, int K, class AL, class EP>
__global__ void __launch_bounds__(256) t_gemm(const float* B, AL al, EP ep) {
    __shared__ float As[16][68];
    __shared__ float Bs[16][68];
    const int tx = threadIdx.x & 15, ty = threadIdx.x >> 4;
    const int m0 = blockIdx.y * 64, n0 = blockIdx.x * 64;
    float acc[4][4];
#pragma unroll
    for (int i = 0; i < 4; ++i)
#pragma unroll
        for (int j = 0; j < 4; ++j) acc[i][j] = 0.f;
    for (int k0 = 0; k0 < K; k0 += 16) {
#pragma unroll
        for (int i = 0; i < 4; ++i) { const int idx = threadIdx.x + i * 256, mm = idx >> 4, kk = idx & 15, m = m0 + mm; As[kk][mm] = (m < M) ? al(m, k0 + kk) : 0.f; }
#pragma unroll
        for (int i = 0; i < 4; ++i) { const int idx = threadIdx.x + i * 256, kk = idx >> 6, nn = idx & 63; Bs[kk][nn] = B[(size_t)(k0 + kk) * N + n0 + nn]; }
        __syncthreads();
#pragma unroll
        for (int kk = 0; kk < 16; ++kk) {
            float a[4], b[4];
#pragma unroll
            for (int i = 0; i < 4; ++i) { a[i] = As[kk][ty * 4 + i]; b[i] = Bs[kk][tx * 4 + i]; }
#pragma unroll
            for (int i = 0; i < 4; ++i)
#pragma unroll
                for (int j = 0; j < 4; ++j) acc[i][j] += a[i] * b[j];
        }
        __syncthreads();
    }
#pragma unroll
    for (int i = 0; i < 4; ++i)
#pragma unroll
        for (int j = 0; j < 4; ++j) { const int m = m0 + ty * 4 + i, n = n0 + tx * 4 + j; if (m < M) ep(m, n, acc[i][j]); }
}
struct AL_CB { const bf16_t* CB; __device__ float operator()(int m, int k) const { return bf2f(CB[(size_t)m * CW + k]); } };
struct EP_PW { bf16_t* GY; const float* pw_b; __device__ void operator()(int m, int n, float v) const { bf16_t* p = GY + (size_t)m * DM + 1024 + n; *p = f2bf((v + pw_b[n]) * bf2f(*p)); } };
struct AL_GY { const bf16_t* GY; __device__ float operator()(int m, int k) const { return bf2f(GY[(size_t)m * DM + k]); } };
struct EP_OUT { float* out; const float* x; __device__ void operator()(int m, int n, float v) const { out[(size_t)m * DM + n] = v + x[(size_t)m * DM + n]; } };
__global__ void t_final(float* out, const float* g) {
    const int w = (blockIdx.x * blockDim.x + threadIdx.x) >> 6, lane = threadIdx.x & 63;
    if (w >= SEQ) return;
    float* r = out + (size_t)w * DM;
    float s = 0.f;
    for (int i = lane; i < DM; i += 64) { const float v = r[i]; s += v * v; }
    const float rs = 1.0f / sqrtf(wave_sum(s) / DM + EPS);
    for (int i = lane; i < DM; i += 64) r[i] = r[i] * rs * g[i];
}
}
#endif

extern "C" void kernel_launch(void* const* d_in, const int* in_sizes, int n_in, void* d_out, int out_size, void* d_ws, size_t ws_size, hipStream_t stream) {
    using namespace mk;
    static int ready = 0;
    if (ready == 0) {
        if (n_in != 13 || out_size != SEQ * DM || ws_size < WS_END) { fprintf(stderr, "kernel_launch: unexpected shapes (n_in %d, out %d, ws %zu)\n", n_in, out_size, ws_size); ready = -1; return; }
        int dev = 0, cus = 0;
        if (hipGetDevice(&dev) != hipSuccess || hipDeviceGetAttribute(&cus, hipDeviceAttributeMultiprocessorCount, dev) != hipSuccess) { ready = -1; return; }
        if (cus < GRID) { fprintf(stderr, "kernel_launch: %d CUs < %d\n", cus, GRID); ready = -1; return; }
        if (hipFuncSetAttribute((const void*)mega, hipFuncAttributeMaxDynamicSharedMemorySize, LDS_BYTES) != hipSuccess) { fprintf(stderr, "kernel_launch: hipFuncSetAttribute failed\n"); ready = -1; return; }
        int per_cu = 0;
        if (hipOccupancyMaxActiveBlocksPerMultiprocessor(&per_cu, (const void*)mega, NTHREADS, LDS_BYTES) != hipSuccess || per_cu < 1) fprintf(stderr, "kernel_launch: occupancy query says %d blocks/CU\n", per_cu);
        (void)hipGetLastError();
        ready = 1;
    }
    if (ready < 0) return;
    (void)hipMemsetAsync((char*)d_ws + WS_CTL, 0, CTL_ZERO_BYTES, stream);
    Args a{};
    for (int i = 0; i < 13; ++i) a.in[i] = (const float*)d_in[i];
    a.out = (float*)d_out; a.ws = (unsigned char*)d_ws;
#if LADDER == 0
#if PROBE_K > 0
    a.ph_lo = 0; a.ph_hi = PROBE_K;
    hipLaunchKernelGGL(mega, dim3(GRID), dim3(NTHREADS), LDS_BYTES, stream, a);
    (void)hipMemsetAsync((char*)d_ws + WS_CTL, 0, CTL_ZERO_BYTES, stream);
#endif
    a.ph_lo = 0; a.ph_hi = 5;
    hipLaunchKernelGGL(mega, dim3(GRID), dim3(NTHREADS), LDS_BYTES, stream, a);
#if PROBE_TAIL > 0
    (void)hipMemsetAsync((char*)d_ws + WS_CTL, 0, CTL_ZERO_BYTES, stream);
    a.ph_lo = PROBE_TAIL; a.ph_hi = 5;
    hipLaunchKernelGGL(mega, dim3(GRID), dim3(NTHREADS), LDS_BYTES, stream, a);
#endif
#else
    using namespace nt;
    unsigned char* ws = (unsigned char*)d_ws;
    bf16_t *Qt = (bf16_t*)(ws + WS_QT), *Kt = (bf16_t*)(ws + WS_KT), *V = (bf16_t*)(ws + WS_V), *U = (bf16_t*)(ws + WS_U), *GY = (bf16_t*)(ws + WS_GY), *CB = (bf16_t*)(ws + WS_CB), *ST = (bf16_t*)(ws + WS_ST);
    const float *x = a.in[0], *gn_g = a.in[4], *dw_w = a.in[5], *dw_b = a.in[6], *cln_g = a.in[7], *cln_b = a.in[8], *pw_w = a.in[9], *pw_b = a.in[10], *w_out = a.in[11], *final_g = a.in[12];
    float* out = (float*)d_out; float* yraw = (float*)d_out;
    a.ph_lo = 0; a.ph_hi = (LADDER == 1 ? 2 : LADDER == 2 ? 3 : 4);
    hipLaunchKernelGGL(mega, dim3(GRID), dim3(NTHREADS), LDS_BYTES, stream, a);
#if LADDER == 1
    t_retention<<<RH * RD, 64, 0, stream>>>(Qt, Kt, V, yraw);
    t_groupnorm<<<(SEQ * RH * 64 + 255) / 256, 256, 0, stream>>>(yraw, GY, gn_g);
    t_conv<<<SEQ, 256, 0, stream>>>(U, dw_w, dw_b, cln_g, cln_b, CB);
    t_gemm<SEQ, CW, CW><<<dim3(CW / 64, SEQ / 64), 256, 0, stream>>>(pw_w, AL_CB{CB}, EP_PW{GY, pw_b});
#elif LADDER == 2
    t_chunk<<<64 * 4, 256, 0, stream>>>(Qt, Kt, V, ST, yraw);
    t_groupnorm<<<(SEQ * RH * 64 + 255) / 256, 256, 0, stream>>>(yraw, GY, gn_g);
#endif
    t_gemm<SEQ, DM, DM><<<dim3(DM / 64, SEQ / 64), 256, 0, stream>>>(w_out, AL_GY{GY}, EP_OUT{out, x});
    t_final<<<(SEQ * 64 + 255) / 256, 256, 0, stream>>>(out, final_g);
#endif
}
```

```cpp
#include <hip/hip_runtime.h>
#include <cstdio>
#include <cstdint>
namespace pg8 {
#define PG8_LAS __attribute__((address_space(3)))
typedef unsigned short bf16_t;
typedef short bf16x8 __attribute__((ext_vector_type(8)));
typedef float f32x4 __attribute__((ext_vector_type(4)));
typedef unsigned u32x4 __attribute__((ext_vector_type(4)));
constexpr int BM = 256, BK = 64, HALF = 128, HTB = HALF * BK * 2  , STAGE_BYTES = 8 * HTB, NXCD = 8, WGM = 8;

__host__ __device__ __forceinline__ int lds_byte(int r, int c) { const int st = (r >> 4) * 2 + (c >> 5), rr = r & 15, cc = c & 31, ob = rr * 64 + cc * 2; return st * 1024 + (ob ^ (((ob >> 9) & 1) << 5)); }
__host__ __device__ __forceinline__ void stage_rc(int b, int& R, int& C) { const int st = b / 1024, sb = b % 1024, swz = sb ^ (((sb >> 9) & 1) << 5); R = (st >> 1) * 16 + swz / 64; C = (st & 1) * 32 + (swz % 64) / 2; }
__host__ __device__ __forceinline__ int perm32(int rho) { const int n = rho >> 4, i = rho & 15; return 8 * (i >> 2) + 4 * n + (i & 3); }

struct Unit { int pm, pn; };
struct Gemm { const bf16_t* A; const bf16_t* Bt; int M, N, K; };

__device__ __forceinline__ unsigned cvt_pk_bf16(float lo, float hi) { unsigned r; asm volatile("v_cvt_pk_bf16_f32 %0, %1, %2" : "=v"(r) : "v"(lo), "v"(hi)); return r; }
typedef float f32x2 __attribute__((ext_vector_type(2)));
template <class Epi, class Sched, bool ALIGN_EPI = false, bool SP2 = false>
__device__ __forceinline__ void gemm_phase(PG8_LAS unsigned char* lds, const Gemm g, const Sched& S, const Epi& E) {
    int tid = threadIdx.x; asm volatile("" : "+v"(tid));
    const int wid = __builtin_amdgcn_readfirstlane(tid >> 6), lane = tid & 63, wr = wid >> 2, wc = wid & 3, fr = lane & 15, fq = lane >> 4;
    const int K = g.K, nt = K / BK;
    unsigned voffA[2], voffB[2];
#pragma unroll
    for (int i = 0; i < 2; ++i) { int R, C; stage_rc(tid * 16 + i * 8192, R, C); const int Rb = Epi::PERM ? ((R & ~31) + perm32(R & 31)) : R;
        voffA[i] = (unsigned)(R * K + C) * 2u; voffB[i] = (unsigned)(Rb * K + C) * 2u; }
    const size_t kstep = (size_t)(BK * 2);
    const size_t hstep = (size_t)HALF * K * 2;
    const size_t tstep = 2 * hstep;
    const unsigned ldsw = (unsigned)wid * 1024u;
    const int aoff = lds_byte(wr * 64 + fr, fq * 8), boff = lds_byte(wc * 32 + fr, fq * 8);
#define PG8_SA(b, h) (((b) * 2 + (h)) * HTB)
#define PG8_SB(b, h) ((4 + (b) * 2 + (h)) * HTB)
#define PG8_STAGE(bufoff, gbase, voff) do { _Pragma("unroll") for (int _i = 0; _i < 2; ++_i) \
        __builtin_amdgcn_global_load_lds((const unsigned*)((const char*)(gbase) + (voff)[_i]), (PG8_LAS unsigned*)(lds + (bufoff) + ldsw + _i * 8192), 16, 0, 0); } while (0)
#define PG8_LDA(dst, b, h) do { _Pragma("unroll") for (int m = 0; m < 4; ++m) _Pragma("unroll") for (int k = 0; k < 2; ++k) dst[m][k] = *(const PG8_LAS bf16x8*)(lds + PG8_SA(b, h) + aoff + m * 2048 + k * 1024); } while (0)
#define PG8_LDB(dst, b, h) do { _Pragma("unroll") for (int n = 0; n < 2; ++n) _Pragma("unroll") for (int k = 0; k < 2; ++k) dst[n][k] = *(const PG8_LAS bf16x8*)(lds + PG8_SB(b, h) + boff + n * 2048 + k * 1024); } while (0)
#define PG8_MMA(ai, bj, At, Bt) do { __builtin_amdgcn_s_setprio(1); _Pragma("unroll") for (int m = 0; m < 4; ++m) _Pragma("unroll") for (int n = 0; n < 2; ++n) _Pragma("unroll") for (int k = 0; k < 2; ++k) \
        acc[ai][bj][m][n] = __builtin_amdgcn_mfma_f32_16x16x32_bf16(Bt[n][k], At[m][k], acc[ai][bj][m][n], 0, 0, 0); __builtin_amdgcn_s_setprio(0); } while (0)
#define PG8_WAIT_V(n) asm volatile("s_waitcnt vmcnt(" #n ")" ::: "memory")
#define PG8_WAIT_L(n) asm volatile("s_waitcnt lgkmcnt(" #n ")" ::: "memory")
#define PG8_BAR __builtin_amdgcn_s_barrier()
#define PG8_SCHED __builtin_amdgcn_sched_barrier(0)
    Unit cur, nxt; int ui = 0;
    if (!S.next(0, cur)) return;
    f32x4 acc[2][2][4][2];
    if constexpr (Epi::INIT) E.init(acc, cur, wr, wc, fr, fq);
    else {
#pragma unroll
    for (int a = 0; a < 2; ++a)
#pragma unroll
        for (int b = 0; b < 2; ++b)
#pragma unroll
            for (int m = 0; m < 4; ++m)
#pragma unroll
                for (int n = 0; n < 2; ++n) acc[a][b][m][n] = (f32x4){0.f, 0.f, 0.f, 0.f};
    }
    bf16x8 At[4][2], B0[2][2], B1[2][2];
    const char* cA = (const char*)g.A + (size_t)cur.pm * tstep; const char* cB = (const char*)g.Bt + (size_t)cur.pn * tstep;
    S.a_ready(cur);
    if constexpr (SP2) {
        PG8_STAGE(PG8_SB(0, 0), cB, voffB); PG8_STAGE(PG8_SB(0, 1), cB + hstep, voffB); PG8_STAGE(PG8_SA(0, 0), cA, voffA); PG8_STAGE(PG8_SA(0, 1), cA + hstep, voffA);
        if (wr == 1) PG8_BAR;
        PG8_WAIT_V(2); PG8_BAR;
        PG8_STAGE(PG8_SB(1, 0), cB + kstep, voffB); PG8_STAGE(PG8_SA(1, 0), cA + kstep, voffA); PG8_STAGE(PG8_SB(1, 1), cB + hstep + kstep, voffB);
        PG8_WAIT_V(6); PG8_BAR;
    } else {
        PG8_STAGE(PG8_SB(0, 0), cB, voffB); PG8_STAGE(PG8_SA(0, 0), cA, voffA); PG8_STAGE(PG8_SB(0, 1), cB + hstep, voffB); PG8_STAGE(PG8_SA(0, 1), cA + hstep, voffA);
        if (wr == 1) PG8_BAR;
        PG8_WAIT_V(4); PG8_BAR;
        PG8_STAGE(PG8_SB(1, 0), cB + kstep, voffB); PG8_STAGE(PG8_SA(1, 0), cA + kstep, voffA); PG8_STAGE(PG8_SB(1, 1), cB + hstep + kstep, voffB);
        PG8_WAIT_V(6); PG8_BAR;
    }
    for (;;) {
        const bool has_next = S.next(ui + 1, nxt);
        const char* nA = has_next ? (const char*)g.A + (size_t)nxt.pm * tstep : cA; const char* nB = has_next ? (const char*)g.Bt + (size_t)nxt.pn * tstep : cB;
        for (int t = 0; t < nt; t += 2) {
            const bool last = (t == nt - 2);
            const char* a1 = cA + (size_t)(t + 1) * kstep;
            const char* a2 = last ? nA : cA + (size_t)(t + 2) * kstep; const char* b2 = last ? nB : cB + (size_t)(t + 2) * kstep;
            const char* a3 = a2 + kstep; const char* b3 = b2 + kstep;
            if (last && has_next) S.a_ready(nxt);
            if constexpr (SP2) {
            PG8_LDB(B0, 0, 0); PG8_LDB(B1, 0, 1); PG8_SCHED; PG8_LDA(At, 0, 0); PG8_STAGE(PG8_SA(1, 1), a1 + hstep, voffA);
            PG8_WAIT_V(8); PG8_WAIT_L(0); PG8_BAR; PG8_MMA(0, 0, At, B0); PG8_MMA(0, 1, At, B1); PG8_BAR; PG8_SCHED;
            PG8_LDA(At, 0, 1); PG8_STAGE(PG8_SB(0, 0), b2, voffB); PG8_STAGE(PG8_SB(0, 1), b2 + hstep, voffB); PG8_STAGE(PG8_SA(0, 0), a2, voffA);
            PG8_WAIT_V(8); PG8_WAIT_L(0); PG8_BAR; PG8_MMA(1, 0, At, B0); PG8_MMA(1, 1, At, B1); PG8_BAR; PG8_SCHED;
            PG8_LDB(B0, 1, 0); PG8_LDB(B1, 1, 1); PG8_SCHED; PG8_LDA(At, 1, 0); PG8_STAGE(PG8_SA(0, 1), a2 + hstep, voffA);
            PG8_WAIT_V(8); PG8_WAIT_L(0); PG8_BAR; PG8_MMA(0, 0, At, B0); PG8_MMA(0, 1, At, B1); PG8_BAR; PG8_SCHED;
            PG8_LDA(At, 1, 1); PG8_STAGE(PG8_SB(1, 0), b3, voffB); PG8_STAGE(PG8_SB(1, 1), b3 + hstep, voffB); PG8_STAGE(PG8_SA(1, 0), a3, voffA);
            PG8_WAIT_V(8); PG8_WAIT_L(0); PG8_BAR; PG8_MMA(1, 0, At, B0); PG8_MMA(1, 1, At, B1); PG8_BAR; PG8_SCHED;
            } else {
            PG8_LDB(B0, 0, 0); PG8_SCHED; PG8_LDA(At, 0, 0); PG8_STAGE(PG8_SA(1, 1), a1 + hstep, voffA);
            PG8_WAIT_L(8); PG8_BAR; PG8_WAIT_L(0); PG8_MMA(0, 0, At, B0); PG8_BAR; PG8_SCHED;
            PG8_LDB(B1, 0, 1); PG8_STAGE(PG8_SB(0, 0), b2, voffB);
            PG8_BAR; PG8_WAIT_L(0); PG8_MMA(0, 1, At, B1); PG8_BAR;
            PG8_LDA(At, 0, 1); PG8_STAGE(PG8_SA(0, 0), a2, voffA);
            PG8_BAR; PG8_WAIT_L(0); PG8_MMA(1, 0, At, B0); PG8_BAR; PG8_SCHED;
            PG8_STAGE(PG8_SB(0, 1), b2 + hstep, voffB);
            PG8_WAIT_V(6); PG8_BAR; PG8_MMA(1, 1, At, B1); PG8_BAR;
            PG8_LDB(B0, 1, 0); PG8_SCHED; PG8_LDA(At, 1, 0); PG8_STAGE(PG8_SA(0, 1), a2 + hstep, voffA);
            PG8_WAIT_L(8); PG8_BAR; PG8_WAIT_L(0); PG8_MMA(0, 0, At, B0); PG8_BAR; PG8_SCHED;
            PG8_LDB(B1, 1, 1); PG8_STAGE(PG8_SB(1, 0), b3, voffB);
            PG8_BAR; PG8_WAIT_L(0); PG8_MMA(0, 1, At, B1); PG8_BAR;
            PG8_LDA(At, 1, 1); PG8_STAGE(PG8_SA(1, 0), a3, voffA);
            PG8_BAR; PG8_WAIT_L(0); PG8_MMA(1, 0, At, B0); PG8_BAR; PG8_SCHED;
            PG8_STAGE(PG8_SB(1, 1), b3 + hstep, voffB);
            PG8_WAIT_V(6); PG8_BAR; PG8_MMA(1, 1, At, B1); PG8_BAR;
            }
        }
        if constexpr (ALIGN_EPI) { if (wr == 0) PG8_BAR; }
        if constexpr (!Epi::AFTER_DRAIN) { E(acc, cur, wr, wc, fr, fq); S.done(cur); }
        if (!has_next) break;
#pragma unroll
        for (int a = 0; a < 2; ++a)
#pragma unroll
            for (int b = 0; b < 2; ++b)
#pragma unroll
                for (int m = 0; m < 4; ++m)
#pragma unroll
                    for (int n = 0; n < 2; ++n) acc[a][b][m][n] = (f32x4){0.f, 0.f, 0.f, 0.f};
        cur = nxt; cA = nA; cB = nB; ++ui;
        if constexpr (ALIGN_EPI) { if (wr == 1) PG8_BAR; }
    }
    PG8_WAIT_V(0);
    if constexpr (!ALIGN_EPI) { if (wr == 0) PG8_BAR; }
    PG8_BAR;
    if constexpr (Epi::AFTER_DRAIN) { E.fused(acc, cur, wr, wc, fr, fq, lds, wid, lane); S.done(cur); }
#undef PG8_SA
#undef PG8_SB
#undef PG8_STAGE
#undef PG8_LDA
#undef PG8_LDB
#undef PG8_MMA
#undef PG8_WAIT_V
#undef PG8_WAIT_L
#undef PG8_BAR
#undef PG8_SCHED
}
}

namespace mk {
using pg8::bf16_t; using pg8::bf16x8; using pg8::f32x4; using pg8::u32x4; using pg8::Unit;
#define LAS __attribute__((address_space(3)))
typedef float f32x16 __attribute__((ext_vector_type(16)));
typedef float f32x2 __attribute__((ext_vector_type(2)));
typedef float f32x2_ __attribute__((ext_vector_type(2)));
typedef short s16x4 __attribute__((ext_vector_type(4)));
typedef unsigned u32x2 __attribute__((ext_vector_type(2)));
typedef __bf16 bf16x2_t __attribute__((ext_vector_type(2)));
__device__ __forceinline__ unsigned cvt_pk_bf16(float lo, float hi) { const f32x2_ v = {lo, hi}; return __builtin_bit_cast(unsigned, __builtin_convertvector(v, bf16x2_t)); }

constexpr int DM = 2048, SEQ = 8192, NMETA = 16, LTOK = SEQ + NMETA, MPAD = 8448;
constexpr int RW = 1024, RH = 4, RD = 256, CW = 1024, CK = 31, INW = 7168;
constexpr float EPS = 1e-6f;
constexpr int NTHREADS = 512, GRID = 256;
constexpr size_t MiB = 1u << 20;
constexpr size_t WS_CTL = 0, CTL_ZERO_BYTES = 1 * MiB;
constexpr size_t WS_RSTD = 1 * MiB;
constexpr size_t WS_PSUM = 1 * MiB + 64 * 1024;
constexpr size_t WS_WOUT = 2 * MiB;
constexpr size_t WS_WPW = 10 * MiB;
constexpr size_t WS_WIN = 12 * MiB;
constexpr size_t WS_HB = 40 * MiB;
constexpr size_t WS_COS = 73 * MiB;
constexpr size_t WS_SIN = 77 * MiB + 256 * 1024;
constexpr size_t WS_QT = 82 * MiB;
constexpr size_t WS_KT = 98 * MiB;
constexpr size_t WS_V = 115 * MiB;
constexpr size_t WS_U = 132 * MiB;
constexpr size_t WS_GY = 149 * MiB;
constexpr size_t WS_CB = 181 * MiB;
constexpr size_t WS_ST = 197 * MiB;
constexpr size_t WS_END = 229 * MiB;
static_assert(WS_COS + (size_t)LTOK * 128 * 4 <= WS_SIN && WS_SIN + (size_t)LTOK * 128 * 4 <= WS_QT && WS_HB + (size_t)MPAD * DM * 2 <= WS_COS, "ws map");
__device__ __forceinline__ bf16_t* kvt_tile(unsigned char* ws, int t) { return (bf16_t*)(ws + WS_ST + (size_t)t * 131072); }
constexpr int CW_BAR = 4096;
constexpr int CW_YR = 14656;
constexpr int CW_PANEL = 12544;
constexpr int CW_CONV = 8448, CW_GC = 10496;
constexpr int CW_MID = 8192, CW_META = 8256, CW_Q = 8320;
constexpr int LDS_MAIN = 147456, MISC_OFF = LDS_MAIN, LDS_BYTES = LDS_MAIN + 1024;

__device__ __constant__ const float kLog2G[4] = {-0.045803689613124755f, -0.022720076500083796f, -0.011315313227834148f, -0.005646563141142062f};

#define LDS_WAIT() asm volatile("s_waitcnt lgkmcnt(0)" ::: "memory")
#define MFMA32(a, b, c) __builtin_amdgcn_mfma_f32_32x32x16_bf16((a), (b), (c), 0, 0, 0)
template <int CTRL> __device__ __forceinline__ float dpp_mov(float x) { return __builtin_bit_cast(float, __builtin_amdgcn_update_dpp(0, __builtin_bit_cast(int, x), CTRL, 0xF, 0xF, true)); }
__device__ __forceinline__ float sum16(float x) { x += dpp_mov<0xB1>(x); x += dpp_mov<0x4E>(x); x += dpp_mov<0x141>(x); x += dpp_mov<0x140>(x); return x; }
__device__ __forceinline__ float sum32(float x) { x = sum16(x); x += __builtin_bit_cast(float, __builtin_amdgcn_ds_swizzle(__builtin_bit_cast(int, x), 0x401F)); return x; }
__device__ __forceinline__ float wave_sum(float v) { v = sum32(v); return v + __shfl_xor(v, 32); }
__device__ __forceinline__ float sigmoid_f(float x) { return __builtin_amdgcn_rcpf(1.0f + __expf(-x)); }
__device__ __forceinline__ float silu_f(float x) { return x * sigmoid_f(x); }
__device__ __forceinline__ float bf_lo(unsigned w) { return __uint_as_float(w << 16); }
__device__ __forceinline__ float bf_hi(unsigned w) { return __uint_as_float(w & 0xffff0000u); }
__device__ __forceinline__ u32x4 pack8(const f32x4 a, const f32x4 b) { u32x4 w; w.x = cvt_pk_bf16(a[0], a[1]); w.y = cvt_pk_bf16(a[2], a[3]); w.z = cvt_pk_bf16(b[0], b[1]); w.w = cvt_pk_bf16(b[2], b[3]); return w; }
__device__ __forceinline__ void st8_sc1(void* p, u32x2 v) { asm volatile("global_store_dwordx2 %0, %1, off sc1\n\ts_nop 1" :: "v"(p), "v"(v) : "memory"); }
__device__ __forceinline__ void st16_sc1(void* p, u32x4 v) { asm volatile("global_store_dwordx4 %0, %1, off sc1\n\ts_nop 1" :: "v"(p), "v"(v) : "memory"); }
__device__ __forceinline__ int crow(int reg, int hh) { return (reg & 3) + 8 * (reg >> 2) + 4 * hh; }
__device__ __forceinline__ s16x4 tr_read(LAS unsigned char* p) { return __builtin_amdgcn_ds_read_tr16_b64_v4i16((LAS s16x4*)p); }

#define XB_TMO      128
#define XB_XCNT(j)  (256  + 64 * (j))
#define XB_XSUB(j)  (1280 + 64 * (j))
#define XB_XGEN(j)  (2304 + 64 * (j))
#define XB_TOP      3328
#define XB_TOPGEN   3392
#define XCD_BAR_WORDS 3456
#define XB_SPIN_CAP (1u << 18)
__device__ __forceinline__ unsigned xb_ld(unsigned* p)              { return __hip_atomic_load(p, __ATOMIC_RELAXED, __HIP_MEMORY_SCOPE_AGENT); }
__device__ __forceinline__ unsigned xb_add(unsigned* p, unsigned v) { return __hip_atomic_fetch_add(p, v, __ATOMIC_RELAXED, __HIP_MEMORY_SCOPE_AGENT); }
__device__ __forceinline__ unsigned xb_xcc_id() { return (unsigned)__builtin_amdgcn_s_getreg((3 << 11) | 20) & 0xFu; }
#define XB_SPIN(cond, bar) do { unsigned _sp = 0; while (cond) { __builtin_amdgcn_s_sleep(1); \
    if ((++_sp & 255u) == 0u) { if (xb_ld(&(bar)[XB_TMO])) break; if (_sp > XB_SPIN_CAP) { atomicAdd(&(bar)[XB_TMO], 1u); break; } } } } while (0)
struct XcdBarrier { unsigned* bar; unsigned x; volatile LAS unsigned* st; };
__device__ __forceinline__ XcdBarrier xcd_barrier_post(unsigned* bar, volatile LAS unsigned* st) {
    XcdBarrier b; b.bar = bar; b.x = xb_xcc_id(); b.st = st;
    if (threadIdx.x == 0) (void)xb_add(&bar[XB_XCNT(b.x)], 1u);
    return b;
}
__device__ __forceinline__ void xcd_barrier_complete(unsigned* bar, unsigned x, unsigned& nloc, unsigned& nx) {
    const unsigned G = gridDim.x * gridDim.y * gridDim.z;
    unsigned sum, cnt, mine, sp = 0u;
    for (;;) {
        sum = 0u; cnt = 0u; mine = 0u;
#pragma unroll
        for (unsigned j = 0; j < 16; ++j) { const unsigned c = xb_ld(&bar[XB_XCNT(j)]); sum += c; cnt += (c > 0u) ? 1u : 0u; mine = (j == x) ? c : mine; }
        if (sum == G) break;
        __builtin_amdgcn_s_sleep(1);
        if ((++sp & 255u) == 0u) { if (xb_ld(&bar[XB_TMO])) break; if (sp > XB_SPIN_CAP) { atomicAdd(&bar[XB_TMO], 1u); break; } }
    }
    nloc = mine > 0u ? mine : 1u; nx = cnt > 0u ? cnt : 1u;
}
__device__ __forceinline__ void xcd_barrier(const XcdBarrier& b) {
    asm volatile("s_waitcnt vmcnt(0)" ::: "memory");
    __syncthreads();
    if (threadIdx.x == 0) {
        unsigned* bar = b.bar;
        __builtin_amdgcn_s_waitcnt(0);
        unsigned nloc = b.st[0], nx = b.st[1];
        if (nloc == 0u) { xcd_barrier_complete(bar, b.x, nloc, nx); b.st[0] = nloc; b.st[1] = nx; }
        const unsigned old = xb_add(&bar[XB_XSUB(b.x)], 1u);
        const unsigned gen = old / nloc;
        if (old + 1u == (gen + 1u) * nloc) {
            __builtin_amdgcn_fence(__ATOMIC_RELEASE, "agent");
            asm volatile("s_waitcnt vmcnt(0)" ::: "memory");
            const unsigned og = xb_add(&bar[XB_TOP], 1u);
            const unsigned tg = og / nx;
            if (og + 1u == (tg + 1u) * nx) xb_add(&bar[XB_TOPGEN], 1u);
            else XB_SPIN(xb_ld(&bar[XB_TOPGEN]) == tg, bar);
            __builtin_amdgcn_fence(__ATOMIC_ACQUIRE, "agent");
            xb_add(&bar[XB_XGEN(b.x)], 1u);
            asm volatile("s_waitcnt vmcnt(0)" ::: "memory");
        } else {
            XB_SPIN(xb_ld(&bar[XB_XGEN(b.x)]) == gen, bar);
            __builtin_amdgcn_fence(__ATOMIC_ACQUIRE, "agent");
            asm volatile("s_waitcnt vmcnt(0)" ::: "memory");
        }
    }
    __syncthreads();
}

__device__ __forceinline__ void xcd_barrier_arrive(const XcdBarrier& b, unsigned& tok, unsigned& tok2) {
    asm volatile("s_waitcnt vmcnt(0)" ::: "memory");
    __syncthreads();
    tok = 0u; tok2 = 0u;
    if (threadIdx.x == 0) {
        unsigned* bar = b.bar;
        __builtin_amdgcn_s_waitcnt(0);
        unsigned nloc = b.st[0], nx = b.st[1];
        if (nloc == 0u) { xcd_barrier_complete(bar, b.x, nloc, nx); b.st[0] = nloc; b.st[1] = nx; }
        const unsigned old = xb_add(&bar[XB_XSUB(b.x)], 1u);
        const unsigned gen = old / nloc;
        tok = gen & 0x3FFFFFFFu;
        if (old + 1u == (gen + 1u) * nloc) {
            __builtin_amdgcn_fence(__ATOMIC_RELEASE, "agent");
            asm volatile("s_waitcnt vmcnt(0)" ::: "memory");
            const unsigned og = xb_add(&bar[XB_TOP], 1u);
            const unsigned tg = og / nx;
            tok |= 1u << 30; tok2 = tg;
            if (og + 1u == (tg + 1u) * nx) { xb_add(&bar[XB_TOPGEN], 1u); tok |= 1u << 31; }
        }
    }
}
__device__ __forceinline__ void xcd_barrier_wait_t0(const XcdBarrier& b, unsigned tok, unsigned tok2) {
    unsigned* bar = b.bar;
    const unsigned gen = tok & 0x3FFFFFFFu;
    if (tok & (1u << 30)) {
        if (!(tok & (1u << 31))) XB_SPIN(xb_ld(&bar[XB_TOPGEN]) == tok2, bar);
        __builtin_amdgcn_fence(__ATOMIC_ACQUIRE, "agent");
        xb_add(&bar[XB_XGEN(b.x)], 1u);
        asm volatile("s_waitcnt vmcnt(0)" ::: "memory");
    } else {
        XB_SPIN(xb_ld(&bar[XB_XGEN(b.x)]) == gen, bar);
        __builtin_amdgcn_fence(__ATOMIC_ACQUIRE, "agent");
        asm volatile("s_waitcnt vmcnt(0)" ::: "memory");
    }
}

__host__ __device__ __forceinline__ int win_src_col(int nd) {
    if (nd < 4096 || nd >= 6144) return nd;
    const int t = (nd - 4096) >> 8, jj = (nd - 4096) & 255;
    return jj < 128 ? 4096 + 128 * t + jj : 5120 + 128 * t + (jj - 128);
}
__device__ __forceinline__ void p0_transpose_item(const float* __restrict__ W, int K, int N, bf16_t* __restrict__ WT, LAS float* scr, int kb, int n_src0, int n_dst0, int lane) {
    const int k0 = 64 * kb;
    float w[32];
#pragma unroll
    for (int i = 0; i < 32; ++i) w[i] = __builtin_nontemporal_load(W + (size_t)(k0 + 2 * i + (lane >> 5)) * N + n_src0 + (lane & 31));
#pragma unroll
    for (int i = 0; i < 32; ++i) scr[(2 * i + (lane >> 5)) * 33 + (lane & 31)] = w[i];
    LDS_WAIT(); asm volatile("" ::: "memory");
    const int c = lane & 7;
#pragma unroll
    for (int j = 0; j < 4; ++j) { const int n = (lane >> 3) + 8 * j; const LAS float* s = scr + (8 * c) * 33 + n;
        u32x4 o; o.x = cvt_pk_bf16(s[0 * 33], s[1 * 33]); o.y = cvt_pk_bf16(s[2 * 33], s[3 * 33]); o.z = cvt_pk_bf16(s[4 * 33], s[5 * 33]); o.w = cvt_pk_bf16(s[6 * 33], s[7 * 33]);
        st16_sc1(WT + (size_t)(n_dst0 + n) * K + k0 + 8 * c, o); }
    LDS_WAIT(); asm volatile("" ::: "memory");
}
__device__ __forceinline__ void p0_row(const float* __restrict__ src, bf16_t* __restrict__ dst, float* rstd_out, const f32x4 (&g)[8], int lane) {
    f32x4 v[8]; float s = 0.f;
#pragma unroll
    for (int j = 0; j < 8; ++j) v[j] = src ? __builtin_nontemporal_load((const f32x4*)src + lane + 64 * j) : (f32x4){0.f, 0.f, 0.f, 0.f};
#pragma unroll
    for (int j = 0; j < 8; ++j) s += (v[j][0] * v[j][0] + v[j][1] * v[j][1]) + (v[j][2] * v[j][2] + v[j][3] * v[j][3]);
    s = wave_sum(s);
    const float rs = src ? 1.0f / sqrtf(s * (1.0f / DM) + EPS) : 0.f;
    if (lane == 0) *rstd_out = rs;
#pragma unroll
    for (int j = 0; j < 8; ++j) { const f32x4 y = v[j] * g[j] * rs; u32x2 o; o.x = cvt_pk_bf16(y[0], y[1]); o.y = cvt_pk_bf16(y[2], y[3]); st8_sc1((u32x2*)dst + lane + 64 * j, o); }
}
__device__ __forceinline__ void p0_prologue(LAS unsigned char* lds, const float* x, const float* meta, const float* ln_g, const float* w_in, const float* pw_w, const float* w_out,
                                            unsigned char* ws, int b, int tid, int wid, int lane) {
    LAS float* scr = (LAS float*)(lds + wid * 16384);
    const int gw = b * 8 + wid, NGW = GRID * 8;
    bf16_t* Win = (bf16_t*)(ws + WS_WIN); bf16_t* Wout = (bf16_t*)(ws + WS_WOUT); bf16_t* Wpw = (bf16_t*)(ws + WS_WPW);
    constexpr int I_IN = 32 * 224, I_OUT = 32 * 64, I_PW = 16 * 32;
    for (int it = gw; it < I_IN + I_OUT + I_PW; it += NGW) {
        int r = it;
        if (r < I_IN) { const int kb = r / 224, nb = r % 224; p0_transpose_item(w_in, DM, INW, Win, scr, kb, win_src_col(32 * nb), 32 * nb, lane); continue; } r -= I_IN;
        if (r < I_OUT) { const int kb = r / 64, nb = r % 64; p0_transpose_item(w_out, DM, DM, Wout, scr, kb, 32 * nb, 32 * nb, lane); continue; } r -= I_OUT;
        { const int kb = r / 32, nb = r % 32; p0_transpose_item(pw_w, CW, CW, Wpw, scr, kb, 32 * nb, 32 * nb, lane); }
    }
    bf16_t* HB = (bf16_t*)(ws + WS_HB); float* rstd = (float*)(ws + WS_RSTD);
    f32x4 gl[8];
#pragma unroll
    for (int j = 0; j < 8; ++j) gl[j] = ((const f32x4*)ln_g)[lane + 64 * j];
    for (int r = gw; r < MPAD; r += NGW) {
        const float* src = r < SEQ ? x + (size_t)r * DM : (r < LTOK ? meta + (size_t)(r - SEQ) * DM : nullptr);
        p0_row(src, HB + (size_t)r * DM, rstd + r, gl, lane);
    }
    float* cosT = (float*)(ws + WS_COS); float* sinT = (float*)(ws + WS_SIN);
    const int gid = b * NTHREADS + tid, i = gid & 127;
    const double inv = exp2(-(double)i * 0.10381025296523007);
    for (int pos = gid >> 7; pos < LTOK; pos += (GRID * NTHREADS) >> 7) {
        const double a = (double)pos * inv;
        const double n = rint(a * 0.15915494309189535);
        const float rr = (float)fma(-n, 6.283185307179586, a);
        float sn, cs; sincosf(rr, &sn, &cs);
        cosT[(size_t)pos * 128 + i] = cs; sinT[(size_t)pos * 128 + i] = sn;
    }
}

__device__ __forceinline__ void wait_count(unsigned* p, unsigned want) {
    unsigned sp = 0;
    while (__hip_atomic_load(p, __ATOMIC_RELAXED, __HIP_MEMORY_SCOPE_AGENT) < want) { __builtin_amdgcn_s_sleep(2); if (++sp > (1u << 20)) break; }
}
struct Sched1 { int c; unsigned* ctl;
    __device__ __forceinline__ bool next(int i, Unit& u) const {
        const bool mb = (c >= 145) && (c <= 175) && (c & 1);
        if (mb && i == 2) { const int t = (c - 145) >> 1; u.pm = 32; u.pn = t < 8 ? 4 + t : 8 + t; return true; }
        const int L = (mb && i == 3 ? 2 : i) * GRID + c;
        if (i < 4 && L < 896) { const int xcd = L & 7, off = L >> 3, wg = xcd * 112 + off, gid = wg / 224, rem = wg % 224; u.pm = gid * 8 + (rem & 7); u.pn = rem >> 3; return true; }
        return false;
    }
    __device__ __forceinline__ void a_ready(const Unit&) const {}
    __device__ __forceinline__ void done(const Unit& u) const {
        Unit t3; (void)next(2, t3);
        const bool third = (u.pm == t3.pm && u.pn == t3.pn), meta = (u.pm == 32), gc = (u.pn >= 24);
        if (third || meta || gc) {
            asm volatile("s_waitcnt vmcnt(0)" ::: "memory");
            __syncthreads();
            if (threadIdx.x == 0) {
                if (meta) __hip_atomic_fetch_add(ctl + CW_META, 1u, __ATOMIC_RELAXED, __HIP_MEMORY_SCOPE_AGENT);
                if (third) __hip_atomic_fetch_add(ctl + CW_MID, 1u, __ATOMIC_RELAXED, __HIP_MEMORY_SCOPE_AGENT);
                if (gc) __hip_atomic_fetch_add(ctl + CW_GC + 64 * u.pm, 1u, __ATOMIC_RELAXED, __HIP_MEMORY_SCOPE_AGENT);
            }
        }
    }
};
struct Epi1 {
    static constexpr bool PERM = true, AFTER_DRAIN = false, INIT = false;
    bf16_t *Qt, *Kt, *V, *U, *GY; const float *rstd, *cosT, *sinT;
    __device__ __forceinline__ void operator()(const f32x4 (&acc)[2][2][4][2], const Unit& u, int wr, int wc, int fr, int fq) const {
        const int pn = u.pn; const bool meta = (u.pm == 32);
        if (meta && wr != 0) return;
        const int cl = wc * 32 + 8 * fq;
#pragma unroll
        for (int ai = 0; ai < 2; ++ai)
#pragma unroll
            for (int m = 0; m < 4; ++m) {
                if (meta && (ai | m)) continue;
                const int r = u.pm * 256 + ai * 128 + wr * 64 + m * 16 + fr;
                if (pn < 8) {
                    const int head = pn & 3; const bool isk = pn >= 4;
                    const int pos = meta ? (r - SEQ) : (r + NMETA);
                    const int il = meta ? (112 + r - SEQ) : (r & 127);
                    const float l2g = kLog2G[head];
                    const float dec = isk ? 0.0625f * exp2f((float)(127 - il) * l2g) : exp2f((float)(il + 1) * l2g);
                    const f32x4* cp = (const f32x4*)(cosT + (size_t)pos * 128 + cl); const f32x4* sp = (const f32x4*)(sinT + (size_t)pos * 128 + cl);
                    f32x4 o1[2], o2[2];
#pragma unroll
                    for (int n = 0; n < 2; ++n) { const f32x4 c = cp[n], s = sp[n], x1 = acc[ai][0][m][n], x2 = acc[ai][1][m][n];
                        o1[n] = (x1 * c - x2 * s) * dec; o2[n] = (x1 * s + x2 * c) * dec; }
                    bf16_t* dst = (isk ? Kt : Qt) + (size_t)r * RW + head * 256 + cl;
                    if (isk) { st16_sc1(dst, pack8(o1[0], o1[1])); st16_sc1(dst + 128, pack8(o2[0], o2[1])); }
                    else { *(u32x4*)dst = pack8(o1[0], o1[1]); *(u32x4*)(dst + 128) = pack8(o2[0], o2[1]); }
                } else if (pn < 12) {
                    bf16_t* dst = V + (size_t)r * RW + (pn - 8) * 256 + cl;
#pragma unroll
                    for (int bj = 0; bj < 2; ++bj) st16_sc1(dst + 128 * bj, pack8(acc[ai][bj][m][0], acc[ai][bj][m][1]));
                } else if (pn < 16 || pn >= 24) {
                    bf16_t* dst = GY + (size_t)r * DM + (pn < 16 ? (pn - 12) * 256 : 1024 + (pn - 24) * 256) + cl;
#pragma unroll
                    for (int bj = 0; bj < 2; ++bj) { f32x4 g0 = acc[ai][bj][m][0], g1 = acc[ai][bj][m][1];
#pragma unroll
                        for (int e = 0; e < 4; ++e) { g0[e] = silu_f(g0[e]); g1[e] = silu_f(g1[e]); }
                        if (pn >= 24) st16_sc1(dst + 128 * bj, pack8(g0, g1)); else *(u32x4*)(dst + 128 * bj) = pack8(g0, g1); }
                } else {
                    f32x4 u0 = acc[ai][0][m][0], u1 = acc[ai][0][m][1]; const f32x4 b0 = acc[ai][1][m][0], b1 = acc[ai][1][m][1];
#pragma unroll
                    for (int e = 0; e < 4; ++e) { u0[e] *= sigmoid_f(b0[e]); u1[e] *= sigmoid_f(b1[e]); }
                    st16_sc1(U + (size_t)r * CW + (pn - 16) * 128 + cl, pack8(u0, u1));
                }
            }
    }
};

__device__ __forceinline__ void p2a_kv(LAS unsigned char* lds, const bf16_t* __restrict__ Kt, const bf16_t* __restrict__ V, bf16_t* __restrict__ KVT, int c, int h, int tid, int wid, int lane) {
    constexpr int PT = 576, PR = 528;
    LAS unsigned char* imgK = lds; LAS unsigned char* imgV = lds + 128 * PT;
    {
        u32x4 kreg[8], vreg[8];
#pragma unroll
        for (int it = 0; it < 8; ++it) {
            const int ci = tid + NTHREADS * it, row = ci >> 5, cc = ci & 31;
            const size_t grow = c > 0 ? (size_t)(c - 1) * 128 + row : (size_t)(SEQ + (row >= 112 ? row - 112 : 0));
            kreg[it] = *(const u32x4*)(Kt + grow * RW + h * 256 + cc * 8); vreg[it] = *(const u32x4*)(V + grow * RW + h * 256 + cc * 8);
        }
#pragma unroll
        for (int it = 0; it < 8; ++it) {
            const int ci = tid + NTHREADS * it, row = ci >> 5, cc = ci & 31;
            const bool valid = (c > 0) || (row >= 112);
            u32x4 kv = kreg[it], vv = vreg[it];
            if (!valid) { kv = (u32x4){0u, 0u, 0u, 0u}; vv = kv; }
            *(LAS u32x4*)(imgK + row * PT + cc * 16) = kv; *(LAS u32x4*)(imgV + row * PT + cc * 16) = vv;
        }
    }
    __syncthreads();
    const int w2 = wid >> 2, w4 = wid & 3, n31 = lane & 31, i16 = lane & 15, q4 = i16 >> 2, p4 = i16 & 3, blk = (lane >> 4) & 1, hh = lane >> 5;
    f32x16 acc[4][2];
#pragma unroll
    for (int a = 0; a < 4; ++a)
#pragma unroll
        for (int b2 = 0; b2 < 2; ++b2)
#pragma unroll
            for (int e = 0; e < 16; ++e) acc[a][b2][e] = 0.f;
#pragma unroll
    for (int ks = 0; ks < 8; ++ks) {
        const int tok = 16 * ks + 8 * hh + q4;
        bf16x8 af[4], bf[2];
#pragma unroll
        for (int a = 0; a < 4; ++a) { const int col0 = 128 * w2 + 32 * a + 16 * blk + 4 * p4;
            const s16x4 lo = tr_read(imgK + tok * PT + col0 * 2), hi = tr_read(imgK + (tok + 4) * PT + col0 * 2);
            af[a] = __builtin_shufflevector(lo, hi, 0, 1, 2, 3, 4, 5, 6, 7); }
#pragma unroll
        for (int b2 = 0; b2 < 2; ++b2) { const int col0 = 64 * w4 + 32 * b2 + 16 * blk + 4 * p4;
            const s16x4 lo = tr_read(imgV + tok * PT + col0 * 2), hi = tr_read(imgV + (tok + 4) * PT + col0 * 2);
            bf[b2] = __builtin_shufflevector(lo, hi, 0, 1, 2, 3, 4, 5, 6, 7); }
#pragma unroll
        for (int a = 0; a < 4; ++a)
#pragma unroll
            for (int b2 = 0; b2 < 2; ++b2) acc[a][b2] = MFMA32(af[a], bf[b2], acc[a][b2]);
    }
    __syncthreads();
#pragma unroll
    for (int a = 0; a < 4; ++a)
#pragma unroll
        for (int b2 = 0; b2 < 2; ++b2)
#pragma unroll
            for (int g = 0; g < 4; ++g) { u32x2 o; o.x = cvt_pk_bf16(acc[a][b2][4 * g], acc[a][b2][4 * g + 1]); o.y = cvt_pk_bf16(acc[a][b2][4 * g + 2], acc[a][b2][4 * g + 3]);
                *(LAS u32x2*)(lds + (64 * w4 + 32 * b2 + n31) * PR + (128 * w2 + 32 * a + 8 * g + 4 * hh) * 2) = o; }
    __syncthreads();
    bf16_t* dst = KVT;
#pragma unroll
    for (int it = 0; it < 16; ++it) {
        const int ci = tid + NTHREADS * it, row = ci >> 5, cc = ci & 31;
        *(u32x4*)(dst + (size_t)row * 256 + cc * 8) = *(LAS u32x4*)(lds + row * PR + cc * 16);
    }
    __syncthreads();
}
__device__ __forceinline__ void p2a_conv(LAS unsigned char* lds, const bf16_t* __restrict__ U, const float* __restrict__ dw_w, const float* __restrict__ dw_b, const float* __restrict__ ln_g, const float* __restrict__ ln_b,
                                         bf16_t* __restrict__ CB, int ct, int tid, int wid, int lane) {
    {
        f32x2 w[CK];
#pragma unroll
        for (int j = 0; j < CK; ++j) w[j] = *(const f32x2*)(dw_w + j * CW + 2 * tid);
        const f32x2 bias = *(const f32x2*)(dw_b + 2 * tid);
        f32x2 acc[32];
#pragma unroll
        for (int t = 0; t < 32; ++t) acc[t] = bias;
        const int p0 = 32 * ct + NMETA - (CK - 1);
#pragma unroll
        for (int s = 0; s < 32 + CK - 1; ++s) {
            const int p = p0 + s, pc = p < 0 ? 0 : p, row = pc >= NMETA ? pc - NMETA : SEQ + pc;
            unsigned raw = *(const unsigned*)(U + (size_t)row * CW + 2 * tid);
            if (p < 0) raw = 0u;
            const f32x2 uv = {bf_lo(raw), bf_hi(raw)};
#pragma unroll
            for (int t = (s - (CK - 1) > 0 ? s - (CK - 1) : 0); t <= (s < 31 ? s : 31); ++t) acc[t] = __builtin_elementwise_fma(uv, w[s - t], acc[t]);
        }
#pragma unroll
        for (int t = 0; t < 32; ++t) *(LAS f32x2*)(lds + (t * CW + 2 * tid) * 4) = acc[t];
    }
    __syncthreads();
    {
        f32x4 gg[2][2], bb[2][2];
#pragma unroll
        for (int i = 0; i < 2; ++i)
#pragma unroll
            for (int q = 0; q < 2; ++q) { gg[i][q] = *(const f32x4*)(ln_g + 512 * i + 8 * lane + 4 * q); bb[i][q] = *(const f32x4*)(ln_b + 512 * i + 8 * lane + 4 * q); }
#pragma unroll
        for (int k = 0; k < 4; ++k) {
            const int t = 4 * wid + k;
            f32x4 v[2][2]; float s = 0.f;
#pragma unroll
            for (int i = 0; i < 2; ++i)
#pragma unroll
                for (int q = 0; q < 2; ++q) { v[i][q] = *(LAS f32x4*)(lds + (t * CW + 512 * i + 8 * lane + 4 * q) * 4); s += (v[i][q][0] + v[i][q][1]) + (v[i][q][2] + v[i][q][3]); }
            const float mu = wave_sum(s) * (1.0f / CW);
            float qq = 0.f;
#pragma unroll
            for (int i = 0; i < 2; ++i)
#pragma unroll
                for (int q = 0; q < 2; ++q) { v[i][q] = v[i][q] - mu; qq += (v[i][q][0] * v[i][q][0] + v[i][q][1] * v[i][q][1]) + (v[i][q][2] * v[i][q][2] + v[i][q][3] * v[i][q][3]); }
            const float rs = 1.0f / sqrtf(wave_sum(qq) * (1.0f / CW) + EPS);
#pragma unroll
            for (int i = 0; i < 2; ++i) { f32x4 y0 = v[i][0] * rs * gg[i][0] + bb[i][0], y1 = v[i][1] * rs * gg[i][1] + bb[i][1];
#pragma unroll
                for (int e = 0; e < 4; ++e) { y0[e] = silu_f(y0[e]); y1[e] = silu_f(y1[e]); }
                st16_sc1(CB + (size_t)(32 * ct + t) * CW + 512 * i + 8 * lane, pack8(y0, y1)); }
        }
    }
    asm volatile("s_waitcnt vmcnt(0)" ::: "memory");
    __syncthreads();
}

__device__ __forceinline__ void p2b_scan(bf16_t* ST, int sb, int tid) {
    const int e2 = sb * NTHREADS + tid, h = e2 >> 15;
    const float cd = exp2f(128.0f * kLog2G[h]);
    f32x2 S = {0.f, 0.f};
    unsigned* p = (unsigned*)ST + e2;
#pragma unroll 1
    for (int c0 = 0; c0 < 64; c0 += 16) {
        unsigned kv[16];
#pragma unroll
        for (int j = 0; j < 16; ++j) kv[j] = __builtin_nontemporal_load(p + (size_t)(c0 + j) * 131072);
#pragma unroll
        for (int j = 0; j < 16; ++j) {
            const f32x2 k2 = {bf_lo(kv[j]), bf_hi(kv[j])};
            S = S * cd + k2;
            p[(size_t)(c0 + j) * 131072] = cvt_pk_bf16(S[0], S[1]);
        }
    }
}
struct SchedOne { int pm, pn; bool on;
    __device__ __forceinline__ bool next(int i, Unit& u) const { if (i > 0 || !on) return false; u.pm = pm; u.pn = pn; return true; }
    __device__ __forceinline__ void a_ready(const Unit&) const {}
    __device__ __forceinline__ void done(const Unit&) const {}
};
struct EpiPw {
    static constexpr bool PERM = true, AFTER_DRAIN = false, INIT = false;
    bf16_t* GY; const float* pw_b;
    __device__ __forceinline__ void operator()(const f32x4 (&acc)[2][2][4][2], const Unit& u, int wr, int wc, int fr, int fq) const {
        const int cl = wc * 32 + 8 * fq;
#pragma unroll
        for (int bj = 0; bj < 2; ++bj) {
            const int col = u.pn * 256 + bj * 128 + cl;
            const f32x4 b0 = *(const f32x4*)(pw_b + col), b1 = *(const f32x4*)(pw_b + col + 4);
#pragma unroll
            for (int ai = 0; ai < 2; ++ai)
#pragma unroll
                for (int m = 0; m < 4; ++m) {
                    const int r = u.pm * 256 + ai * 128 + wr * 64 + m * 16 + fr;
                    bf16_t* p = GY + (size_t)r * DM + 1024 + col;
                    const u32x4 g = *(const u32x4*)p;
                    const f32x4 g0 = {bf_lo(g.x), bf_hi(g.x), bf_lo(g.y), bf_hi(g.y)}, g1 = {bf_lo(g.z), bf_hi(g.z), bf_lo(g.w), bf_hi(g.w)};
                    *(u32x4*)p = pack8((acc[ai][bj][m][0] + b0) * g0, (acc[ai][bj][m][1] + b1) * g1);
                }
        }
    }
};

__device__ __forceinline__ void p2c_images(LAS unsigned char* lds, const bf16_t* __restrict__ Qt, const bf16_t* __restrict__ Kt, int xc, int h, int tid) {
    constexpr int PR = 528;
    LAS unsigned char* imgQ = lds; LAS unsigned char* imgK = lds + 73728;
    const size_t row0 = (size_t)xc * 128;
#pragma unroll
    for (int it = 0; it < 8; ++it) {
        const int ci = tid + NTHREADS * it, row = ci >> 5, cc = ci & 31;
        const u32x4 q = __builtin_nontemporal_load((const u32x4*)(Qt + (row0 + row) * RW + h * 256 + cc * 8)), k = __builtin_nontemporal_load((const u32x4*)(Kt + (row0 + row) * RW + h * 256 + cc * 8));
        *(LAS u32x4*)(imgQ + row * PR + cc * 16) = q; *(LAS u32x4*)(imgK + row * PR + cc * 16) = k;
    }
}
__device__ __forceinline__ void p2c_item(LAS unsigned char* lds, const bf16_t* __restrict__ Qt, const bf16_t* __restrict__ Kt, const bf16_t* __restrict__ V, const bf16_t* __restrict__ ST, bf16_t* __restrict__ GY,
                                         const float* __restrict__ gn_g, int xc, int h, int tid, int wid, int lane, const XcdBarrier& bar, bool pending, unsigned tok, unsigned tok2, bool preloaded) {
    constexpr int PR = 528, PT = 576, PF = 1040;
    LAS unsigned char* imgQ = lds; LAS unsigned char* imgK = lds + 73728; LAS unsigned char* imgV = lds + 73728; LAS unsigned char* imgS = lds;
    LAS float* ex = (LAS float*)(lds + 135168);
    const int wr = wid >> 1, wc = wid & 1, n31 = lane & 31, hh = lane >> 5, i16 = lane & 15, q4 = i16 >> 2, p4 = i16 & 3, blk = (lane >> 4) & 1;
    const size_t row0 = (size_t)xc * 128;
    if (!preloaded) p2c_images(lds, Qt, Kt, xc, h, tid);
    u32x4 vreg[8];
#pragma unroll
    for (int it = 0; it < 8; ++it) { const int ci = tid + NTHREADS * it, row = ci >> 5, cc = ci & 31; vreg[it] = __builtin_nontemporal_load((const u32x4*)(V + (row0 + row) * RW + h * 256 + cc * 8)); }
    __syncthreads();
    const float ginv = exp2f(-128.0f * kLog2G[h]);
    bf16x8 pf[4][2];
    {
        bf16x8 qf[16];
#pragma unroll
        for (int ks = 0; ks < 16; ++ks) qf[ks] = *(LAS bf16x8*)(imgQ + (32 * wr + n31) * PR + (16 * ks + 8 * hh) * 2);
#pragma unroll
        for (int jb = 0; jb < 4; ++jb) {
            if (jb <= wr) {
                f32x16 X;
#pragma unroll
                for (int e = 0; e < 16; ++e) X[e] = 0.f;
#pragma unroll
                for (int ks = 0; ks < 16; ++ks) { const bf16x8 kf = *(LAS bf16x8*)(imgK + (32 * jb + n31) * PR + (16 * ks + 8 * hh) * 2); X = MFMA32(kf, qf[ks], X); }
#pragma unroll
                for (int e = 0; e < 16; ++e) { const bool keep = (jb < wr) || (crow(e, hh) <= n31); X[e] = keep ? X[e] * ginv : 0.f; }
#pragma unroll
                for (int s2 = 0; s2 < 2; ++s2) { u32x4 p; p.x = cvt_pk_bf16(X[8 * s2], X[8 * s2 + 1]); p.y = cvt_pk_bf16(X[8 * s2 + 2], X[8 * s2 + 3]); p.z = cvt_pk_bf16(X[8 * s2 + 4], X[8 * s2 + 5]); p.w = cvt_pk_bf16(X[8 * s2 + 6], X[8 * s2 + 7]);
                    pf[jb][s2] = __builtin_bit_cast(bf16x8, p); }
            } else { pf[jb][0] = (bf16x8){0, 0, 0, 0, 0, 0, 0, 0}; pf[jb][1] = pf[jb][0]; }
        }
    }
    if (pending && tid == 0) xcd_barrier_wait_t0(bar, tok, tok2);
    __syncthreads();
#pragma unroll
    for (int it = 0; it < 8; ++it) { const int ci = tid + NTHREADS * it, row = ci >> 5, cc = ci & 31; *(LAS u32x4*)(imgV + row * PT + cc * 16) = vreg[it]; }
    const bf16_t* Ssrc = ST + (size_t)(xc * 4 + h) * 65536;
    u32x4 sreg[8];
#pragma unroll
    for (int it = 0; it < 8; ++it) { const int ci = tid + NTHREADS * it, row = ci >> 5, cc = ci & 31; sreg[it] = __builtin_nontemporal_load((const u32x4*)(Ssrc + (size_t)row * 256 + cc * 8)); }
    __syncthreads();
    f32x16 acc[4];
#pragma unroll
    for (int nb = 0; nb < 4; ++nb)
#pragma unroll
        for (int e = 0; e < 16; ++e) acc[nb][e] = 0.f;
#pragma unroll
    for (int jb = 0; jb < 4; ++jb) {
        if (jb <= wr) {
#pragma unroll
            for (int s2 = 0; s2 < 2; ++s2) {
                const int tok = 32 * jb + 16 * s2 + 4 * hh + q4;
#pragma unroll
                for (int nb = 0; nb < 4; ++nb) { const int col0 = 128 * wc + 32 * nb + 16 * blk + 4 * p4;
                    const s16x4 lo = tr_read(imgV + tok * PT + col0 * 2), hi = tr_read(imgV + (tok + 8) * PT + col0 * 2);
                    const bf16x8 vf = __builtin_shufflevector(lo, hi, 0, 1, 2, 3, 4, 5, 6, 7);
                    acc[nb] = MFMA32(pf[jb][s2], vf, acc[nb]); }
            }
        }
    }
    bf16x8 qf[16];
#pragma unroll
    for (int ks = 0; ks < 16; ++ks) qf[ks] = *(LAS bf16x8*)(imgQ + (32 * wr + n31) * PR + (16 * ks + 8 * hh) * 2);
    __syncthreads();
    {
        u32x4 sreg2[8];
#pragma unroll
        for (int it = 0; it < 8; ++it) { const int ci = tid + NTHREADS * (it + 8), row = ci >> 5, cc = ci & 31; sreg2[it] = __builtin_nontemporal_load((const u32x4*)(Ssrc + (size_t)row * 256 + cc * 8)); }
#pragma unroll
        for (int it = 0; it < 8; ++it) { const int ci = tid + NTHREADS * it, row = ci >> 5, cc = ci & 31; *(LAS u32x4*)(imgS + row * PR + cc * 16) = sreg[it]; }
#pragma unroll
        for (int it = 0; it < 8; ++it) { const int ci = tid + NTHREADS * (it + 8), row = ci >> 5, cc = ci & 31; *(LAS u32x4*)(imgS + row * PR + cc * 16) = sreg2[it]; }
    }
    u32x4 greg[8];
#pragma unroll
    for (int it = 0; it < 8; ++it) { const int ci = tid + NTHREADS * it, row = ci >> 5, cc = ci & 31; greg[it] = __builtin_nontemporal_load((const u32x4*)(GY + (row0 + row) * DM + h * 256 + cc * 8)); }
    __syncthreads();
#pragma unroll
    for (int ks = 0; ks < 16; ++ks)
#pragma unroll
        for (int nb = 0; nb < 4; ++nb) { const bf16x8 sf = *(LAS bf16x8*)(imgS + (128 * wc + 32 * nb + n31) * PR + (16 * ks + 8 * hh) * 2); acc[nb] = MFMA32(qf[ks], sf, acc[nb]); }
    float sm[16], sq[16];
#pragma unroll
    for (int e = 0; e < 16; ++e) {
        float a = (acc[0][e] + acc[1][e]) + (acc[2][e] + acc[3][e]);
        float q = (acc[0][e] * acc[0][e] + acc[1][e] * acc[1][e]) + (acc[2][e] * acc[2][e] + acc[3][e] * acc[3][e]);
        a = sum32(a); q = sum32(q);
        sm[e] = a; sq[e] = q;
        if (n31 == e) { ex[(wid * 32 + crow(e, hh)) * 2] = a; ex[(wid * 32 + crow(e, hh)) * 2 + 1] = q; }
    }
    __syncthreads();
    float gng[4];
#pragma unroll
    for (int nb = 0; nb < 4; ++nb) gng[nb] = gn_g[h * 256 + 128 * wc + 32 * nb + n31];
#pragma unroll
    for (int e = 0; e < 16; ++e) {
        const int rl = crow(e, hh);
        const float ta = sm[e] + ex[((wid ^ 1) * 32 + rl) * 2], tq = sq[e] + ex[((wid ^ 1) * 32 + rl) * 2 + 1];
        const float mu = ta * (1.0f / RD), var = tq * (1.0f / RD) - mu * mu, rs = __builtin_amdgcn_rsqf(fmaxf(var, 0.f) + EPS);
#pragma unroll
        for (int nb = 0; nb < 4; ++nb) *(LAS float*)(lds + (32 * wr + rl) * PF + (128 * wc + 32 * nb + n31) * 4) = (acc[nb][e] - mu) * rs * gng[nb];
    }
    __syncthreads();
#pragma unroll
    for (int it = 0; it < 8; ++it) {
        const int ci = tid + NTHREADS * it, row = ci >> 5, cc = ci & 31;
        const f32x4 y0 = *(LAS f32x4*)(lds + row * PF + cc * 32), y1 = *(LAS f32x4*)(lds + row * PF + cc * 32 + 16);
        const u32x4 g = greg[it];
        const f32x4 g0 = {bf_lo(g.x), bf_hi(g.x), bf_lo(g.y), bf_hi(g.y)}, g1 = {bf_lo(g.z), bf_hi(g.z), bf_lo(g.w), bf_hi(g.w)};
        st16_sc1(GY + (row0 + row) * DM + h * 256 + cc * 8, pack8(y0 * g0, y1 * g1));
    }
    asm volatile("s_waitcnt vmcnt(0)" ::: "memory");
    __syncthreads();
}

struct SchedP3 { int pm, pn; unsigned* cnt; unsigned want;
    __device__ __forceinline__ bool next(int i, Unit& u) const { if (i > 0) return false; u.pm = pm; u.pn = pn; return true; }
    __device__ __forceinline__ void a_ready(const Unit&) const {
        if (threadIdx.x == 0) { wait_count(cnt + 64 * pm, want); __builtin_amdgcn_fence(__ATOMIC_ACQUIRE, "agent"); asm volatile("s_waitcnt vmcnt(0)" ::: "memory"); }
        __syncthreads();
    }
    __device__ __forceinline__ void done(const Unit&) const {}
};
struct Epi3 {
    static constexpr bool PERM = true, AFTER_DRAIN = true, INIT = true;
    const float* x; float* out; const float* final_g; float* psum; unsigned* panel;
    __device__ __forceinline__ void init(f32x4 (&acc)[2][2][4][2], const Unit& u, int wr, int wc, int fr, int fq) const {
        const int cl = wc * 32 + 8 * fq;
#pragma unroll
        for (int ai = 0; ai < 2; ++ai)
#pragma unroll
            for (int m = 0; m < 4; ++m) { const float* xr = x + ((size_t)u.pm * 256 + ai * 128 + wr * 64 + m * 16 + fr) * DM + u.pn * 256 + cl;
#pragma unroll
                for (int bj = 0; bj < 2; ++bj)
#pragma unroll
                    for (int n = 0; n < 2; ++n) acc[ai][bj][m][n] = __builtin_nontemporal_load((const f32x4*)(xr + bj * 128 + 4 * n)); }
    }
    __device__ __forceinline__ void fused(f32x4 (&acc)[2][2][4][2], const Unit& u, int wr, int wc, int fr, int fq, LAS unsigned char* lds, int wid, int lane) const {
        constexpr int PF = 1040;
        int ln = lane; asm volatile("" : "+v"(ln));
        const int cl = wc * 32 + 8 * fq, wv = wid;
        const size_t prow = (size_t)u.pn * SEQ + u.pm * 256;
        LAS float* red = (LAS float*)(lds + 135168);
#pragma unroll
        for (int ai = 0; ai < 2; ++ai)
#pragma unroll
            for (int m = 0; m < 4; ++m) {
                float sq = 0.f;
#pragma unroll
                for (int bj = 0; bj < 2; ++bj)
#pragma unroll
                    for (int n = 0; n < 2; ++n) { const f32x4 v = acc[ai][bj][m][n]; sq += (v[0] * v[0] + v[1] * v[1]) + (v[2] * v[2] + v[3] * v[3]); }
                sq += __builtin_bit_cast(float, __builtin_amdgcn_ds_swizzle(__builtin_bit_cast(int, sq), 0x401F)); sq += __shfl_xor(sq, 32);
                if (fq == 0) red[wc * 256 + ai * 128 + wr * 64 + m * 16 + fr] = sq;
            }
        __syncthreads();
        if (threadIdx.x < 256) { const int t = threadIdx.x; const float tot = (red[t] + red[256 + t]) + (red[512 + t] + red[768 + t]);
            __hip_atomic_store(psum + prow + t, tot, __ATOMIC_RELAXED, __HIP_MEMORY_SCOPE_AGENT); }
        asm volatile("s_waitcnt vmcnt(0)" ::: "memory");
        __syncthreads();
        if (threadIdx.x == 0) __hip_atomic_fetch_add(panel + 64 * u.pm, 1u, __ATOMIC_RELAXED, __HIP_MEMORY_SCOPE_AGENT);
        f32x4 hreg[2][16];
#pragma unroll
        for (int ai = 0; ai < 2; ++ai) {
            if (ai) __syncthreads();
#pragma unroll
            for (int m = 0; m < 4; ++m)
#pragma unroll
                for (int bj = 0; bj < 2; ++bj)
#pragma unroll
                    for (int n = 0; n < 2; ++n) *(LAS f32x4*)(lds + (wr * 64 + m * 16 + fr) * PF + (bj * 128 + cl + 4 * n) * 4) = acc[ai][bj][m][n];
            __syncthreads();
#pragma unroll
            for (int it = 0; it < 16; ++it) hreg[ai][it] = *(LAS f32x4*)(lds + (wv + 8 * it) * PF + ln * 16);
        }
        if (threadIdx.x == 0) {
            wait_count(panel + 64 * u.pm, 8u);
            __builtin_amdgcn_fence(__ATOMIC_ACQUIRE, "agent");
            asm volatile("s_waitcnt vmcnt(0)" ::: "memory");
        }
        __syncthreads();
        float rsl;
        { const size_t r = (size_t)u.pm * 256 + (ln >> 4 & 1) * 128 + wv + 8 * (ln & 15);
          float tot = 0.f;
#pragma unroll
          for (int p = 0; p < 8; ++p) tot += psum[(size_t)p * SEQ + r];
          rsl = 1.0f / sqrtf(tot * (1.0f / DM) + EPS); }
        const f32x4 g = *(const f32x4*)(final_g + u.pn * 256 + 4 * ln);
        float* ob = out + ((size_t)u.pm * 256 + wv) * DM + u.pn * 256 + 4 * ln;
#pragma unroll
        for (int ai = 0; ai < 2; ++ai)
#pragma unroll
            for (int it = 0; it < 16; ++it) {
                const float rs = __builtin_bit_cast(float, __builtin_amdgcn_readlane(__builtin_bit_cast(int, rsl), ai * 16 + it));
                __builtin_nontemporal_store(hreg[ai][it] * rs * g, (f32x4*)(ob + (size_t)(ai * 128 + 8 * it) * DM));
            }
    }
};

struct Args { const float* in[13]; float* out; unsigned char* ws; int ph_lo, ph_hi; };
__global__ void __launch_bounds__(NTHREADS, 2) mega(Args a) {
    extern __shared__ __attribute__((aligned(16))) unsigned char lds_[];
    LAS unsigned char* lds = (LAS unsigned char*)lds_;
    const int tid = threadIdx.x, lane = tid & 63, wid = __builtin_amdgcn_readfirstlane(tid >> 6), b = blockIdx.x;
    unsigned char* ws = a.ws;
    const float *x = a.in[0], *meta = a.in[1], *ln_g = a.in[2], *w_in = a.in[3], *gn_g = a.in[4], *dw_w = a.in[5], *dw_b = a.in[6], *cln_g = a.in[7], *cln_b = a.in[8],
                *pw_w = a.in[9], *pw_b = a.in[10], *w_out = a.in[11], *final_g = a.in[12];
    for (int u = tid; u < (LDS_BYTES - MISC_OFF) / 4; u += NTHREADS) ((LAS unsigned*)(lds + MISC_OFF))[u] = 0u;
    __syncthreads();
    XcdBarrier bar = xcd_barrier_post((unsigned*)(ws + WS_CTL) + CW_BAR, (volatile LAS unsigned*)(lds + MISC_OFF) + 8);
    const int lo = a.ph_lo, hi = a.ph_hi;
#define IN(k) (lo <= (k) && (k) < hi)
#define SEAM(k) do { if (IN(k) && IN((k) + 1)) xcd_barrier(bar); } while (0)
#define WS_LAUNDER() size_t wsz_ = 0; asm volatile("" : "+s"(wsz_)); unsigned char* wsl = ws + wsz_
    if (IN(0)) { p0_prologue(lds, x, meta, ln_g, w_in, pw_w, w_out, ws, b, tid, wid, lane); }
    SEAM(0);
    if (IN(1)) {
        unsigned* ctl = (unsigned*)(ws + WS_CTL);
        {
            WS_LAUNDER();
            pg8::Gemm g{(const bf16_t*)(wsl + WS_HB), (const bf16_t*)(wsl + WS_WIN), MPAD, INW, DM};
            Sched1 S{b, ctl};
            Epi1 E{(bf16_t*)(wsl + WS_QT), (bf16_t*)(wsl + WS_KT), (bf16_t*)(wsl + WS_V), (bf16_t*)(wsl + WS_U), (bf16_t*)(wsl + WS_GY), (const float*)(wsl + WS_RSTD), (const float*)(wsl + WS_COS), (const float*)(wsl + WS_SIN)};
            pg8::gemm_phase<Epi1, Sched1, true, true>(lds, g, S, E);
        }
        {
            WS_LAUNDER();
            volatile LAS unsigned* misc = (volatile LAS unsigned*)(lds + MISC_OFF);
            if (tid == 0) { wait_count(ctl + CW_MID, (unsigned)GRID); __builtin_amdgcn_fence(__ATOMIC_ACQUIRE, "agent"); asm volatile("s_waitcnt vmcnt(0)" ::: "memory"); }
            __syncthreads();
            bool meta_ok = false;
            for (;;) {
                if (tid == 0) misc[0] = __hip_atomic_fetch_add(ctl + CW_Q, 1u, __ATOMIC_RELAXED, __HIP_MEMORY_SCOPE_AGENT);
                __syncthreads();
                const int item = (int)misc[0];
                __syncthreads();
                if (item >= 640) break;
                if (item >= 256 && item < 384) {
                    const int pm = (item - 256) >> 2, pn = item & 3;
                    if (tid == 0) { wait_count(ctl + CW_CONV + 64 * pm, 8u); wait_count(ctl + CW_GC + 64 * pm, 4u); __builtin_amdgcn_fence(__ATOMIC_ACQUIRE, "agent"); asm volatile("s_waitcnt vmcnt(0)" ::: "memory"); }
                    __syncthreads();
                    size_t zp = 0; asm volatile("" : "+s"(zp));
                    pg8::Gemm g{(const bf16_t*)(wsl + WS_CB) + zp, (const bf16_t*)(wsl + WS_WPW) + zp, SEQ, CW, CW};
                    SchedOne S{pm, pn, true};
                    EpiPw E{(bf16_t*)(wsl + WS_GY) + zp, pw_b + zp};
                    pg8::gemm_phase<EpiPw, SchedOne, false, true>(lds, g, S, E);
                    continue;
                }
                const bool is_kv = item >= 384;
                const int j = is_kv ? item - 384 : item;
                const int c = j < 252 ? (j >> 2) + 1 : 0, hq = j & 3, ct = j;
                const bool needs_meta = is_kv ? (c == 0) : (ct == 0);
                if (needs_meta && !meta_ok) {
                    if (tid == 0) { wait_count(ctl + CW_META, 16u); __builtin_amdgcn_fence(__ATOMIC_ACQUIRE, "agent"); asm volatile("s_waitcnt vmcnt(0)" ::: "memory"); }
                    __syncthreads();
                    meta_ok = true;
                }
                size_t zi = 0; asm volatile("" : "+s"(zi));
                int tl = tid; asm volatile("" : "+v"(tl));
                const int ll = tl & 63, wl = __builtin_amdgcn_readfirstlane(tl >> 6);
                if (is_kv) p2a_kv(lds, (const bf16_t*)(wsl + WS_KT) + zi, (const bf16_t*)(wsl + WS_V) + zi, kvt_tile(wsl, c * 4 + hq) + zi, c, hq, tl, wl, ll);
                else { p2a_conv(lds, (const bf16_t*)(wsl + WS_U) + zi, dw_w + zi, dw_b + zi, cln_g + zi, cln_b + zi, (bf16_t*)(wsl + WS_CB) + zi, ct, tl, wl, ll);
                       if (tid == 0) __hip_atomic_fetch_add(ctl + CW_CONV + 64 * (ct >> 3), 1u, __ATOMIC_RELAXED, __HIP_MEMORY_SCOPE_AGENT); }
            }
        }
    }
    const bool preloaded = IN(1) && IN(3);
    {
        unsigned t1 = 0u, t1b = 0u;
        const bool pend1 = IN(1) && IN(2);
        if (pend1) xcd_barrier_arrive(bar, t1, t1b);
        if (preloaded) { WS_LAUNDER(); p2c_images(lds, (const bf16_t*)(wsl + WS_QT), (const bf16_t*)(wsl + WS_KT), b >> 2, b & 3, tid); }
        if (pend1) { if (tid == 0) xcd_barrier_wait_t0(bar, t1, t1b); __syncthreads(); }
    }
    if (IN(2)) {
        WS_LAUNDER();
        p2b_scan((bf16_t*)(wsl + WS_ST), b, tid);
    }
    unsigned tok = 0u, tok2 = 0u;
    const bool pending = IN(2) && IN(3);
    if (pending) xcd_barrier_arrive(bar, tok, tok2);
    if (IN(3)) {
        WS_LAUNDER();
        p2c_item(lds, (const bf16_t*)(wsl + WS_QT), (const bf16_t*)(wsl + WS_KT), (const bf16_t*)(wsl + WS_V), (const bf16_t*)(wsl + WS_ST), (bf16_t*)(wsl + WS_GY), gn_g, b >> 2, b & 3, tid, wid, lane, bar, pending, tok, tok2, preloaded);
        if (tid == 0) __hip_atomic_fetch_add((unsigned*)(ws + WS_CTL) + CW_YR + 64 * (b >> 3), 1u, __ATOMIC_RELAXED, __HIP_MEMORY_SCOPE_AGENT);
    }
    if (IN(4)) {
        WS_LAUNDER();
        pg8::Gemm g{(const bf16_t*)(wsl + WS_GY), (const bf16_t*)(wsl + WS_WOUT), SEQ, DM, DM};
        const int xcd = b & 7, off = b >> 3, wg = xcd * 32 + off;
        SchedP3 S{(wg >> 6) * 8 + (wg & 7), (wg & 63) >> 3, (unsigned*)(ws + WS_CTL) + CW_YR, IN(3) ? 8u : 0u};
        Epi3 E{x, a.out, final_g, (float*)(wsl + WS_PSUM), (unsigned*)(ws + WS_CTL) + CW_PANEL};
        pg8::gemm_phase<Epi3, SchedP3, false, true>(lds, g, S, E);
    }
#undef WS_LAUNDER
#undef IN
#undef SEAM
}
}

#ifndef LADDER
#define LADDER 0
#endif
#ifndef PROBE_K
#define PROBE_K 0
#endif
#ifndef PROBE_TAIL
#define PROBE_TAIL 0
#endif
#if LADDER > 0
namespace nt {
using namespace mk;
__device__ __forceinline__ float bf2f(bf16_t v) { return __uint_as_float((unsigned)v << 16); }
__device__ __forceinline__ bf16_t f2bf(float f) { unsigned u = __float_as_uint(f); return (bf16_t)((u + 0x7fffu + ((u >> 16) & 1u)) >> 16); }
__device__ __forceinline__ float sigm(float x) { return 1.f / (1.f + expf(-x)); }
__global__ void __launch_bounds__(64) t_retention(const bf16_t* Qt, const bf16_t* Kt, const bf16_t* V, float* yraw) {
    const int w = blockIdx.x, h = w >> 8, dv = w & 255, lane = threadIdx.x;
    const float gamma = 1.0f - exp2f(-5.0f - (float)h), l2g = log2f(gamma);
    float S[4] = {0.f, 0.f, 0.f, 0.f};
    for (int pos = 0; pos < LTOK; ++pos) {
        const int r = pos < NMETA ? SEQ + pos : pos - NMETA, il = pos < NMETA ? 112 + pos : (r & 127);
        const float v = bf2f(V[(size_t)r * RW + h * RD + dv]);
        const float kd = exp2f(-(float)(127 - il) * l2g), qd = exp2f(-(float)(il + 1) * l2g);
        float part = 0.f;
#pragma unroll
        for (int i = 0; i < 4; ++i) {
            const int d = lane + 64 * i;
            const float k = bf2f(Kt[(size_t)r * RW + h * RD + d]) * kd;
            const float q = r < SEQ ? bf2f(Qt[(size_t)r * RW + h * RD + d]) * qd : 0.f;
            S[i] = gamma * S[i] + k * v;
            part += q * S[i];
        }
        part = wave_sum(part);
        if (lane == 0 && r < SEQ) yraw[(size_t)r * RW + h * RD + dv] = part;
    }
}
__global__ void __launch_bounds__(256) t_chunk(const bf16_t* Qt, const bf16_t* Kt, const bf16_t* V, const bf16_t* ST, float* yraw) {
    __shared__ float sc[128];
    __shared__ float qs[256];
    const int xc = blockIdx.x >> 2, h = blockIdx.x & 3, dv = threadIdx.x;
    const float gamma = 1.0f - exp2f(-5.0f - (float)h), ginv = exp2f(-128.0f * log2f(gamma));
    const bf16_t* Sx = ST + (size_t)(xc * 4 + h) * 65536;
    for (int i = 0; i < 128; ++i) {
        const size_t ri = (size_t)xc * 128 + i;
        __syncthreads();
        qs[dv] = bf2f(Qt[ri * RW + h * RD + dv]);
        __syncthreads();
        if (dv < 128) { float s = 0.f; if (dv <= i) { const size_t rj = (size_t)xc * 128 + dv; for (int d = 0; d < 256; ++d) s += qs[d] * bf2f(Kt[rj * RW + h * RD + d]); } sc[dv] = s * ginv; }
        __syncthreads();
        float y = 0.f;
        for (int j = 0; j <= i; ++j) y += sc[j] * bf2f(V[((size_t)xc * 128 + j) * RW + h * RD + dv]);
        for (int d = 0; d < 256; ++d) y += qs[d] * bf2f(Sx[(size_t)dv * 256 + d]);
        yraw[ri * RW + h * RD + dv] = y;
    }
}
__global__ void t_groupnorm(const float* yraw, bf16_t* GY, const float* gn_g) {
    const int w = (blockIdx.x * blockDim.x + threadIdx.x) >> 6, lane = threadIdx.x & 63;
    if (w >= SEQ * RH) return;
    const int r = w >> 2, h = w & 3;
    float v[4], s = 0.f;
#pragma unroll
    for (int i = 0; i < 4; ++i) { v[i] = yraw[(size_t)r * RW + h * RD + lane + 64 * i]; s += v[i]; }
    const float mu = wave_sum(s) / RD;
    float q = 0.f;
#pragma unroll
    for (int i = 0; i < 4; ++i) { v[i] -= mu; q += v[i] * v[i]; }
    const float rs = 1.0f / sqrtf(wave_sum(q) / RD + EPS);
#pragma unroll
    for (int i = 0; i < 4; ++i) { const int c = h * RD + lane + 64 * i; bf16_t* p = GY + (size_t)r * DM + c; *p = f2bf(v[i] * rs * gn_g[c] * bf2f(*p)); }
}
__global__ void __launch_bounds__(256) t_conv(const bf16_t* U, const float* dw_w, const float* dw_b, const float* ln_g, const float* ln_b, bf16_t* CB) {
    __shared__ float red[8];
    const int r = blockIdx.x, pos = r + NMETA, tid = threadIdx.x, lane = tid & 63, wv = tid >> 6;
    float c[4];
#pragma unroll
    for (int i = 0; i < 4; ++i) {
        const int ch = tid + 256 * i;
        float a = dw_b[ch];
        for (int j = 0; j < CK; ++j) { const int p = pos - (CK - 1) + j; if (p >= 0) { const int row = p >= NMETA ? p - NMETA : SEQ + p; a += bf2f(U[(size_t)row * CW + ch]) * dw_w[j * CW + ch]; } }
        c[i] = a;
    }
    float s = wave_sum(c[0] + c[1] + c[2] + c[3]);
    if (lane == 0) red[wv] = s;
    __syncthreads();
    const float mu = (red[0] + red[1] + red[2] + red[3]) / CW;
    float q = 0.f;
#pragma unroll
    for (int i = 0; i < 4; ++i) { c[i] -= mu; q += c[i] * c[i]; }
    q = wave_sum(q);
    if (lane == 0) red[4 + wv] = q;
    __syncthreads();
    const float rs = 1.0f / sqrtf((red[4] + red[5] + red[6] + red[7]) / CW + EPS);
#pragma unroll
    for (int i = 0; i < 4; ++i) { const int ch = tid + 256 * i; const float y = c[i] * rs * ln_g[ch] + ln_b[ch]; CB[(size_t)r * CW + ch] = f2bf(y * sigm(y)); }
}
template <int M, int N, int K, class AL, class EP>
__global__ void __launch_bounds__(256) t_gemm(const float* B, AL al, EP ep) {
    __shared__ float As[16][68];
    __shared__ float Bs[16][68];
    const int tx = threadIdx.x & 15, ty = threadIdx.x >> 4;
    const int m0 = blockIdx.y * 64, n0 = blockIdx.x * 64;
    float acc[4][4];
#pragma unroll
    for (int i = 0; i < 4; ++i)
#pragma unroll
        for (int j = 0; j < 4; ++j) acc[i][j] = 0.f;
    for (int k0 = 0; k0 < K; k0 += 16) {
#pragma unroll
        for (int i = 0; i < 4; ++i) { const int idx = threadIdx.x + i * 256, mm = idx >> 4, kk = idx & 15, m = m0 + mm; As[kk][mm] = (m < M) ? al(m, k0 + kk) : 0.f; }
#pragma unroll
        for (int i = 0; i < 4; ++i) { const int idx = threadIdx.x + i * 256, kk = idx >> 6, nn = idx & 63; Bs[kk][nn] = B[(size_t)(k0 + kk) * N + n0 + nn]; }
        __syncthreads();
#pragma unroll
        for (int kk = 0; kk < 16; ++kk) {
            float a[4], b[4];
#pragma unroll
            for (int i = 0; i < 4; ++i) { a[i] = As[kk][ty * 4 + i]; b[i] = Bs[kk][tx * 4 + i]; }
#pragma unroll
            for (int i = 0; i < 4; ++i)
#pragma unroll
                for (int j = 0; j < 4; ++j) acc[i][j] += a[i] * b[j];
        }
        __syncthreads();
    }
#pragma unroll
    for (int i = 0; i < 4; ++i)
#pragma unroll
        for (int j = 0; j < 4; ++j) { const int m = m0 + ty * 4 + i, n = n0 + tx * 4 + j; if (m < M) ep(m, n, acc[i][j]); }
}
struct AL_CB { const bf16_t* CB; __device__ float operator()(int m, int k) const { return bf2f(CB[(size_t)m * CW + k]); } };
struct EP_PW { bf16_t* GY; const float* pw_b; __device__ void operator()(int m, int n, float v) const { bf16_t* p = GY + (size_t)m * DM + 1024 + n; *p = f2bf((v + pw_b[n]) * bf2f(*p)); } };
struct AL_GY { const bf16_t* GY; __device__ float operator()(int m, int k) const { return bf2f(GY[(size_t)m * DM + k]); } };
struct EP_OUT { float* out; const float* x; __device__ void operator()(int m, int n, float v) const { out[(size_t)m * DM + n] = v + x[(size_t)m * DM + n]; } };
__global__ void t_final(float* out, const float* g) {
    const int w = (blockIdx.x * blockDim.x + threadIdx.x) >> 6, lane = threadIdx.x & 63;
    if (w >= SEQ) return;
    float* r = out + (size_t)w * DM;
    float s = 0.f;
    for (int i = lane; i < DM; i += 64) { const float v = r[i]; s += v * v; }
    const float rs = 1.0f / sqrtf(wave_sum(s) / DM + EPS);
    for (int i = lane; i < DM; i += 64) r[i] = r[i] * rs * g[i];
}
}
#endif

extern "C" void kernel_launch(void* const* d_in, const int* in_sizes, int n_in, void* d_out, int out_size, void* d_ws, size_t ws_size, hipStream_t stream) {
    using namespace mk;
    static int ready = 0;
    if (ready == 0) {
        if (n_in != 13 || out_size != SEQ * DM || ws_size < WS_END) { fprintf(stderr, "kernel_launch: unexpected shapes (n_in %d, out %d, ws %zu)\n", n_in, out_size, ws_size); ready = -1; return; }
        int dev = 0, cus = 0;
        if (hipGetDevice(&dev) != hipSuccess || hipDeviceGetAttribute(&cus, hipDeviceAttributeMultiprocessorCount, dev) != hipSuccess) { ready = -1; return; }
        if (cus < GRID) { fprintf(stderr, "kernel_launch: %d CUs < %d\n", cus, GRID); ready = -1; return; }
        if (hipFuncSetAttribute((const void*)mega, hipFuncAttributeMaxDynamicSharedMemorySize, LDS_BYTES) != hipSuccess) { fprintf(stderr, "kernel_launch: hipFuncSetAttribute failed\n"); ready = -1; return; }
        int per_cu = 0;
        if (hipOccupancyMaxActiveBlocksPerMultiprocessor(&per_cu, (const void*)mega, NTHREADS, LDS_BYTES) != hipSuccess || per_cu < 1) fprintf(stderr, "kernel_launch: occupancy query says %d blocks/CU\n", per_cu);
        (void)hipGetLastError();
        ready = 1;
    }
    if (ready < 0) return;
    (void)hipMemsetAsync((char*)d_ws + WS_CTL, 0, CTL_ZERO_BYTES, stream);
    Args a{};
    for (int i = 0; i < 13; ++i) a.in[i] = (const float*)d_in[i];
    a.out = (float*)d_out; a.ws = (unsigned char*)d_ws;
#if LADDER == 0
#if PROBE_K > 0
    a.ph_lo = 0; a.ph_hi = PROBE_K;
    hipLaunchKernelGGL(mega, dim3(GRID), dim3(NTHREADS), LDS_BYTES, stream, a);
    (void)hipMemsetAsync((char*)d_ws + WS_CTL, 0, CTL_ZERO_BYTES, stream);
#endif
    a.ph_lo = 0; a.ph_hi = 5;
    hipLaunchKernelGGL(mega, dim3(GRID), dim3(NTHREADS), LDS_BYTES, stream, a);
#if PROBE_TAIL > 0
    (void)hipMemsetAsync((char*)d_ws + WS_CTL, 0, CTL_ZERO_BYTES, stream);
    a.ph_lo = PROBE_TAIL; a.ph_hi = 5;
    hipLaunchKernelGGL(mega, dim3(GRID), dim3(NTHREADS), LDS_BYTES, stream, a);
#endif
#else
    using namespace nt;
    unsigned char* ws = (unsigned char*)d_ws;
    bf16_t *Qt = (bf16_t*)(ws + WS_QT), *Kt = (bf16_t*)(ws + WS_KT), *V = (bf16_t*)(ws + WS_V), *U = (bf16_t*)(ws + WS_U), *GY = (bf16_t*)(ws + WS_GY), *CB = (bf16_t*)(ws + WS_CB), *ST = (bf16_t*)(ws + WS_ST);
    const float *x = a.in[0], *gn_g = a.in[4], *dw_w = a.in[5], *dw_b = a.in[6], *cln_g = a.in[7], *cln_b = a.in[8], *pw_w = a.in[9], *pw_b = a.in[10], *w_out = a.in[11], *final_g = a.in[12];
    float* out = (float*)d_out; float* yraw = (float*)d_out;
    a.ph_lo = 0; a.ph_hi = (LADDER == 1 ? 2 : LADDER == 2 ? 3 : 4);
    hipLaunchKernelGGL(mega, dim3(GRID), dim3(NTHREADS), LDS_BYTES, stream, a);
#if LADDER == 1
    t_retention<<<RH * RD, 64, 0, stream>>>(Qt, Kt, V, yraw);
    t_groupnorm<<<(SEQ * RH * 64 + 255) / 256, 256, 0, stream>>>(yraw, GY, gn_g);
    t_conv<<<SEQ, 256, 0, stream>>>(U, dw_w, dw_b, cln_g, cln_b, CB);
    t_gemm<SEQ, CW, CW><<<dim3(CW / 64, SEQ / 64), 256, 0, stream>>>(pw_w, AL_CB{CB}, EP_PW{GY, pw_b});
#elif LADDER == 2
    t_chunk<<<64 * 4, 256, 0, stream>>>(Qt, Kt, V, ST, yraw);
    t_groupnorm<<<(SEQ * RH * 64 + 255) / 256, 256, 0, stream>>>(yraw, GY, gn_g);
#endif
    t_gemm<SEQ, DM, DM><<<dim3(DM / 64, SEQ / 64), 256, 0, stream>>>(w_out, AL_GY{GY}, EP_OUT{out, x});
    t_final<<<(SEQ * 64 + 255) / 256, 256, 0, stream>>>(out, final_g);
#endif
}
```

```cpp
#include <hip/hip_runtime.h>
#include <cstdio>
#include <cstdint>
namespace pg8 {
#define PG8_LAS __attribute__((address_space(3)))
typedef unsigned short bf16_t;
typedef short bf16x8 __attribute__((ext_vector_type(8)));
typedef float f32x4 __attribute__((ext_vector_type(4)));
typedef unsigned u32x4 __attribute__((ext_vector_type(4)));
constexpr int BM = 256, BK = 64, HALF = 128, HTB = HALF * BK * 2  , STAGE_BYTES = 8 * HTB, NXCD = 8, WGM = 8;

__host__ __device__ __forceinline__ int lds_byte(int r, int c) { const int st = (r >> 4) * 2 + (c >> 5), rr = r & 15, cc = c & 31, ob = rr * 64 + cc * 2; return st * 1024 + (ob ^ (((ob >> 9) & 1) << 5)); }
__host__ __device__ __forceinline__ void stage_rc(int b, int& R, int& C) { const int st = b / 1024, sb = b % 1024, swz = sb ^ (((sb >> 9) & 1) << 5); R = (st >> 1) * 16 + swz / 64; C = (st & 1) * 32 + (swz % 64) / 2; }
__host__ __device__ __forceinline__ int perm32(int rho) { const int n = rho >> 4, i = rho & 15; return 8 * (i >> 2) + 4 * n + (i & 3); }

struct Unit { int pm, pn; };
struct Gemm { const bf16_t* A; const bf16_t* Bt; int M, N, K; };

__device__ __forceinline__ unsigned cvt_pk_bf16(float lo, float hi) { unsigned r; asm volatile("v_cvt_pk_bf16_f32 %0, %1, %2" : "=v"(r) : "v"(lo), "v"(hi)); return r; }
typedef float f32x2 __attribute__((ext_vector_type(2)));
template <class Epi, class Sched, bool ALIGN_EPI = false, bool SP2 = false>
__device__ __forceinline__ void gemm_phase(PG8_LAS unsigned char* lds, const Gemm g, const Sched& S, const Epi& E) {
    int tid = threadIdx.x; asm volatile("" : "+v"(tid));
    const int wid = __builtin_amdgcn_readfirstlane(tid >> 6), lane = tid & 63, wr = wid >> 2, wc = wid & 3, fr = lane & 15, fq = lane >> 4;
    const int K = g.K, nt = K / BK;
    unsigned voffA[2], voffB[2];
#pragma unroll
    for (int i = 0; i < 2; ++i) { int R, C; stage_rc(tid * 16 + i * 8192, R, C); const int Rb = Epi::PERM ? ((R & ~31) + perm32(R & 31)) : R;
        voffA[i] = (unsigned)(R * K + C) * 2u; voffB[i] = (unsigned)(Rb * K + C) * 2u; }
    const size_t kstep = (size_t)(BK * 2);
    const size_t hstep = (size_t)HALF * K * 2;
    const size_t tstep = 2 * hstep;
    const unsigned ldsw = (unsigned)wid * 1024u;
    const int aoff = lds_byte(wr * 64 + fr, fq * 8), boff = lds_byte(wc * 32 + fr, fq * 8);
#define PG8_SA(b, h) (((b) * 2 + (h)) * HTB)
#define PG8_SB(b, h) ((4 + (b) * 2 + (h)) * HTB)
#define PG8_STAGE(bufoff, gbase, voff) do { _Pragma("unroll") for (int _i = 0; _i < 2; ++_i) \
        __builtin_amdgcn_global_load_lds((const unsigned*)((const char*)(gbase) + (voff)[_i]), (PG8_LAS unsigned*)(lds + (bufoff) + ldsw + _i * 8192), 16, 0, 0); } while (0)
#define PG8_LDA(dst, b, h) do { _Pragma("unroll") for (int m = 0; m < 4; ++m) _Pragma("unroll") for (int k = 0; k < 2; ++k) dst[m][k] = *(const PG8_LAS bf16x8*)(lds + PG8_SA(b, h) + aoff + m * 2048 + k * 1024); } while (0)
#define PG8_LDB(dst, b, h) do { _Pragma("unroll") for (int n = 0; n < 2; ++n) _Pragma("unroll") for (int k = 0; k < 2; ++k) dst[n][k] = *(const PG8_LAS bf16x8*)(lds + PG8_SB(b, h) + boff + n * 2048 + k * 1024); } while (0)
#define PG8_MMA(ai, bj, At, Bt) do { __builtin_amdgcn_s_setprio(1); _Pragma("unroll") for (int m = 0; m < 4; ++m) _Pragma("unroll") for (int n = 0; n < 2; ++n) _Pragma("unroll") for (int k = 0; k < 2; ++k) \
        acc[ai][bj][m][n] = __builtin_amdgcn_mfma_f32_16x16x32_bf16(Bt[n][k], At[m][k], acc[ai][bj][m][n], 0, 0, 0); __builtin_amdgcn_s_setprio(0); } while (0)
#define PG8_WAIT_V(n) asm volatile("s_waitcnt vmcnt(" #n ")" ::: "memory")
#define PG8_WAIT_L(n) asm volatile("s_waitcnt lgkmcnt(" #n ")" ::: "memory")
#define PG8_BAR __builtin_amdgcn_s_barrier()
#define PG8_SCHED __builtin_amdgcn_sched_barrier(0)
    Unit cur, nxt; int ui = 0;
    if (!S.next(0, cur)) return;
    f32x4 acc[2][2][4][2];
    if constexpr (Epi::INIT) E.init(acc, cur, wr, wc, fr, fq);
    else {
#pragma unroll
    for (int a = 0; a < 2; ++a)
#pragma unroll
        for (int b = 0; b < 2; ++b)
#pragma unroll
            for (int m = 0; m < 4; ++m)
#pragma unroll
                for (int n = 0; n < 2; ++n) acc[a][b][m][n] = (f32x4){0.f, 0.f, 0.f, 0.f};
    }
    bf16x8 At[4][2], B0[2][2], B1[2][2];
    const char* cA = (const char*)g.A + (size_t)cur.pm * tstep; const char* cB = (const char*)g.Bt + (size_t)cur.pn * tstep;
    S.a_ready(cur);
    if constexpr (SP2) {
        PG8_STAGE(PG8_SB(0, 0), cB, voffB); PG8_STAGE(PG8_SB(0, 1), cB + hstep, voffB); PG8_STAGE(PG8_SA(0, 0), cA, voffA); PG8_STAGE(PG8_SA(0, 1), cA + hstep, voffA);
        if (wr == 1) PG8_BAR;
        PG8_WAIT_V(2); PG8_BAR;
        PG8_STAGE(PG8_SB(1, 0), cB + kstep, voffB); PG8_STAGE(PG8_SA(1, 0), cA + kstep, voffA); PG8_STAGE(PG8_SB(1, 1), cB + hstep + kstep, voffB);
        PG8_WAIT_V(6); PG8_BAR;
    } else {
        PG8_STAGE(PG8_SB(0, 0), cB, voffB); PG8_STAGE(PG8_SA(0, 0), cA, voffA); PG8_STAGE(PG8_SB(0, 1), cB + hstep, voffB); PG8_STAGE(PG8_SA(0, 1), cA + hstep, voffA);
        if (wr == 1) PG8_BAR;
        PG8_WAIT_V(4); PG8_BAR;
        PG8_STAGE(PG8_SB(1, 0), cB + kstep, voffB); PG8_STAGE(PG8_SA(1, 0), cA + kstep, voffA); PG8_STAGE(PG8_SB(1, 1), cB + hstep + kstep, voffB);
        PG8_WAIT_V(6); PG8_BAR;
    }
    for (;;) {
        const bool has_next = S.next(ui + 1, nxt);
        const char* nA = has_next ? (const char*)g.A + (size_t)nxt.pm * tstep : cA; const char* nB = has_next ? (const char*)g.Bt + (size_t)nxt.pn * tstep : cB;
        for (int t = 0; t < nt; t += 2) {
            const bool last = (t == nt - 2);
            const char* a1 = cA + (size_t)(t + 1) * kstep;
            const char* a2 = last ? nA : cA + (size_t)(t + 2) * kstep; const char* b2 = last ? nB : cB + (size_t)(t + 2) * kstep;
            const char* a3 = a2 + kstep; const char* b3 = b2 + kstep;
            if (last && has_next) S.a_ready(nxt);
            if constexpr (SP2) {
            PG8_LDB(B0, 0, 0); PG8_LDB(B1, 0, 1); PG8_SCHED; PG8_LDA(At, 0, 0); PG8_STAGE(PG8_SA(1, 1), a1 + hstep, voffA);
            PG8_WAIT_V(8); PG8_WAIT_L(0); PG8_BAR; PG8_MMA(0, 0, At, B0); PG8_MMA(0, 1, At, B1); PG8_BAR; PG8_SCHED;
            PG8_LDA(At, 0, 1); PG8_STAGE(PG8_SB(0, 0), b2, voffB); PG8_STAGE(PG8_SB(0, 1), b2 + hstep, voffB); PG8_STAGE(PG8_SA(0, 0), a2, voffA);
            PG8_WAIT_V(8); PG8_WAIT_L(0); PG8_BAR; PG8_MMA(1, 0, At, B0); PG8_MMA(1, 1, At, B1); PG8_BAR; PG8_SCHED;
            PG8_LDB(B0, 1, 0); PG8_LDB(B1, 1, 1); PG8_SCHED; PG8_LDA(At, 1, 0); PG8_STAGE(PG8_SA(0, 1), a2 + hstep, voffA);
            PG8_WAIT_V(8); PG8_WAIT_L(0); PG8_BAR; PG8_MMA(0, 0, At, B0); PG8_MMA(0, 1, At, B1); PG8_BAR; PG8_SCHED;
            PG8_LDA(At, 1, 1); PG8_STAGE(PG8_SB(1, 0), b3, voffB); PG8_STAGE(PG8_SB(1, 1), b3 + hstep, voffB); PG8_STAGE(PG8_SA(1, 0), a3, voffA);
            PG8_WAIT_V(8); PG8_WAIT_L(0); PG8_BAR; PG8_MMA(1, 0, At, B0); PG8_MMA(1, 1, At, B1); PG8_BAR; PG8_SCHED;
            } else {
            PG8_LDB(B0, 0, 0); PG8_SCHED; PG8_LDA(At, 0, 0); PG8_STAGE(PG8_SA(1, 1), a1 + hstep, voffA);
            PG8_WAIT_L(8); PG8_BAR; PG8_WAIT_L(0); PG8_MMA(0, 0, At, B0); PG8_BAR; PG8_SCHED;
            PG8_LDB(B1, 0, 1); PG8_STAGE(PG8_SB(0, 0), b2, voffB);
            PG8_BAR; PG8_WAIT_L(0); PG8_MMA(0, 1, At, B1); PG8_BAR;
            PG8_LDA(At, 0, 1); PG8_STAGE(PG8_SA(0, 0), a2, voffA);
            PG8_BAR; PG8_WAIT_L(0); PG8_MMA(1, 0, At, B0); PG8_BAR; PG8_SCHED;
            PG8_STAGE(PG8_SB(0, 1), b2 + hstep, voffB);
            PG8_WAIT_V(6); PG8_BAR; PG8_MMA(1, 1, At, B1); PG8_BAR;
            PG8_LDB(B0, 1, 0); PG8_SCHED; PG8_LDA(At, 1, 0); PG8_STAGE(PG8_SA(0, 1), a2 + hstep, voffA);
            PG8_WAIT_L(8); PG8_BAR; PG8_WAIT_L(0); PG8_MMA(0, 0, At, B0); PG8_BAR; PG8_SCHED;
            PG8_LDB(B1, 1, 1); PG8_STAGE(PG8_SB(1, 0), b3, voffB);
            PG8_BAR; PG8_WAIT_L(0); PG8_MMA(0, 1, At, B1); PG8_BAR;
            PG8_LDA(At, 1, 1); PG8_STAGE(PG8_SA(1, 0), a3, voffA);
            PG8_BAR; PG8_WAIT_L(0); PG8_MMA(1, 0, At, B0); PG8_BAR; PG8_SCHED;
            PG8_STAGE(PG8_SB(1, 1), b3 + hstep, voffB);
            PG8_WAIT_V(6); PG8_BAR; PG8_MMA(1, 1, At, B1); PG8_BAR;
            }
        }
        if constexpr (ALIGN_EPI) { if (wr == 0) PG8_BAR; }
        if constexpr (!Epi::AFTER_DRAIN) { E(acc, cur, wr, wc, fr, fq); S.done(cur); }
        if (!has_next) break;
#pragma unroll
        for (int a = 0; a < 2; ++a)
#pragma unroll
            for (int b = 0; b < 2; ++b)
#pragma unroll
                for (int m = 0; m < 4; ++m)
#pragma unroll
                    for (int n = 0; n < 2; ++n) acc[a][b][m][n] = (f32x4){0.f, 0.f, 0.f, 0.f};
        cur = nxt; cA = nA; cB = nB; ++ui;
        if constexpr (ALIGN_EPI) { if (wr == 1) PG8_BAR; }
    }
    PG8_WAIT_V(0);
    if constexpr (!ALIGN_EPI) { if (wr == 0) PG8_BAR; }
    PG8_BAR;
    if constexpr (Epi::AFTER_DRAIN) { E.fused(acc, cur, wr, wc, fr, fq, lds, wid, lane); S.done(cur); }
#undef PG8_SA
#undef PG8_SB
#undef PG8_STAGE
#undef PG8_LDA
#undef PG8_LDB
#undef PG8_MMA
#undef PG8_WAIT_V
#undef PG8_WAIT_L
#undef PG8_BAR
#undef PG8_SCHED
}
}

namespace mk {
using pg8::bf16_t; using pg8::bf16x8; using pg8::f32x4; using pg8::u32x4; using pg8::Unit;
#define LAS __attribute__((address_space(3)))
typedef float f32x16 __attribute__((ext_vector_type(16)));
typedef float f32x2 __attribute__((ext_vector_type(2)));
typedef float f32x2_ __attribute__((ext_vector_type(2)));
typedef short s16x4 __attribute__((ext_vector_type(4)));
typedef unsigned u32x2 __attribute__((ext_vector_type(2)));
typedef __bf16 bf16x2_t __attribute__((ext_vector_type(2)));
__device__ __forceinline__ unsigned cvt_pk_bf16(float lo, float hi) { const f32x2_ v = {lo, hi}; return __builtin_bit_cast(unsigned, __builtin_convertvector(v, bf16x2_t)); }

constexpr int DM = 2048, SEQ = 8192, NMETA = 16, LTOK = SEQ + NMETA, MPAD = 8448;
constexpr int RW = 1024, RH = 4, RD = 256, CW = 1024, CK = 31, INW = 7168;
constexpr float EPS = 1e-6f;
constexpr int NTHREADS = 512, GRID = 256;
constexpr size_t MiB = 1u << 20;
constexpr size_t WS_CTL = 0, CTL_ZERO_BYTES = 1 * MiB;
constexpr size_t WS_RSTD = 1 * MiB;
constexpr size_t WS_PSUM = 1 * MiB + 64 * 1024;
constexpr size_t WS_WOUT = 2 * MiB;
constexpr size_t WS_WPW = 10 * MiB;
constexpr size_t WS_WIN = 12 * MiB;
constexpr size_t WS_HB = 40 * MiB;
constexpr size_t WS_COS = 73 * MiB;
constexpr size_t WS_SIN = 77 * MiB + 256 * 1024;
constexpr size_t WS_QT = 82 * MiB;
constexpr size_t WS_KT = 98 * MiB;
constexpr size_t WS_V = 115 * MiB;
constexpr size_t WS_U = 132 * MiB;
constexpr size_t WS_GY = 149 * MiB;
constexpr size_t WS_CB = 181 * MiB;
constexpr size_t WS_ST = 197 * MiB;
constexpr size_t WS_END = 229 * MiB;
static_assert(WS_COS + (size_t)LTOK * 128 * 4 <= WS_SIN && WS_SIN + (size_t)LTOK * 128 * 4 <= WS_QT && WS_HB + (size_t)MPAD * DM * 2 <= WS_COS, "ws map");
__device__ __forceinline__ bf16_t* kvt_tile(unsigned char* ws, int t) { return (bf16_t*)(ws + WS_ST + (size_t)t * 131072); }
constexpr int CW_BAR = 4096;
constexpr int CW_YR = 14656;
constexpr int CW_PANEL = 12544;
constexpr int CW_CONV = 8448, CW_GC = 10496;
constexpr int CW_MID = 8192, CW_META = 8256, CW_Q = 8320;
constexpr int LDS_MAIN = 147456, MISC_OFF = LDS_MAIN, LDS_BYTES = LDS_MAIN + 1024;

__device__ __constant__ const float kLog2G[4] = {-0.045803689613124755f, -0.022720076500083796f, -0.011315313227834148f, -0.005646563141142062f};

#define LDS_WAIT() asm volatile("s_waitcnt lgkmcnt(0)" ::: "memory")
#define MFMA32(a, b, c) __builtin_amdgcn_mfma_f32_32x32x16_bf16((a), (b), (c), 0, 0, 0)
template <int CTRL> __device__ __forceinline__ float dpp_mov(float x) { return __builtin_bit_cast(float, __builtin_amdgcn_update_dpp(0, __builtin_bit_cast(int, x), CTRL, 0xF, 0xF, true)); }
__device__ __forceinline__ float sum16(float x) { x += dpp_mov<0xB1>(x); x += dpp_mov<0x4E>(x); x += dpp_mov<0x141>(x); x += dpp_mov<0x140>(x); return x; }
__device__ __forceinline__ float sum32(float x) { x = sum16(x); x += __builtin_bit_cast(float, __builtin_amdgcn_ds_swizzle(__builtin_bit_cast(int, x), 0x401F)); return x; }
__device__ __forceinline__ float wave_sum(float v) { v = sum32(v); return v + __shfl_xor(v, 32); }
__device__ __forceinline__ float sigmoid_f(float x) { return __builtin_amdgcn_rcpf(1.0f + __expf(-x)); }
__device__ __forceinline__ float silu_f(float x) { return x * sigmoid_f(x); }
__device__ __forceinline__ float bf_lo(unsigned w) { return __uint_as_float(w << 16); }
__device__ __forceinline__ float bf_hi(unsigned w) { return __uint_as_float(w & 0xffff0000u); }
__device__ __forceinline__ u32x4 pack8(const f32x4 a, const f32x4 b) { u32x4 w; w.x = cvt_pk_bf16(a[0], a[1]); w.y = cvt_pk_bf16(a[2], a[3]); w.z = cvt_pk_bf16(b[0], b[1]); w.w = cvt_pk_bf16(b[2], b[3]); return w; }
__device__ __forceinline__ void st8_sc1(void* p, u32x2 v) { asm volatile("global_store_dwordx2 %0, %1, off sc1\n\ts_nop 1" :: "v"(p), "v"(v) : "memory"); }
__device__ __forceinline__ void st16_sc1(void* p, u32x4 v) { asm volatile("global_store_dwordx4 %0, %1, off sc1\n\ts_nop 1" :: "v"(p), "v"(v) : "memory"); }
__device__ __forceinline__ int crow(int reg, int hh) { return (reg & 3) + 8 * (reg >> 2) + 4 * hh; }
__device__ __forceinline__ s16x4 tr_read(LAS unsigned char* p) { return __builtin_amdgcn_ds_read_tr16_b64_v4i16((LAS s16x4*)p); }

#define XB_TMO      128
#define XB_XCNT(j)  (256  + 64 * (j))
#define XB_XSUB(j)  (1280 + 64 * (j))
#define XB_XGEN(j)  (2304 + 64 * (j))
#define XB_TOP      3328
#define XB_TOPGEN   3392
#define XCD_BAR_WORDS 3456
#define XB_SPIN_CAP (1u << 18)
__device__ __forceinline__ unsigned xb_ld(unsigned* p)              { return __hip_atomic_load(p, __ATOMIC_RELAXED, __HIP_MEMORY_SCOPE_AGENT); }
__device__ __forceinline__ unsigned xb_add(unsigned* p, unsigned v) { return __hip_atomic_fetch_add(p, v, __ATOMIC_RELAXED, __HIP_MEMORY_SCOPE_AGENT); }
__device__ __forceinline__ unsigned xb_xcc_id() { return (unsigned)__builtin_amdgcn_s_getreg((3 << 11) | 20) & 0xFu; }
#define XB_SPIN(cond, bar) do { unsigned _sp = 0; while (cond) { __builtin_amdgcn_s_sleep(1); \
    if ((++_sp & 255u) == 0u) { if (xb_ld(&(bar)[XB_TMO])) break; if (_sp > XB_SPIN_CAP) { atomicAdd(&(bar)[XB_TMO], 1u); break; } } } } while (0)
struct XcdBarrier { unsigned* bar; unsigned x; volatile LAS unsigned* st; };
__device__ __forceinline__ XcdBarrier xcd_barrier_post(unsigned* bar, volatile LAS unsigned* st) {
    XcdBarrier b; b.bar = bar; b.x = xb_xcc_id(); b.st = st;
    if (threadIdx.x == 0) (void)xb_add(&bar[XB_XCNT(b.x)], 1u);
    return b;
}
__device__ __forceinline__ void xcd_barrier_complete(unsigned* bar, unsigned x, unsigned& nloc, unsigned& nx) {
    const unsigned G = gridDim.x * gridDim.y * gridDim.z;
    unsigned sum, cnt, mine, sp = 0u;
    for (;;) {
        sum = 0u; cnt = 0u; mine = 0u;
#pragma unroll
        for (unsigned j = 0; j < 16; ++j) { const unsigned c = xb_ld(&bar[XB_XCNT(j)]); sum += c; cnt += (c > 0u) ? 1u : 0u; mine = (j == x) ? c : mine; }
        if (sum == G) break;
        __builtin_amdgcn_s_sleep(1);
        if ((++sp & 255u) == 0u) { if (xb_ld(&bar[XB_TMO])) break; if (sp > XB_SPIN_CAP) { atomicAdd(&bar[XB_TMO], 1u); break; } }
    }
    nloc = mine > 0u ? mine : 1u; nx = cnt > 0u ? cnt : 1u;
}
__device__ __forceinline__ void xcd_barrier(const XcdBarrier& b) {
    asm volatile("s_waitcnt vmcnt(0)" ::: "memory");
    __syncthreads();
    if (threadIdx.x == 0) {
        unsigned* bar = b.bar;
        __builtin_amdgcn_s_waitcnt(0);
        unsigned nloc = b.st[0], nx = b.st[1];
        if (nloc == 0u) { xcd_barrier_complete(bar, b.x, nloc, nx); b.st[0] = nloc; b.st[1] = nx; }
        const unsigned old = xb_add(&bar[XB_XSUB(b.x)], 1u);
        const unsigned gen = old / nloc;
        if (old + 1u == (gen + 1u) * nloc) {
            __builtin_amdgcn_fence(__ATOMIC_RELEASE, "agent");
            asm volatile("s_waitcnt vmcnt(0)" ::: "memory");
            const unsigned og = xb_add(&bar[XB_TOP], 1u);
            const unsigned tg = og / nx;
            if (og + 1u == (tg + 1u) * nx) xb_add(&bar[XB_TOPGEN], 1u);
            else XB_SPIN(xb_ld(&bar[XB_TOPGEN]) == tg, bar);
            __builtin_amdgcn_fence(__ATOMIC_ACQUIRE, "agent");
            xb_add(&bar[XB_XGEN(b.x)], 1u);
            asm volatile("s_waitcnt vmcnt(0)" ::: "memory");
        } else {
            XB_SPIN(xb_ld(&bar[XB_XGEN(b.x)]) == gen, bar);
            __builtin_amdgcn_fence(__ATOMIC_ACQUIRE, "agent");
            asm volatile("s_waitcnt vmcnt(0)" ::: "memory");
        }
    }
    __syncthreads();
}

__device__ __forceinline__ void xcd_barrier_arrive(const XcdBarrier& b, unsigned& tok, unsigned& tok2) {
    asm volatile("s_waitcnt vmcnt(0)" ::: "memory");
    __syncthreads();
    tok = 0u; tok2 = 0u;
    if (threadIdx.x == 0) {
        unsigned* bar = b.bar;
        __builtin_amdgcn_s_waitcnt(0);
        unsigned nloc = b.st[0], nx = b.st[1];
        if (nloc == 0u) { xcd_barrier_complete(bar, b.x, nloc, nx); b.st[0] = nloc; b.st[1] = nx; }
        const unsigned old = xb_add(&bar[XB_XSUB(b.x)], 1u);
        const unsigned gen = old / nloc;
        tok = gen & 0x3FFFFFFFu;
        if (old + 1u == (gen + 1u) * nloc) {
            __builtin_amdgcn_fence(__ATOMIC_RELEASE, "agent");
            asm volatile("s_waitcnt vmcnt(0)" ::: "memory");
            const unsigned og = xb_add(&bar[XB_TOP], 1u);
            const unsigned tg = og / nx;
            tok |= 1u << 30; tok2 = tg;
            if (og + 1u == (tg + 1u) * nx) { xb_add(&bar[XB_TOPGEN], 1u); tok |= 1u << 31; }
        }
    }
}
__device__ __forceinline__ void xcd_barrier_wait_t0(const XcdBarrier& b, unsigned tok, unsigned tok2) {
    unsigned* bar = b.bar;
    const unsigned gen = tok & 0x3FFFFFFFu;
    if (tok & (1u << 30)) {
        if (!(tok & (1u << 31))) XB_SPIN(xb_ld(&bar[XB_TOPGEN]) == tok2, bar);
        __builtin_amdgcn_fence(__ATOMIC_ACQUIRE, "agent");
        xb_add(&bar[XB_XGEN(b.x)], 1u);
        asm volatile("s_waitcnt vmcnt(0)" ::: "memory");
    } else {
        XB_SPIN(xb_ld(&bar[XB_XGEN(b.x)]) == gen, bar);
        __builtin_amdgcn_fence(__ATOMIC_ACQUIRE, "agent");
        asm volatile("s_waitcnt vmcnt(0)" ::: "memory");
    }
}

__host__ __device__ __forceinline__ int win_src_col(int nd) {
    if (nd < 4096 || nd >= 6144) return nd;
    const int t = (nd - 4096) >> 8, jj = (nd - 4096) & 255;
    return jj < 128 ? 4096 + 128 * t + jj : 5120 + 128 * t + (jj - 128);
}
__device__ __forceinline__ void p0_transpose_item(const float* __restrict__ W, int K, int N, bf16_t* __restrict__ WT, LAS float* scr, int kb, int n_src0, int n_dst0, int lane) {
    const int k0 = 64 * kb;
    float w[32];
#pragma unroll
    for (int i = 0; i < 32; ++i) w[i] = __builtin_nontemporal_load(W + (size_t)(k0 + 2 * i + (lane >> 5)) * N + n_src0 + (lane & 31));
#pragma unroll
    for (int i = 0; i < 32; ++i) scr[(2 * i + (lane >> 5)) * 33 + (lane & 31)] = w[i];
    LDS_WAIT(); asm volatile("" ::: "memory");
    const int c = lane & 7;
#pragma unroll
    for (int j = 0; j < 4; ++j) { const int n = (lane >> 3) + 8 * j; const LAS float* s = scr + (8 * c) * 33 + n;
        u32x4 o; o.x = cvt_pk_bf16(s[0 * 33], s[1 * 33]); o.y = cvt_pk_bf16(s[2 * 33], s[3 * 33]); o.z = cvt_pk_bf16(s[4 * 33], s[5 * 33]); o.w = cvt_pk_bf16(s[6 * 33], s[7 * 33]);
        st16_sc1(WT + (size_t)(n_dst0 + n) * K + k0 + 8 * c, o); }
    LDS_WAIT(); asm volatile("" ::: "memory");
}
__device__ __forceinline__ void p0_row(const float* __restrict__ src, bf16_t* __restrict__ dst, float* rstd_out, const f32x4 (&g)[8], int lane) {
    f32x4 v[8]; float s = 0.f;
#pragma unroll
    for (int j = 0; j < 8; ++j) v[j] = src ? __builtin_nontemporal_load((const f32x4*)src + lane + 64 * j) : (f32x4){0.f, 0.f, 0.f, 0.f};
#pragma unroll
    for (int j = 0; j < 8; ++j) s += (v[j][0] * v[j][0] + v[j][1] * v[j][1]) + (v[j][2] * v[j][2] + v[j][3] * v[j][3]);
    s = wave_sum(s);
    const float rs = src ? 1.0f / sqrtf(s * (1.0f / DM) + EPS) : 0.f;
    if (lane == 0) *rstd_out = rs;
#pragma unroll
    for (int j = 0; j < 8; ++j) { const f32x4 y = v[j] * g[j] * rs; u32x2 o; o.x = cvt_pk_bf16(y[0], y[1]); o.y = cvt_pk_bf16(y[2], y[3]); st8_sc1((u32x2*)dst + lane + 64 * j, o); }
}
__device__ __forceinline__ void p0_prologue(LAS unsigned char* lds, const float* x, const float* meta, const float* ln_g, const float* w_in, const float* pw_w, const float* w_out,
                                            unsigned char* ws, int b, int tid, int wid, int lane) {
    LAS float* scr = (LAS float*)(lds + wid * 16384);
    const int gw = b * 8 + wid, NGW = GRID * 8;
    bf16_t* Win = (bf16_t*)(ws + WS_WIN); bf16_t* Wout = (bf16_t*)(ws + WS_WOUT); bf16_t* Wpw = (bf16_t*)(ws + WS_WPW);
    constexpr int I_IN = 32 * 224, I_OUT = 32 * 64, I_PW = 16 * 32;
    for (int it = gw; it < I_IN + I_OUT + I_PW; it += NGW) {
        int r = it;
        if (r < I_IN) { const int kb = r / 224, nb = r % 224; p0_transpose_item(w_in, DM, INW, Win, scr, kb, win_src_col(32 * nb), 32 * nb, lane); continue; } r -= I_IN;
        if (r < I_OUT) { const int kb = r / 64, nb = r % 64; p0_transpose_item(w_out, DM, DM, Wout, scr, kb, 32 * nb, 32 * nb, lane); continue; } r -= I_OUT;
        { const int kb = r / 32, nb = r % 32; p0_transpose_item(pw_w, CW, CW, Wpw, scr, kb, 32 * nb, 32 * nb, lane); }
    }
    bf16_t* HB = (bf16_t*)(ws + WS_HB); float* rstd = (float*)(ws + WS_RSTD);
    f32x4 gl[8];
#pragma unroll
    for (int j = 0; j < 8; ++j) gl[j] = ((const f32x4*)ln_g)[lane + 64 * j];
    for (int r = gw; r < MPAD; r += NGW) {
        const float* src = r < SEQ ? x + (size_t)r * DM : (r < LTOK ? meta + (size_t)(r - SEQ) * DM : nullptr);
        p0_row(src, HB + (size_t)r * DM, rstd + r, gl, lane);
    }
    float* cosT = (float*)(ws + WS_COS); float* sinT = (float*)(ws + WS_SIN);
    const int gid = b * NTHREADS + tid, i = gid & 127;
    const double inv = exp2(-(double)i * 0.10381025296523007);
    for (int pos = gid >> 7; pos < LTOK; pos += (GRID * NTHREADS) >> 7) {
        const double a = (double)pos * inv;
        const double n = rint(a * 0.15915494309189535);
        const float rr = (float)fma(-n, 6.283185307179586, a);
        float sn, cs; sincosf(rr, &sn, &cs);
        cosT[(size_t)pos * 128 + i] = cs; sinT[(size_t)pos * 128 + i] = sn;
    }
}

__device__ __forceinline__ void wait_count(unsigned* p, unsigned want) {
    unsigned sp = 0;
    while (__hip_atomic_load(p, __ATOMIC_RELAXED, __HIP_MEMORY_SCOPE_AGENT) < want) { __builtin_amdgcn_s_sleep(2); if (++sp > (1u << 20)) break; }
}
struct Sched1 { int c; unsigned* ctl;
    __device__ __forceinline__ bool next(int i, Unit& u) const {
        const bool mb = (c >= 145) && (c <= 175) && (c & 1);
        if (mb && i == 2) { const int t = (c - 145) >> 1; u.pm = 32; u.pn = t < 8 ? 4 + t : 8 + t; return true; }
        const int L = (mb && i == 3 ? 2 : i) * GRID + c;
        if (i < 4 && L < 896) { const int xcd = L & 7, off = L >> 3, wg = xcd * 112 + off, gid = wg / 224, rem = wg % 224; u.pm = gid * 8 + (rem & 7); u.pn = rem >> 3; return true; }
        return false;
    }
    __device__ __forceinline__ void a_ready(const Unit&) const {}
    __device__ __forceinline__ void done(const Unit& u) const {
        Unit t3; (void)next(2, t3);
        const bool third = (u.pm == t3.pm && u.pn == t3.pn), meta = (u.pm == 32), gc = (u.pn >= 24);
        if (third || meta || gc) {
            asm volatile("s_waitcnt vmcnt(0)" ::: "memory");
            __syncthreads();
            if (threadIdx.x == 0) {
                if (meta) __hip_atomic_fetch_add(ctl + CW_META, 1u, __ATOMIC_RELAXED, __HIP_MEMORY_SCOPE_AGENT);
                if (third) __hip_atomic_fetch_add(ctl + CW_MID, 1u, __ATOMIC_RELAXED, __HIP_MEMORY_SCOPE_AGENT);
                if (gc) __hip_atomic_fetch_add(ctl + CW_GC + 64 * u.pm, 1u, __ATOMIC_RELAXED, __HIP_MEMORY_SCOPE_AGENT);
            }
        }
    }
};
struct Epi1 {
    static constexpr bool PERM = true, AFTER_DRAIN = false, INIT = false;
    bf16_t *Qt, *Kt, *V, *U, *GY; const float *rstd, *cosT, *sinT;
    __device__ __forceinline__ void operator()(const f32x4 (&acc)[2][2][4][2], const Unit& u, int wr, int wc, int fr, int fq) const {
        const int pn = u.pn; const bool meta = (u.pm == 32);
        if (meta && wr != 0) return;
        const int cl = wc * 32 + 8 * fq;
#pragma unroll
        for (int ai = 0; ai < 2; ++ai)
#pragma unroll
            for (int m = 0; m < 4; ++m) {
                if (meta && (ai | m)) continue;
                const int r = u.pm * 256 + ai * 128 + wr * 64 + m * 16 + fr;
                if (pn < 8) {
                    const int head = pn & 3; const bool isk = pn >= 4;
                    const int pos = meta ? (r - SEQ) : (r + NMETA);
                    const int il = meta ? (112 + r - SEQ) : (r & 127);
                    const float l2g = kLog2G[head];
                    const float dec = isk ? 0.0625f * exp2f((float)(127 - il) * l2g) : exp2f((float)(il + 1) * l2g);
                    const f32x4* cp = (const f32x4*)(cosT + (size_t)pos * 128 + cl); const f32x4* sp = (const f32x4*)(sinT + (size_t)pos * 128 + cl);
                    f32x4 o1[2], o2[2];
#pragma unroll
                    for (int n = 0; n < 2; ++n) { const f32x4 c = cp[n], s = sp[n], x1 = acc[ai][0][m][n], x2 = acc[ai][1][m][n];
                        o1[n] = (x1 * c - x2 * s) * dec; o2[n] = (x1 * s + x2 * c) * dec; }
                    bf16_t* dst = (isk ? Kt : Qt) + (size_t)r * RW + head * 256 + cl;
                    if (isk) { st16_sc1(dst, pack8(o1[0], o1[1])); st16_sc1(dst + 128, pack8(o2[0], o2[1])); }
                    else { *(u32x4*)dst = pack8(o1[0], o1[1]); *(u32x4*)(dst + 128) = pack8(o2[0], o2[1]); }
                } else if (pn < 12) {
                    bf16_t* dst = V + (size_t)r * RW + (pn - 8) * 256 + cl;
#pragma unroll
                    for (int bj = 0; bj < 2; ++bj) st16_sc1(dst + 128 * bj, pack8(acc[ai][bj][m][0], acc[ai][bj][m][1]));
                } else if (pn < 16 || pn >= 24) {
                    bf16_t* dst = GY + (size_t)r * DM + (pn < 16 ? (pn - 12) * 256 : 1024 + (pn - 24) * 256) + cl;
#pragma unroll
                    for (int bj = 0; bj < 2; ++bj) { f32x4 g0 = acc[ai][bj][m][0], g1 = acc[ai][bj][m][1];
#pragma unroll
                        for (int e = 0; e < 4; ++e) { g0[e] = silu_f(g0[e]); g1[e] = silu_f(g1[e]); }
                        if (pn >= 24) st16_sc1(dst + 128 * bj, pack8(g0, g1)); else *(u32x4*)(dst + 128 * bj) = pack8(g0, g1); }
                } else {
                    f32x4 u0 = acc[ai][0][m][0], u1 = acc[ai][0][m][1]; const f32x4 b0 = acc[ai][1][m][0], b1 = acc[ai][1][m][1];
#pragma unroll
                    for (int e = 0; e < 4; ++e) { u0[e] *= sigmoid_f(b0[e]); u1[e] *= sigmoid_f(b1[e]); }
                    st16_sc1(U + (size_t)r * CW + (pn - 16) * 128 + cl, pack8(u0, u1));
                }
            }
    }
};

__device__ __forceinline__ void p2a_kv(LAS unsigned char* lds, const bf16_t* __restrict__ Kt, const bf16_t* __restrict__ V, bf16_t* __restrict__ KVT, int c, int h, int tid, int wid, int lane) {
    constexpr int PT = 576, PR = 528;
    LAS unsigned char* imgK = lds; LAS unsigned char* imgV = lds + 128 * PT;
    {
        u32x4 kreg[8], vreg[8];
#pragma unroll
        for (int it = 0; it < 8; ++it) {
            const int ci = tid + NTHREADS * it, row = ci >> 5, cc = ci & 31;
            const size_t grow = c > 0 ? (size_t)(c - 1) * 128 + row : (size_t)(SEQ + (row >= 112 ? row - 112 : 0));
            kreg[it] = *(const u32x4*)(Kt + grow * RW + h * 256 + cc * 8); vreg[it] = *(const u32x4*)(V + grow * RW + h * 256 + cc * 8);
        }
#pragma unroll
        for (int it = 0; it < 8; ++it) {
            const int ci = tid + NTHREADS * it, row = ci >> 5, cc = ci & 31;
            const bool valid = (c > 0) || (row >= 112);
            u32x4 kv = kreg[it], vv = vreg[it];
            if (!valid) { kv = (u32x4){0u, 0u, 0u, 0u}; vv = kv; }
            *(LAS u32x4*)(imgK + row * PT + cc * 16) = kv; *(LAS u32x4*)(imgV + row * PT + cc * 16) = vv;
        }
    }
    __syncthreads();
    const int w2 = wid >> 2, w4 = wid & 3, n31 = lane & 31, i16 = lane & 15, q4 = i16 >> 2, p4 = i16 & 3, blk = (lane >> 4) & 1, hh = lane >> 5;
    f32x16 acc[4][2];
#pragma unroll
    for (int a = 0; a < 4; ++a)
#pragma unroll
        for (int b2 = 0; b2 < 2; ++b2)
#pragma unroll
            for (int e = 0; e < 16; ++e) acc[a][b2][e] = 0.f;
#pragma unroll
    for (int ks = 0; ks < 8; ++ks) {
        const int tok = 16 * ks + 8 * hh + q4;
        bf16x8 af[4], bf[2];
#pragma unroll
        for (int a = 0; a < 4; ++a) { const int col0 = 128 * w2 + 32 * a + 16 * blk + 4 * p4;
            const s16x4 lo = tr_read(imgK + tok * PT + col0 * 2), hi = tr_read(imgK + (tok + 4) * PT + col0 * 2);
            af[a] = __builtin_shufflevector(lo, hi, 0, 1, 2, 3, 4, 5, 6, 7); }
#pragma unroll
        for (int b2 = 0; b2 < 2; ++b2) { const int col0 = 64 * w4 + 32 * b2 + 16 * blk + 4 * p4;
            const s16x4 lo = tr_read(imgV + tok * PT + col0 * 2), hi = tr_read(imgV + (tok + 4) * PT + col0 * 2);
            bf[b2] = __builtin_shufflevector(lo, hi, 0, 1, 2, 3, 4, 5, 6, 7); }
#pragma unroll
        for (int a = 0; a < 4; ++a)
#pragma unroll
            for (int b2 = 0; b2 < 2; ++b2) acc[a][b2] = MFMA32(af[a], bf[b2], acc[a][b2]);
    }
    __syncthreads();
#pragma unroll
    for (int a = 0; a < 4; ++a)
#pragma unroll
        for (int b2 = 0; b2 < 2; ++b2)
#pragma unroll
            for (int g = 0; g < 4; ++g) { u32x2 o; o.x = cvt_pk_bf16(acc[a][b2][4 * g], acc[a][b2][4 * g + 1]); o.y = cvt_pk_bf16(acc[a][b2][4 * g + 2], acc[a][b2][4 * g + 3]);
                *(LAS u32x2*)(lds + (64 * w4 + 32 * b2 + n31) * PR + (128 * w2 + 32 * a + 8 * g + 4 * hh) * 2) = o; }
    __syncthreads();
    bf16_t* dst = KVT;
#pragma unroll
    for (int it = 0; it < 16; ++it) {
        const int ci = tid + NTHREADS * it, row = ci >> 5, cc = ci & 31;
        *(u32x4*)(dst + (size_t)row * 256 + cc * 8) = *(LAS u32x4*)(lds + row * PR + cc * 16);
    }
    __syncthreads();
}
__device__ __forceinline__ void conv_rows_load(unsigned (&raw)[32 + CK - 1], const bf16_t* __restrict__ U, int ct, int tid) {
    if (ct == 0) {
        const int p0 = NMETA - (CK - 1);
#pragma unroll
        for (int s = 0; s < 32 + CK - 1; ++s) {
            const int p = p0 + s, pc = p < 0 ? 0 : p, row = pc >= NMETA ? pc - NMETA : SEQ + pc;
            raw[s] = *(const unsigned*)(U + (size_t)row * CW + 2 * tid);
            if (p < 0) raw[s] = 0u;
        }
    } else {
        const bf16_t* b0 = U + (size_t)(32 * ct - (CK - 1)) * CW + 2 * tid;
#pragma unroll
        for (int s = 0; s < 32 + CK - 1; ++s) raw[s] = *(const unsigned*)(b0 + (size_t)s * CW);
    }
}
__device__ __forceinline__ int p2a_conv_run(LAS unsigned char* lds, const bf16_t* __restrict__ U, const float* __restrict__ dw_w, const float* __restrict__ dw_b, const float* __restrict__ ln_g, const float* __restrict__ ln_b,
                                            bf16_t* __restrict__ CB, unsigned* ctl, volatile LAS unsigned* misc, int ct, int tid0, int wid) {
    f32x2 w[CK];
#pragma unroll
    for (int j = 0; j < CK; ++j) w[j] = *(const f32x2*)(dw_w + j * CW + 2 * tid0);
    const f32x2 bias = *(const f32x2*)(dw_b + 2 * tid0);
    unsigned raw[32 + CK - 1];
    conv_rows_load(raw, U, ct, tid0);
    int prev = -1, nxt;
#pragma unroll 1
    for (;;) {
        int tid = tid0; asm volatile("" : "+v"(tid));
        const int lane = tid & 63;
        {
            f32x2 acc[32];
#pragma unroll
            for (int t = 0; t < 32; ++t) acc[t] = bias;
#pragma unroll
            for (int s = 0; s < 32 + CK - 1; ++s) {
                const f32x2 uv = {bf_lo(raw[s]), bf_hi(raw[s])};
#pragma unroll
                for (int t = (s - (CK - 1) > 0 ? s - (CK - 1) : 0); t <= (s < 31 ? s : 31); ++t) acc[t] = __builtin_elementwise_fma(uv, w[s - t], acc[t]);
            }
            asm volatile("s_waitcnt vmcnt(0)" ::: "memory");
            __syncthreads();
#pragma unroll
            for (int t = 0; t < 32; ++t) *(LAS f32x2*)(lds + (t * CW + 2 * tid) * 4) = acc[t];
        }
        if (tid == 0) misc[0] = __hip_atomic_fetch_add(ctl + CW_Q, 1u, __ATOMIC_RELAXED, __HIP_MEMORY_SCOPE_AGENT);
        __syncthreads();
        if (tid == 0 && prev >= 0) __hip_atomic_fetch_add(ctl + CW_CONV + 64 * (prev >> 3), 1u, __ATOMIC_RELAXED, __HIP_MEMORY_SCOPE_AGENT);
        nxt = (int)misc[0];
        {
            f32x4 gg[2][2], bb[2][2];
#pragma unroll
            for (int i = 0; i < 2; ++i)
#pragma unroll
                for (int q = 0; q < 2; ++q) { gg[i][q] = *(const f32x4*)(ln_g + 512 * i + 8 * lane + 4 * q); bb[i][q] = *(const f32x4*)(ln_b + 512 * i + 8 * lane + 4 * q); }
            if (nxt < 256) conv_rows_load(raw, U, nxt, tid);
#pragma unroll
            for (int k = 0; k < 4; ++k) {
                const int t = 4 * wid + k;
                f32x4 v[2][2]; float sm = 0.f;
#pragma unroll
                for (int i = 0; i < 2; ++i)
#pragma unroll
                    for (int q = 0; q < 2; ++q) { v[i][q] = *(LAS f32x4*)(lds + (t * CW + 512 * i + 8 * lane + 4 * q) * 4); sm += (v[i][q][0] + v[i][q][1]) + (v[i][q][2] + v[i][q][3]); }
                const float mu = wave_sum(sm) * (1.0f / CW);
                float qq = 0.f;
#pragma unroll
                for (int i = 0; i < 2; ++i)
#pragma unroll
                    for (int q = 0; q < 2; ++q) { v[i][q] = v[i][q] - mu; qq += (v[i][q][0] * v[i][q][0] + v[i][q][1] * v[i][q][1]) + (v[i][q][2] * v[i][q][2] + v[i][q][3] * v[i][q][3]); }
                const float rs = 1.0f / sqrtf(wave_sum(qq) * (1.0f / CW) + EPS);
#pragma unroll
                for (int i = 0; i < 2; ++i) { f32x4 y0 = v[i][0] * rs * gg[i][0] + bb[i][0], y1 = v[i][1] * rs * gg[i][1] + bb[i][1];
#pragma unroll
                    for (int e = 0; e < 4; ++e) { y0[e] = silu_f(y0[e]); y1[e] = silu_f(y1[e]); }
                    st16_sc1(CB + (size_t)(32 * ct + t) * CW + 512 * i + 8 * lane, pack8(y0, y1)); }
            }
        }
        prev = ct;
        if (nxt >= 256) break;
        ct = nxt;
    }
    asm volatile("s_waitcnt vmcnt(0)" ::: "memory");
    __syncthreads();
    if (tid0 == 0) __hip_atomic_fetch_add(ctl + CW_CONV + 64 * (prev >> 3), 1u, __ATOMIC_RELAXED, __HIP_MEMORY_SCOPE_AGENT);
    return nxt;
}

__device__ __forceinline__ void p2b_scan(bf16_t* ST, int sb, int tid) {
    const int e2 = sb * NTHREADS + tid, h = e2 >> 15;
    const float cd = exp2f(128.0f * kLog2G[h]);
    f32x2 S = {0.f, 0.f};
    unsigned* p = (unsigned*)ST + e2;
#pragma unroll 1
    for (int c0 = 0; c0 < 64; c0 += 16) {
        unsigned kv[16];
#pragma unroll
        for (int j = 0; j < 16; ++j) kv[j] = __builtin_nontemporal_load(p + (size_t)(c0 + j) * 131072);
#pragma unroll
        for (int j = 0; j < 16; ++j) {
            const f32x2 k2 = {bf_lo(kv[j]), bf_hi(kv[j])};
            S = S * cd + k2;
            p[(size_t)(c0 + j) * 131072] = cvt_pk_bf16(S[0], S[1]);
        }
    }
}
struct SchedOne { int pm, pn; bool on;
    __device__ __forceinline__ bool next(int i, Unit& u) const { if (i > 0 || !on) return false; u.pm = pm; u.pn = pn; return true; }
    __device__ __forceinline__ void a_ready(const Unit&) const {}
    __device__ __forceinline__ void done(const Unit&) const {}
};
struct EpiPw {
    static constexpr bool PERM = true, AFTER_DRAIN = false, INIT = false;
    bf16_t* GY; const float* pw_b;
    __device__ __forceinline__ void operator()(const f32x4 (&acc)[2][2][4][2], const Unit& u, int wr, int wc, int fr, int fq) const {
        const int cl = wc * 32 + 8 * fq;
#pragma unroll
        for (int bj = 0; bj < 2; ++bj) {
            const int col = u.pn * 256 + bj * 128 + cl;
            const f32x4 b0 = *(const f32x4*)(pw_b + col), b1 = *(const f32x4*)(pw_b + col + 4);
#pragma unroll
            for (int ai = 0; ai < 2; ++ai)
#pragma unroll
                for (int m = 0; m < 4; ++m) {
                    const int r = u.pm * 256 + ai * 128 + wr * 64 + m * 16 + fr;
                    bf16_t* p = GY + (size_t)r * DM + 1024 + col;
                    const u32x4 g = *(const u32x4*)p;
                    const f32x4 g0 = {bf_lo(g.x), bf_hi(g.x), bf_lo(g.y), bf_hi(g.y)}, g1 = {bf_lo(g.z), bf_hi(g.z), bf_lo(g.w), bf_hi(g.w)};
                    *(u32x4*)p = pack8((acc[ai][bj][m][0] + b0) * g0, (acc[ai][bj][m][1] + b1) * g1);
                }
        }
    }
};

__device__ __forceinline__ void p2c_images(LAS unsigned char* lds, const bf16_t* __restrict__ Qt, const bf16_t* __restrict__ Kt, int xc, int h, int tid) {
    constexpr int PR = 528;
    LAS unsigned char* imgQ = lds; LAS unsigned char* imgK = lds + 73728;
    const size_t row0 = (size_t)xc * 128;
#pragma unroll
    for (int it = 0; it < 8; ++it) {
        const int ci = tid + NTHREADS * it, row = ci >> 5, cc = ci & 31;
        const u32x4 q = __builtin_nontemporal_load((const u32x4*)(Qt + (row0 + row) * RW + h * 256 + cc * 8)), k = __builtin_nontemporal_load((const u32x4*)(Kt + (row0 + row) * RW + h * 256 + cc * 8));
        *(LAS u32x4*)(imgQ + row * PR + cc * 16) = q; *(LAS u32x4*)(imgK + row * PR + cc * 16) = k;
    }
}
__device__ __forceinline__ void p2c_item(LAS unsigned char* lds, const bf16_t* __restrict__ Qt, const bf16_t* __restrict__ Kt, const bf16_t* __restrict__ V, const bf16_t* __restrict__ ST, bf16_t* __restrict__ GY,
                                         const float* __restrict__ gn_g, int xc, int h, int tid, int wid, int lane, const XcdBarrier& bar, bool pending, unsigned tok, unsigned tok2, bool preloaded) {
    constexpr int PR = 528, PT = 576, PF = 1040;
    LAS unsigned char* imgQ = lds; LAS unsigned char* imgK = lds + 73728; LAS unsigned char* imgV = lds + 73728; LAS unsigned char* imgS = lds;
    LAS float* ex = (LAS float*)(lds + 135168);
    const int wr = wid >> 1, wc = wid & 1, n31 = lane & 31, hh = lane >> 5, i16 = lane & 15, q4 = i16 >> 2, p4 = i16 & 3, blk = (lane >> 4) & 1;
    const size_t row0 = (size_t)xc * 128;
    if (!preloaded) p2c_images(lds, Qt, Kt, xc, h, tid);
    u32x4 vreg[8];
#pragma unroll
    for (int it = 0; it < 8; ++it) { const int ci = tid + NTHREADS * it, row = ci >> 5, cc = ci & 31; vreg[it] = __builtin_nontemporal_load((const u32x4*)(V + (row0 + row) * RW + h * 256 + cc * 8)); }
    __syncthreads();
    const float ginv = exp2f(-128.0f * kLog2G[h]);
    bf16x8 pf[4][2];
    {
        bf16x8 qf[16];
#pragma unroll
        for (int ks = 0; ks < 16; ++ks) qf[ks] = *(LAS bf16x8*)(imgQ + (32 * wr + n31) * PR + (16 * ks + 8 * hh) * 2);
#pragma unroll
        for (int jb = 0; jb < 4; ++jb) {
            if (jb <= wr) {
                f32x16 X;
#pragma unroll
                for (int e = 0; e < 16; ++e) X[e] = 0.f;
#pragma unroll
                for (int ks = 0; ks < 16; ++ks) { const bf16x8 kf = *(LAS bf16x8*)(imgK + (32 * jb + n31) * PR + (16 * ks + 8 * hh) * 2); X = MFMA32(kf, qf[ks], X); }
#pragma unroll
                for (int e = 0; e < 16; ++e) { const bool keep = (jb < wr) || (crow(e, hh) <= n31); X[e] = keep ? X[e] * ginv : 0.f; }
#pragma unroll
                for (int s2 = 0; s2 < 2; ++s2) { u32x4 p; p.x = cvt_pk_bf16(X[8 * s2], X[8 * s2 + 1]); p.y = cvt_pk_bf16(X[8 * s2 + 2], X[8 * s2 + 3]); p.z = cvt_pk_bf16(X[8 * s2 + 4], X[8 * s2 + 5]); p.w = cvt_pk_bf16(X[8 * s2 + 6], X[8 * s2 + 7]);
                    pf[jb][s2] = __builtin_bit_cast(bf16x8, p); }
            } else { pf[jb][0] = (bf16x8){0, 0, 0, 0, 0, 0, 0, 0}; pf[jb][1] = pf[jb][0]; }
        }
    }
    if (pending && tid == 0) xcd_barrier_wait_t0(bar, tok, tok2);
    __syncthreads();
#pragma unroll
    for (int it = 0; it < 8; ++it) { const int ci = tid + NTHREADS * it, row = ci >> 5, cc = ci & 31; *(LAS u32x4*)(imgV + row * PT + cc * 16) = vreg[it]; }
    const bf16_t* Ssrc = ST + (size_t)(xc * 4 + h) * 65536;
    u32x4 sreg[8];
#pragma unroll
    for (int it = 0; it < 8; ++it) { const int ci = tid + NTHREADS * it, row = ci >> 5, cc = ci & 31; sreg[it] = __builtin_nontemporal_load((const u32x4*)(Ssrc + (size_t)row * 256 + cc * 8)); }
    __syncthreads();
    f32x16 acc[4];
#pragma unroll
    for (int nb = 0; nb < 4; ++nb)
#pragma unroll
        for (int e = 0; e < 16; ++e) acc[nb][e] = 0.f;
#pragma unroll
    for (int jb = 0; jb < 4; ++jb) {
        if (jb <= wr) {
#pragma unroll
            for (int s2 = 0; s2 < 2; ++s2) {
                const int tok = 32 * jb + 16 * s2 + 4 * hh + q4;
#pragma unroll
                for (int nb = 0; nb < 4; ++nb) { const int col0 = 128 * wc + 32 * nb + 16 * blk + 4 * p4;
                    const s16x4 lo = tr_read(imgV + tok * PT + col0 * 2), hi = tr_read(imgV + (tok + 8) * PT + col0 * 2);
                    const bf16x8 vf = __builtin_shufflevector(lo, hi, 0, 1, 2, 3, 4, 5, 6, 7);
                    acc[nb] = MFMA32(pf[jb][s2], vf, acc[nb]); }
            }
        }
    }
    bf16x8 qf[16];
#pragma unroll
    for (int ks = 0; ks < 16; ++ks) qf[ks] = *(LAS bf16x8*)(imgQ + (32 * wr + n31) * PR + (16 * ks + 8 * hh) * 2);
    __syncthreads();
    {
        u32x4 sreg2[8];
#pragma unroll
        for (int it = 0; it < 8; ++it) { const int ci = tid + NTHREADS * (it + 8), row = ci >> 5, cc = ci & 31; sreg2[it] = __builtin_nontemporal_load((const u32x4*)(Ssrc + (size_t)row * 256 + cc * 8)); }
#pragma unroll
        for (int it = 0; it < 8; ++it) { const int ci = tid + NTHREADS * it, row = ci >> 5, cc = ci & 31; *(LAS u32x4*)(imgS + row * PR + cc * 16) = sreg[it]; }
#pragma unroll
        for (int it = 0; it < 8; ++it) { const int ci = tid + NTHREADS * (it + 8), row = ci >> 5, cc = ci & 31; *(LAS u32x4*)(imgS + row * PR + cc * 16) = sreg2[it]; }
    }
    u32x4 greg[8];
#pragma unroll
    for (int it = 0; it < 8; ++it) { const int ci = tid + NTHREADS * it, row = ci >> 5, cc = ci & 31; greg[it] = __builtin_nontemporal_load((const u32x4*)(GY + (row0 + row) * DM + h * 256 + cc * 8)); }
    __syncthreads();
#pragma unroll
    for (int ks = 0; ks < 16; ++ks)
#pragma unroll
        for (int nb = 0; nb < 4; ++nb) { const bf16x8 sf = *(LAS bf16x8*)(imgS + (128 * wc + 32 * nb + n31) * PR + (16 * ks + 8 * hh) * 2); acc[nb] = MFMA32(qf[ks], sf, acc[nb]); }
    float sm[16], sq[16];
#pragma unroll
    for (int e = 0; e < 16; ++e) {
        float a = (acc[0][e] + acc[1][e]) + (acc[2][e] + acc[3][e]);
        float q = (acc[0][e] * acc[0][e] + acc[1][e] * acc[1][e]) + (acc[2][e] * acc[2][e] + acc[3][e] * acc[3][e]);
        a = sum32(a); q = sum32(q);
        sm[e] = a; sq[e] = q;
        if (n31 == e) { ex[(wid * 32 + crow(e, hh)) * 2] = a; ex[(wid * 32 + crow(e, hh)) * 2 + 1] = q; }
    }
    __syncthreads();
    float gng[4];
#pragma unroll
    for (int nb = 0; nb < 4; ++nb) gng[nb] = gn_g[h * 256 + 128 * wc + 32 * nb + n31];
#pragma unroll
    for (int e = 0; e < 16; ++e) {
        const int rl = crow(e, hh);
        const float ta = sm[e] + ex[((wid ^ 1) * 32 + rl) * 2], tq = sq[e] + ex[((wid ^ 1) * 32 + rl) * 2 + 1];
        const float mu = ta * (1.0f / RD), var = tq * (1.0f / RD) - mu * mu, rs = __builtin_amdgcn_rsqf(fmaxf(var, 0.f) + EPS);
#pragma unroll
        for (int nb = 0; nb < 4; ++nb) *(LAS float*)(lds + (32 * wr + rl) * PF + (128 * wc + 32 * nb + n31) * 4) = (acc[nb][e] - mu) * rs * gng[nb];
    }
    __syncthreads();
#pragma unroll
    for (int it = 0; it < 8; ++it) {
        const int ci = tid + NTHREADS * it, row = ci >> 5, cc = ci & 31;
        const f32x4 y0 = *(LAS f32x4*)(lds + row * PF + cc * 32), y1 = *(LAS f32x4*)(lds + row * PF + cc * 32 + 16);
        const u32x4 g = greg[it];
        const f32x4 g0 = {bf_lo(g.x), bf_hi(g.x), bf_lo(g.y), bf_hi(g.y)}, g1 = {bf_lo(g.z), bf_hi(g.z), bf_lo(g.w), bf_hi(g.w)};
        st16_sc1(GY + (row0 + row) * DM + h * 256 + cc * 8, pack8(y0 * g0, y1 * g1));
    }
    asm volatile("s_waitcnt vmcnt(0)" ::: "memory");
    __syncthreads();
}

struct SchedP3 { int pm, pn; unsigned* cnt; unsigned want;
    __device__ __forceinline__ bool next(int i, Unit& u) const { if (i > 0) return false; u.pm = pm; u.pn = pn; return true; }
    __device__ __forceinline__ void a_ready(const Unit&) const {
        if (threadIdx.x == 0) { wait_count(cnt + 64 * pm, want); __builtin_amdgcn_fence(__ATOMIC_ACQUIRE, "agent"); asm volatile("s_waitcnt vmcnt(0)" ::: "memory"); }
        __syncthreads();
    }
    __device__ __forceinline__ void done(const Unit&) const {}
};
struct Epi3 {
    static constexpr bool PERM = true, AFTER_DRAIN = true, INIT = true;
    const float* x; float* out; const float* final_g; float* psum; unsigned* panel;
    __device__ __forceinline__ void init(f32x4 (&acc)[2][2][4][2], const Unit& u, int wr, int wc, int fr, int fq) const {
        const int cl = wc * 32 + 8 * fq;
#pragma unroll
        for (int ai = 0; ai < 2; ++ai)
#pragma unroll
            for (int m = 0; m < 4; ++m) { const float* xr = x + ((size_t)u.pm * 256 + ai * 128 + wr * 64 + m * 16 + fr) * DM + u.pn * 256 + cl;
#pragma unroll
                for (int bj = 0; bj < 2; ++bj)
#pragma unroll
                    for (int n = 0; n < 2; ++n) acc[ai][bj][m][n] = __builtin_nontemporal_load((const f32x4*)(xr + bj * 128 + 4 * n)); }
    }
    __device__ __forceinline__ void fused(f32x4 (&acc)[2][2][4][2], const Unit& u, int wr, int wc, int fr, int fq, LAS unsigned char* lds, int wid, int lane) const {
        constexpr int PF = 1040;
        int ln = lane; asm volatile("" : "+v"(ln));
        const int cl = wc * 32 + 8 * fq, wv = wid;
        const size_t prow = (size_t)u.pn * SEQ + u.pm * 256;
        LAS float* red = (LAS float*)(lds + 135168);
#pragma unroll
        for (int ai = 0; ai < 2; ++ai)
#pragma unroll
            for (int m = 0; m < 4; ++m) {
                float sq = 0.f;
#pragma unroll
                for (int bj = 0; bj < 2; ++bj)
#pragma unroll
                    for (int n = 0; n < 2; ++n) { const f32x4 v = acc[ai][bj][m][n]; sq += (v[0] * v[0] + v[1] * v[1]) + (v[2] * v[2] + v[3] * v[3]); }
                sq += __builtin_bit_cast(float, __builtin_amdgcn_ds_swizzle(__builtin_bit_cast(int, sq), 0x401F)); sq += __shfl_xor(sq, 32);
                if (fq == 0) red[wc * 256 + ai * 128 + wr * 64 + m * 16 + fr] = sq;
            }
        __syncthreads();
        if (threadIdx.x < 256) { const int t = threadIdx.x; const float tot = (red[t] + red[256 + t]) + (red[512 + t] + red[768 + t]);
            __hip_atomic_store(psum + prow + t, tot, __ATOMIC_RELAXED, __HIP_MEMORY_SCOPE_AGENT); }
        asm volatile("s_waitcnt vmcnt(0)" ::: "memory");
        __syncthreads();
        if (threadIdx.x == 0) __hip_atomic_fetch_add(panel + 64 * u.pm, 1u, __ATOMIC_RELAXED, __HIP_MEMORY_SCOPE_AGENT);
        f32x4 hreg[2][16];
#pragma unroll
        for (int ai = 0; ai < 2; ++ai) {
            if (ai) __syncthreads();
#pragma unroll
            for (int m = 0; m < 4; ++m)
#pragma unroll
                for (int bj = 0; bj < 2; ++bj)
#pragma unroll
                    for (int n = 0; n < 2; ++n) *(LAS f32x4*)(lds + (wr * 64 + m * 16 + fr) * PF + (bj * 128 + cl + 4 * n) * 4) = acc[ai][bj][m][n];
            __syncthreads();
#pragma unroll
            for (int it = 0; it < 16; ++it) hreg[ai][it] = *(LAS f32x4*)(lds + (wv + 8 * it) * PF + ln * 16);
        }
        if (threadIdx.x == 0) {
            wait_count(panel + 64 * u.pm, 8u);
            __builtin_amdgcn_fence(__ATOMIC_ACQUIRE, "agent");
            asm volatile("s_waitcnt vmcnt(0)" ::: "memory");
        }
        __syncthreads();
        float rsl;
        { const size_t r = (size_t)u.pm * 256 + (ln >> 4 & 1) * 128 + wv + 8 * (ln & 15);
          float tot = 0.f;
#pragma unroll
          for (int p = 0; p < 8; ++p) tot += psum[(size_t)p * SEQ + r];
          rsl = 1.0f / sqrtf(tot * (1.0f / DM) + EPS); }
        const f32x4 g = *(const f32x4*)(final_g + u.pn * 256 + 4 * ln);
        float* ob = out + ((size_t)u.pm * 256 + wv) * DM + u.pn * 256 + 4 * ln;
#pragma unroll
        for (int ai = 0; ai < 2; ++ai)
#pragma unroll
            for (int it = 0; it < 16; ++it) {
                const float rs = __builtin_bit_cast(float, __builtin_amdgcn_readlane(__builtin_bit_cast(int, rsl), ai * 16 + it));
                __builtin_nontemporal_store(hreg[ai][it] * rs * g, (f32x4*)(ob + (size_t)(ai * 128 + 8 * it) * DM));
            }
    }
};

struct Args { const float* in[13]; float* out; unsigned char* ws; int ph_lo, ph_hi; };
__global__ void __launch_bounds__(NTHREADS, 2) mega(Args a) {
    extern __shared__ __attribute__((aligned(16))) unsigned char lds_[];
    LAS unsigned char* lds = (LAS unsigned char*)lds_;
    const int tid = threadIdx.x, lane = tid & 63, wid = __builtin_amdgcn_readfirstlane(tid >> 6), b = blockIdx.x;
    unsigned char* ws = a.ws;
    const float *x = a.in[0], *meta = a.in[1], *ln_g = a.in[2], *w_in = a.in[3], *gn_g = a.in[4], *dw_w = a.in[5], *dw_b = a.in[6], *cln_g = a.in[7], *cln_b = a.in[8],
                *pw_w = a.in[9], *pw_b = a.in[10], *w_out = a.in[11], *final_g = a.in[12];
    for (int u = tid; u < (LDS_BYTES - MISC_OFF) / 4; u += NTHREADS) ((LAS unsigned*)(lds + MISC_OFF))[u] = 0u;
    __syncthreads();
    XcdBarrier bar = xcd_barrier_post((unsigned*)(ws + WS_CTL) + CW_BAR, (volatile LAS unsigned*)(lds + MISC_OFF) + 8);
    const int lo = a.ph_lo, hi = a.ph_hi;
#define IN(k) (lo <= (k) && (k) < hi)
#define SEAM(k) do { if (IN(k) && IN((k) + 1)) xcd_barrier(bar); } while (0)
#define WS_LAUNDER() size_t wsz_ = 0; asm volatile("" : "+s"(wsz_)); unsigned char* wsl = ws + wsz_
    if (IN(0)) { p0_prologue(lds, x, meta, ln_g, w_in, pw_w, w_out, ws, b, tid, wid, lane); }
    SEAM(0);
    if (IN(1)) {
        unsigned* ctl = (unsigned*)(ws + WS_CTL);
        {
            WS_LAUNDER();
            pg8::Gemm g{(const bf16_t*)(wsl + WS_HB), (const bf16_t*)(wsl + WS_WIN), MPAD, INW, DM};
            Sched1 S{b, ctl};
            Epi1 E{(bf16_t*)(wsl + WS_QT), (bf16_t*)(wsl + WS_KT), (bf16_t*)(wsl + WS_V), (bf16_t*)(wsl + WS_U), (bf16_t*)(wsl + WS_GY), (const float*)(wsl + WS_RSTD), (const float*)(wsl + WS_COS), (const float*)(wsl + WS_SIN)};
            pg8::gemm_phase<Epi1, Sched1, true, true>(lds, g, S, E);
        }
        {
            WS_LAUNDER();
            volatile LAS unsigned* misc = (volatile LAS unsigned*)(lds + MISC_OFF);
            if (tid == 0) { wait_count(ctl + CW_MID, (unsigned)GRID); __builtin_amdgcn_fence(__ATOMIC_ACQUIRE, "agent"); asm volatile("s_waitcnt vmcnt(0)" ::: "memory"); }
            __syncthreads();
            bool meta_ok = false;
            int carried = -1;
            for (;;) {
                int item;
                if (carried >= 0) { item = carried; carried = -1; }
                else {
                    if (tid == 0) misc[0] = __hip_atomic_fetch_add(ctl + CW_Q, 1u, __ATOMIC_RELAXED, __HIP_MEMORY_SCOPE_AGENT);
                    __syncthreads();
                    item = (int)misc[0];
                    __syncthreads();
                }
                if (item >= 640) break;
                if (item >= 256 && item < 384) {
                    const int pm = (item - 256) >> 2, pn = item & 3;
                    if (tid == 0) { wait_count(ctl + CW_CONV + 64 * pm, 8u); wait_count(ctl + CW_GC + 64 * pm, 4u); __builtin_amdgcn_fence(__ATOMIC_ACQUIRE, "agent"); asm volatile("s_waitcnt vmcnt(0)" ::: "memory"); }
                    __syncthreads();
                    size_t zp = 0; asm volatile("" : "+s"(zp));
                    pg8::Gemm g{(const bf16_t*)(wsl + WS_CB) + zp, (const bf16_t*)(wsl + WS_WPW) + zp, SEQ, CW, CW};
                    SchedOne S{pm, pn, true};
                    EpiPw E{(bf16_t*)(wsl + WS_GY) + zp, pw_b + zp};
                    pg8::gemm_phase<EpiPw, SchedOne, false, true>(lds, g, S, E);
                    continue;
                }
                const bool is_kv = item >= 384;
                const int j = is_kv ? item - 384 : item;
                const int c = j < 252 ? (j >> 2) + 1 : 0, hq = j & 3, ct = j;
                const bool needs_meta = is_kv ? (c == 0) : (ct == 0);
                if (needs_meta && !meta_ok) {
                    if (tid == 0) { wait_count(ctl + CW_META, 16u); __builtin_amdgcn_fence(__ATOMIC_ACQUIRE, "agent"); asm volatile("s_waitcnt vmcnt(0)" ::: "memory"); }
                    __syncthreads();
                    meta_ok = true;
                }
                size_t zi = 0; asm volatile("" : "+s"(zi));
                int tl = tid; asm volatile("" : "+v"(tl));
                const int ll = tl & 63, wl = __builtin_amdgcn_readfirstlane(tl >> 6);
                if (is_kv) p2a_kv(lds, (const bf16_t*)(wsl + WS_KT) + zi, (const bf16_t*)(wsl + WS_V) + zi, kvt_tile(wsl, c * 4 + hq) + zi, c, hq, tl, wl, ll);
                else { carried = p2a_conv_run(lds, (const bf16_t*)(wsl + WS_U) + zi, dw_w + zi, dw_b + zi, cln_g + zi, cln_b + zi, (bf16_t*)(wsl + WS_CB) + zi, ctl, misc, ct, tl, wl);
                       __syncthreads(); }
            }
        }
    }
    const bool preloaded = IN(1) && IN(3);
    {
        unsigned t1 = 0u, t1b = 0u;
        const bool pend1 = IN(1) && IN(2);
        if (pend1) xcd_barrier_arrive(bar, t1, t1b);
        if (preloaded) { WS_LAUNDER(); p2c_images(lds, (const bf16_t*)(wsl + WS_QT), (const bf16_t*)(wsl + WS_KT), b >> 2, b & 3, tid); }
        if (pend1) { if (tid == 0) xcd_barrier_wait_t0(bar, t1, t1b); __syncthreads(); }
    }
    if (IN(2)) {
        WS_LAUNDER();
        p2b_scan((bf16_t*)(wsl + WS_ST), b, tid);
    }
    unsigned tok = 0u, tok2 = 0u;
    const bool pending = IN(2) && IN(3);
    if (pending) xcd_barrier_arrive(bar, tok, tok2);
    if (IN(3)) {
        WS_LAUNDER();
        p2c_item(lds, (const bf16_t*)(wsl + WS_QT), (const bf16_t*)(wsl + WS_KT), (const bf16_t*)(wsl + WS_V), (const bf16_t*)(wsl + WS_ST), (bf16_t*)(wsl + WS_GY), gn_g, b >> 2, b & 3, tid, wid, lane, bar, pending, tok, tok2, preloaded);
        if (tid == 0) __hip_atomic_fetch_add((unsigned*)(ws + WS_CTL) + CW_YR + 64 * (b >> 3), 1u, __ATOMIC_RELAXED, __HIP_MEMORY_SCOPE_AGENT);
    }
    if (IN(4)) {
        WS_LAUNDER();
        pg8::Gemm g{(const bf16_t*)(wsl + WS_GY), (const bf16_t*)(wsl + WS_WOUT), SEQ, DM, DM};
        const int xcd = b & 7, off = b >> 3, wg = xcd * 32 + off;
        SchedP3 S{(wg >> 6) * 8 + (wg & 7), (wg & 63) >> 3, (unsigned*)(ws + WS_CTL) + CW_YR, IN(3) ? 8u : 0u};
        Epi3 E{x, a.out, final_g, (float*)(wsl + WS_PSUM), (unsigned*)(ws + WS_CTL) + CW_PANEL};
        pg8::gemm_phase<Epi3, SchedP3, false, true>(lds, g, S, E);
    }
#undef WS_LAUNDER
#undef IN
#undef SEAM
}
}

#ifndef LADDER
#define LADDER 0
#endif
#ifndef PROBE_K
#define PROBE_K 0
#endif
#ifndef PROBE_TAIL
#define PROBE_TAIL 0
#endif
#if LADDER > 0
namespace nt {
using namespace mk;
__device__ __forceinline__ float bf2f(bf16_t v) { return __uint_as_float((unsigned)v << 16); }
__device__ __forceinline__ bf16_t f2bf(float f) { unsigned u = __float_as_uint(f); return (bf16_t)((u + 0x7fffu + ((u >> 16) & 1u)) >> 16); }
__device__ __forceinline__ float sigm(float x) { return 1.f / (1.f + expf(-x)); }
__global__ void __launch_bounds__(64) t_retention(const bf16_t* Qt, const bf16_t* Kt, const bf16_t* V, float* yraw) {
    const int w = blockIdx.x, h = w >> 8, dv = w & 255, lane = threadIdx.x;
    const float gamma = 1.0f - exp2f(-5.0f - (float)h), l2g = log2f(gamma);
    float S[4] = {0.f, 0.f, 0.f, 0.f};
    for (int pos = 0; pos < LTOK; ++pos) {
        const int r = pos < NMETA ? SEQ + pos : pos - NMETA, il = pos < NMETA ? 112 + pos : (r & 127);
        const float v = bf2f(V[(size_t)r * RW + h * RD + dv]);
        const float kd = exp2f(-(float)(127 - il) * l2g), qd = exp2f(-(float)(il + 1) * l2g);
        float part = 0.f;
#pragma unroll
        for (int i = 0; i < 4; ++i) {
            const int d = lane + 64 * i;
            const float k = bf2f(Kt[(size_t)r * RW + h * RD + d]) * kd;
            const float q = r < SEQ ? bf2f(Qt[(size_t)r * RW + h * RD + d]) * qd : 0.f;
            S[i] = gamma * S[i] + k * v;
            part += q * S[i];
        }
        part = wave_sum(part);
        if (lane == 0 && r < SEQ) yraw[(size_t)r * RW + h * RD + dv] = part;
    }
}
__global__ void __launch_bounds__(256) t_chunk(const bf16_t* Qt, const bf16_t* Kt, const bf16_t* V, const bf16_t* ST, float* yraw) {
    __shared__ float sc[128];
    __shared__ float qs[256];
    const int xc = blockIdx.x >> 2, h = blockIdx.x & 3, dv = threadIdx.x;
    const float gamma = 1.0f - exp2f(-5.0f - (float)h), ginv = exp2f(-128.0f * log2f(gamma));
    const bf16_t* Sx = ST + (size_t)(xc * 4 + h) * 65536;
    for (int i = 0; i < 128; ++i) {
        const size_t ri = (size_t)xc * 128 + i;
        __syncthreads();
        qs[dv] = bf2f(Qt[ri * RW + h * RD + dv]);
        __syncthreads();
        if (dv < 128) { float s = 0.f; if (dv <= i) { const size_t rj = (size_t)xc * 128 + dv; for (int d = 0; d < 256; ++d) s += qs[d] * bf2f(Kt[rj * RW + h * RD + d]); } sc[dv] = s * ginv; }
        __syncthreads();
        float y = 0.f;
        for (int j = 0; j <= i; ++j) y += sc[j] * bf2f(V[((size_t)xc * 128 + j) * RW + h * RD + dv]);
        for (int d = 0; d < 256; ++d) y += qs[d] * bf2f(Sx[(size_t)dv * 256 + d]);
        yraw[ri * RW + h * RD + dv] = y;
    }
}
__global__ void t_groupnorm(const float* yraw, bf16_t* GY, const float* gn_g) {
    const int w = (blockIdx.x * blockDim.x + threadIdx.x) >> 6, lane = threadIdx.x & 63;
    if (w >= SEQ * RH) return;
    const int r = w >> 2, h = w & 3;
    float v[4], s = 0.f;
#pragma unroll
    for (int i = 0; i < 4; ++i) { v[i] = yraw[(size_t)r * RW + h * RD + lane + 64 * i]; s += v[i]; }
    const float mu = wave_sum(s) / RD;
    float q = 0.f;
#pragma unroll
    for (int i = 0; i < 4; ++i) { v[i] -= mu; q += v[i] * v[i]; }
    const float rs = 1.0f / sqrtf(wave_sum(q) / RD + EPS);
#pragma unroll
    for (int i = 0; i < 4; ++i) { const int c = h * RD + lane + 64 * i; bf16_t* p = GY + (size_t)r * DM + c; *p = f2bf(v[i] * rs * gn_g[c] * bf2f(*p)); }
}
__global__ void __launch_bounds__(256) t_conv(const bf16_t* U, const float* dw_w, const float* dw_b, const float* ln_g, const float* ln_b, bf16_t* CB) {
    __shared__ float red[8];
    const int r = blockIdx.x, pos = r + NMETA, tid = threadIdx.x, lane = tid & 63, wv = tid >> 6;
    float c[4];
#pragma unroll
    for (int i = 0; i < 4; ++i) {
        const int ch = tid + 256 * i;
        float a = dw_b[ch];
        for (int j = 0; j < CK; ++j) { const int p = pos - (CK - 1) + j; if (p >= 0) { const int row = p >= NMETA ? p - NMETA : SEQ + p; a += bf2f(U[(size_t)row * CW + ch]) * dw_w[j * CW + ch]; } }
        c[i] = a;
    }
    float s = wave_sum(c[0] + c[1] + c[2] + c[3]);
    if (lane == 0) red[wv] = s;
    __syncthreads();
    const float mu = (red[0] + red[1] + red[2] + red[3]) / CW;
    float q = 0.f;
#pragma unroll
    for (int i = 0; i < 4; ++i) { c[i] -= mu; q += c[i] * c[i]; }
    q = wave_sum(q);
    if (lane == 0) red[4 + wv] = q;
    __syncthreads();
    const float rs = 1.0f / sqrtf((red[4] + red[5] + red[6] + red[7]) / CW + EPS);
#pragma unroll
    for (int i = 0; i < 4; ++i) { const int ch = tid + 256 * i; const float y = c[i] * rs * ln_g[ch] + ln_b[ch]; CB[(size_t)r * CW + ch] = f2bf(y * sigm(y)); }
}
template <int M, int N, int K, class AL, class EP>
__global__ void __launch_bounds__(256) t_gemm(const float* B, AL al, EP ep) {
    __shared__ float As[16][68];
    __shared__ float Bs[16][68];
    const int tx = threadIdx.x & 15, ty = threadIdx.x >> 4;
    const int m0 = blockIdx.y * 64, n0 = blockIdx.x * 64;
    float acc[4][4];
#pragma unroll
    for (int i = 0; i < 4; ++i)
#pragma unroll
        for (int j = 0; j < 4; ++j) acc[i][j] = 0.f;
    for (int k0 = 0; k0 < K; k0 += 16) {
#pragma unroll
        for (int i = 0; i < 4; ++i) { const int idx = threadIdx.x + i * 256, mm = idx >> 4, kk = idx & 15, m = m0 + mm; As[kk][mm] = (m < M) ? al(m, k0 + kk) : 0.f; }
#pragma unroll
        for (int i = 0; i < 4; ++i) { const int idx = threadIdx.x + i * 256, kk = idx >> 6, nn = idx & 63; Bs[kk][nn] = B[(size_t)(k0 + kk) * N + n0 + nn]; }
        __syncthreads();
#pragma unroll
        for (int kk = 0; kk < 16; ++kk) {
            float a[4], b[4];
#pragma unroll
            for (int i = 0; i < 4; ++i) { a[i] = As[kk][ty * 4 + i]; b[i] = Bs[kk][tx * 4 + i]; }
#pragma unroll
            for (int i = 0; i < 4; ++i)
#pragma unroll
                for (int j = 0; j < 4; ++j) acc[i][j] += a[i] * b[j];
        }
        __syncthreads();
    }
#pragma unroll
    for (int i = 0; i < 4; ++i)
#pragma unroll
        for (int j = 0; j < 4; ++j) { const int m = m0 + ty * 4 + i, n = n0 + tx * 4 + j; if (m < M) ep(m, n, acc[i][j]); }
}
struct AL_CB { const bf16_t* CB; __device__ float operator()(int m, int k) const { return bf2f(CB[(size_t)m * CW + k]); } };
struct EP_PW { bf16_t* GY; const float* pw_b; __device__ void operator()(int m, int n, float v) const { bf16_t* p = GY + (size_t)m * DM + 1024 + n; *p = f2bf((v + pw_b[n]) * bf2f(*p)); } };
struct AL_GY { const bf16_t* GY; __device__ float operator()(int m, int k) const { return bf2f(GY[(size_t)m * DM + k]); } };
struct EP_OUT { float* out; const float* x; __device__ void operator()(int m, int n, float v) const { out[(size_t)m * DM + n] = v + x[(size_t)m * DM + n]; } };
__global__ void t_final(float* out, const float* g) {
    const int w = (blockIdx.x * blockDim.x + threadIdx.x) >> 6, lane = threadIdx.x & 63;
    if (w >= SEQ) return;
    float* r = out + (size_t)w * DM;
    float s = 0.f;
    for (int i = lane; i < DM; i += 64) { const float v = r[i]; s += v * v; }
    const float rs = 1.0f / sqrtf(wave_sum(s) / DM + EPS);
    for (int i = lane; i < DM; i += 64) r[i] = r[i] * rs * g[i];
}
}
#endif

extern "C" void kernel_launch(void* const* d_in, const int* in_sizes, int n_in, void* d_out, int out_size, void* d_ws, size_t ws_size, hipStream_t stream) {
    using namespace mk;
    static int ready = 0;
    if (ready == 0) {
        if (n_in != 13 || out_size != SEQ * DM || ws_size < WS_END) { fprintf(stderr, "kernel_launch: unexpected shapes (n_in %d, out %d, ws %zu)\n", n_in, out_size, ws_size); ready = -1; return; }
        int dev = 0, cus = 0;
        if (hipGetDevice(&dev) != hipSuccess || hipDeviceGetAttribute(&cus, hipDeviceAttributeMultiprocessorCount, dev) != hipSuccess) { ready = -1; return; }
        if (cus < GRID) { fprintf(stderr, "kernel_launch: %d CUs < %d\n", cus, GRID); ready = -1; return; }
        if (hipFuncSetAttribute((const void*)mega, hipFuncAttributeMaxDynamicSharedMemorySize, LDS_BYTES) != hipSuccess) { fprintf(stderr, "kernel_launch: hipFuncSetAttribute failed\n"); ready = -1; return; }
        int per_cu = 0;
        if (hipOccupancyMaxActiveBlocksPerMultiprocessor(&per_cu, (const void*)mega, NTHREADS, LDS_BYTES) != hipSuccess || per_cu < 1) fprintf(stderr, "kernel_launch: occupancy query says %d blocks/CU\n", per_cu);
        (void)hipGetLastError();
        ready = 1;
    }
    if (ready < 0) return;
    (void)hipMemsetAsync((char*)d_ws + WS_CTL, 0, CTL_ZERO_BYTES, stream);
    Args a{};
    for (int i = 0; i < 13; ++i) a.in[i] = (const float*)d_in[i];
    a.out = (float*)d_out; a.ws = (unsigned char*)d_ws;
#if LADDER == 0
#if PROBE_K > 0
    a.ph_lo = 0; a.ph_hi = PROBE_K;
    hipLaunchKernelGGL(mega, dim3(GRID), dim3(NTHREADS), LDS_BYTES, stream, a);
    (void)hipMemsetAsync((char*)d_ws + WS_CTL, 0, CTL_ZERO_BYTES, stream);
#endif
    a.ph_lo = 0; a.ph_hi = 5;
    hipLaunchKernelGGL(mega, dim3(GRID), dim3(NTHREADS), LDS_BYTES, stream, a);
#if PROBE_TAIL > 0
    (void)hipMemsetAsync((char*)d_ws + WS_CTL, 0, CTL_ZERO_BYTES, stream);
    a.ph_lo = PROBE_TAIL; a.ph_hi = 5;
    hipLaunchKernelGGL(mega, dim3(GRID), dim3(NTHREADS), LDS_BYTES, stream, a);
#endif
#else
    using namespace nt;
    unsigned char* ws = (unsigned char*)d_ws;
    bf16_t *Qt = (bf16_t*)(ws + WS_QT), *Kt = (bf16_t*)(ws + WS_KT), *V = (bf16_t*)(ws + WS_V), *U = (bf16_t*)(ws + WS_U), *GY = (bf16_t*)(ws + WS_GY), *CB = (bf16_t*)(ws + WS_CB), *ST = (bf16_t*)(ws + WS_ST);
    const float *x = a.in[0], *gn_g = a.in[4], *dw_w = a.in[5], *dw_b = a.in[6], *cln_g = a.in[7], *cln_b = a.in[8], *pw_w = a.in[9], *pw_b = a.in[10], *w_out = a.in[11], *final_g = a.in[12];
    float* out = (float*)d_out; float* yraw = (float*)d_out;
    a.ph_lo = 0; a.ph_hi = (LADDER == 1 ? 2 : LADDER == 2 ? 3 : 4);
    hipLaunchKernelGGL(mega, dim3(GRID), dim3(NTHREADS), LDS_BYTES, stream, a);
#if LADDER == 1
    t_retention<<<RH * RD, 64, 0, stream>>>(Qt, Kt, V, yraw);
    t_groupnorm<<<(SEQ * RH * 64 + 255) / 256, 256, 0, stream>>>(yraw, GY, gn_g);
    t_conv<<<SEQ, 256, 0, stream>>>(U, dw_w, dw_b, cln_g, cln_b, CB);
    t_gemm<SEQ, CW, CW><<<dim3(CW / 64, SEQ / 64), 256, 0, stream>>>(pw_w, AL_CB{CB}, EP_PW{GY, pw_b});
#elif LADDER == 2
    t_chunk<<<64 * 4, 256, 0, stream>>>(Qt, Kt, V, ST, yraw);
    t_groupnorm<<<(SEQ * RH * 64 + 255) / 256, 256, 0, stream>>>(yraw, GY, gn_g);
#endif
    t_gemm<SEQ, DM, DM><<<dim3(DM / 64, SEQ / 64), 256, 0, stream>>>(w_out, AL_GY{GY}, EP_OUT{out, x});
    t_final<<<(SEQ * 64 + 255) / 256, 256, 0, stream>>>(out, final_g);
#endif
}
```

```cpp
#include <hip/hip_runtime.h>
#include <cstdio>
#include <cstdint>
namespace pg8 {
#define PG8_LAS __attribute__((address_space(3)))
typedef unsigned short bf16_t;
typedef short bf16x8 __attribute__((ext_vector_type(8)));
typedef float f32x4 __attribute__((ext_vector_type(4)));
typedef unsigned u32x4 __attribute__((ext_vector_type(4)));
constexpr int BM = 256, BK = 64, HALF = 128, HTB = HALF * BK * 2  , STAGE_BYTES = 8 * HTB, NXCD = 8, WGM = 8;

__host__ __device__ __forceinline__ int lds_byte(int r, int c) { const int st = (r >> 4) * 2 + (c >> 5), rr = r & 15, cc = c & 31, ob = rr * 64 + cc * 2; return st * 1024 + (ob ^ (((ob >> 9) & 1) << 5)); }
__host__ __device__ __forceinline__ void stage_rc(int b, int& R, int& C) { const int st = b / 1024, sb = b % 1024, swz = sb ^ (((sb >> 9) & 1) << 5); R = (st >> 1) * 16 + swz / 64; C = (st & 1) * 32 + (swz % 64) / 2; }
__host__ __device__ __forceinline__ int perm32(int rho) { const int n = rho >> 4, i = rho & 15; return 8 * (i >> 2) + 4 * n + (i & 3); }

struct Unit { int pm, pn; };
struct Gemm { const bf16_t* A; const bf16_t* Bt; int M, N, K; };

__device__ __forceinline__ unsigned cvt_pk_bf16(float lo, float hi) { unsigned r; asm volatile("v_cvt_pk_bf16_f32 %0, %1, %2" : "=v"(r) : "v"(lo), "v"(hi)); return r; }
typedef float f32x2 __attribute__((ext_vector_type(2)));
template <class Epi, class Sched, bool ALIGN_EPI = false, bool SP2 = false>
__device__ __forceinline__ void gemm_phase(PG8_LAS unsigned char* lds, const Gemm g, const Sched& S, const Epi& E) {
    int tid = threadIdx.x; asm volatile("" : "+v"(tid));
    const int wid = __builtin_amdgcn_readfirstlane(tid >> 6), lane = tid & 63, wr = wid >> 2, wc = wid & 3, fr = lane & 15, fq = lane >> 4;
    const int K = g.K, nt = K / BK;
    unsigned voffA[2], voffB[2];
#pragma unroll
    for (int i = 0; i < 2; ++i) { int R, C; stage_rc(tid * 16 + i * 8192, R, C); const int Rb = Epi::PERM ? ((R & ~31) + perm32(R & 31)) : R;
        voffA[i] = (unsigned)(R * K + C) * 2u; voffB[i] = (unsigned)(Rb * K + C) * 2u; }
    const size_t kstep = (size_t)(BK * 2);
    const size_t hstep = (size_t)HALF * K * 2;
    const size_t tstep = 2 * hstep;
    const unsigned ldsw = (unsigned)wid * 1024u;
    const int aoff = lds_byte(wr * 64 + fr, fq * 8), boff = lds_byte(wc * 32 + fr, fq * 8);
#define PG8_SA(b, h) (((b) * 2 + (h)) * HTB)
#define PG8_SB(b, h) ((4 + (b) * 2 + (h)) * HTB)
#define PG8_STAGE(bufoff, gbase, voff) do { _Pragma("unroll") for (int _i = 0; _i < 2; ++_i) \
        __builtin_amdgcn_global_load_lds((const unsigned*)((const char*)(gbase) + (voff)[_i]), (PG8_LAS unsigned*)(lds + (bufoff) + ldsw + _i * 8192), 16, 0, 0); } while (0)
#define PG8_LDA(dst, b, h) do { _Pragma("unroll") for (int m = 0; m < 4; ++m) _Pragma("unroll") for (int k = 0; k < 2; ++k) dst[m][k] = *(const PG8_LAS bf16x8*)(lds + PG8_SA(b, h) + aoff + m * 2048 + k * 1024); } while (0)
#define PG8_LDB(dst, b, h) do { _Pragma("unroll") for (int n = 0; n < 2; ++n) _Pragma("unroll") for (int k = 0; k < 2; ++k) dst[n][k] = *(const PG8_LAS bf16x8*)(lds + PG8_SB(b, h) + boff + n * 2048 + k * 1024); } while (0)
#define PG8_MMA(ai, bj, At, Bt) do { __builtin_amdgcn_s_setprio(1); _Pragma("unroll") for (int m = 0; m < 4; ++m) _Pragma("unroll") for (int n = 0; n < 2; ++n) _Pragma("unroll") for (int k = 0; k < 2; ++k) \
        acc[ai][bj][m][n] = __builtin_amdgcn_mfma_f32_16x16x32_bf16(Bt[n][k], At[m][k], acc[ai][bj][m][n], 0, 0, 0); __builtin_amdgcn_s_setprio(0); } while (0)
#define PG8_WAIT_V(n) asm volatile("s_waitcnt vmcnt(" #n ")" ::: "memory")
#define PG8_WAIT_L(n) asm volatile("s_waitcnt lgkmcnt(" #n ")" ::: "memory")
#define PG8_BAR __builtin_amdgcn_s_barrier()
#define PG8_SCHED __builtin_amdgcn_sched_barrier(0)
    Unit cur, nxt; int ui = 0;
    if (!S.next(0, cur)) return;
    f32x4 acc[2][2][4][2];
    if constexpr (Epi::INIT) E.init(acc, cur, wr, wc, fr, fq);
    else {
#pragma unroll
    for (int a = 0; a < 2; ++a)
#pragma unroll
        for (int b = 0; b < 2; ++b)
#pragma unroll
            for (int m = 0; m < 4; ++m)
#pragma unroll
                for (int n = 0; n < 2; ++n) acc[a][b][m][n] = (f32x4){0.f, 0.f, 0.f, 0.f};
    }
    bf16x8 At[4][2], B0[2][2], B1[2][2];
    const char* cA = (const char*)g.A + (size_t)cur.pm * tstep; const char* cB = (const char*)g.Bt + (size_t)cur.pn * tstep;
    S.a_ready(cur);
    if constexpr (SP2) {
        PG8_STAGE(PG8_SB(0, 0), cB, voffB); PG8_STAGE(PG8_SB(0, 1), cB + hstep, voffB); PG8_STAGE(PG8_SA(0, 0), cA, voffA); PG8_STAGE(PG8_SA(0, 1), cA + hstep, voffA);
        if (wr == 1) PG8_BAR;
        PG8_WAIT_V(2); PG8_BAR;
        PG8_STAGE(PG8_SB(1, 0), cB + kstep, voffB); PG8_STAGE(PG8_SA(1, 0), cA + kstep, voffA); PG8_STAGE(PG8_SB(1, 1), cB + hstep + kstep, voffB);
        PG8_WAIT_V(6); PG8_BAR;
    } else {
        PG8_STAGE(PG8_SB(0, 0), cB, voffB); PG8_STAGE(PG8_SA(0, 0), cA, voffA); PG8_STAGE(PG8_SB(0, 1), cB + hstep, voffB); PG8_STAGE(PG8_SA(0, 1), cA + hstep, voffA);
        if (wr == 1) PG8_BAR;
        PG8_WAIT_V(4); PG8_BAR;
        PG8_STAGE(PG8_SB(1, 0), cB + kstep, voffB); PG8_STAGE(PG8_SA(1, 0), cA + kstep, voffA); PG8_STAGE(PG8_SB(1, 1), cB + hstep + kstep, voffB);
        PG8_WAIT_V(6); PG8_BAR;
    }
    for (;;) {
        const bool has_next = S.next(ui + 1, nxt);
        const char* nA = has_next ? (const char*)g.A + (size_t)nxt.pm * tstep : cA; const char* nB = has_next ? (const char*)g.Bt + (size_t)nxt.pn * tstep : cB;
        for (int t = 0; t < nt; t += 2) {
            const bool last = (t == nt - 2);
            const char* a1 = cA + (size_t)(t + 1) * kstep;
            const char* a2 = last ? nA : cA + (size_t)(t + 2) * kstep; const char* b2 = last ? nB : cB + (size_t)(t + 2) * kstep;
            const char* a3 = a2 + kstep; const char* b3 = b2 + kstep;
            if (last && has_next) S.a_ready(nxt);
            if constexpr (SP2) {
            PG8_LDB(B0, 0, 0); PG8_LDB(B1, 0, 1); PG8_SCHED; PG8_LDA(At, 0, 0); PG8_STAGE(PG8_SA(1, 1), a1 + hstep, voffA);
            PG8_WAIT_V(8); PG8_WAIT_L(0); PG8_BAR; PG8_MMA(0, 0, At, B0); PG8_MMA(0, 1, At, B1); PG8_BAR; PG8_SCHED;
            PG8_LDA(At, 0, 1); PG8_STAGE(PG8_SB(0, 0), b2, voffB); PG8_STAGE(PG8_SB(0, 1), b2 + hstep, voffB); PG8_STAGE(PG8_SA(0, 0), a2, voffA);
            PG8_WAIT_V(8); PG8_WAIT_L(0); PG8_BAR; PG8_MMA(1, 0, At, B0); PG8_MMA(1, 1, At, B1); PG8_BAR; PG8_SCHED;
            PG8_LDB(B0, 1, 0); PG8_LDB(B1, 1, 1); PG8_SCHED; PG8_LDA(At, 1, 0); PG8_STAGE(PG8_SA(0, 1), a2 + hstep, voffA);
            PG8_WAIT_V(8); PG8_WAIT_L(0); PG8_BAR; PG8_MMA(0, 0, At, B0); PG8_MMA(0, 1, At, B1); PG8_BAR; PG8_SCHED;
            PG8_LDA(At, 1, 1); PG8_STAGE(PG8_SB(1, 0), b3, voffB); PG8_STAGE(PG8_SB(1, 1), b3 + hstep, voffB); PG8_STAGE(PG8_SA(1, 0), a3, voffA);
            PG8_WAIT_V(8); PG8_WAIT_L(0); PG8_BAR; PG8_MMA(1, 0, At, B0); PG8_MMA(1, 1, At, B1); PG8_BAR; PG8_SCHED;
            } else {
            PG8_LDB(B0, 0, 0); PG8_SCHED; PG8_LDA(At, 0, 0); PG8_STAGE(PG8_SA(1, 1), a1 + hstep, voffA);
            PG8_WAIT_L(8); PG8_BAR; PG8_WAIT_L(0); PG8_MMA(0, 0, At, B0); PG8_BAR; PG8_SCHED;
            PG8_LDB(B1, 0, 1); PG8_STAGE(PG8_SB(0, 0), b2, voffB);
            PG8_BAR; PG8_WAIT_L(0); PG8_MMA(0, 1, At, B1); PG8_BAR;
            PG8_LDA(At, 0, 1); PG8_STAGE(PG8_SA(0, 0), a2, voffA);
            PG8_BAR; PG8_WAIT_L(0); PG8_MMA(1, 0, At, B0); PG8_BAR; PG8_SCHED;
            PG8_STAGE(PG8_SB(0, 1), b2 + hstep, voffB);
            PG8_WAIT_V(6); PG8_BAR; PG8_MMA(1, 1, At, B1); PG8_BAR;
            PG8_LDB(B0, 1, 0); PG8_SCHED; PG8_LDA(At, 1, 0); PG8_STAGE(PG8_SA(0, 1), a2 + hstep, voffA);
            PG8_WAIT_L(8); PG8_BAR; PG8_WAIT_L(0); PG8_MMA(0, 0, At, B0); PG8_BAR; PG8_SCHED;
            PG8_LDB(B1, 1, 1); PG8_STAGE(PG8_SB(1, 0), b3, voffB);
            PG8_BAR; PG8_WAIT_L(0); PG8_MMA(0, 1, At, B1); PG8_BAR;
            PG8_LDA(At, 1, 1); PG8_STAGE(PG8_SA(1, 0), a3, voffA);
            PG8_BAR; PG8_WAIT_L(0); PG8_MMA(1, 0, At, B0); PG8_BAR; PG8_SCHED;
            PG8_STAGE(PG8_SB(1, 1), b3 + hstep, voffB);
            PG8_WAIT_V(6); PG8_BAR; PG8_MMA(1, 1, At, B1); PG8_BAR;
            }
        }
        if constexpr (ALIGN_EPI) { if (wr == 0) PG8_BAR; }
        if constexpr (!Epi::AFTER_DRAIN) { E(acc, cur, wr, wc, fr, fq); S.done(cur); }
        if (!has_next) break;
#pragma unroll
        for (int a = 0; a < 2; ++a)
#pragma unroll
            for (int b = 0; b < 2; ++b)
#pragma unroll
                for (int m = 0; m < 4; ++m)
#pragma unroll
                    for (int n = 0; n < 2; ++n) acc[a][b][m][n] = (f32x4){0.f, 0.f, 0.f, 0.f};
        cur = nxt; cA = nA; cB = nB; ++ui;
        if constexpr (ALIGN_EPI) { if (wr == 1) PG8_BAR; }
    }
    PG8_WAIT_V(0);
    if constexpr (!ALIGN_EPI) { if (wr == 0) PG8_BAR; }
    PG8_BAR;
    if constexpr (Epi::AFTER_DRAIN) { E.fused(acc, cur, wr, wc, fr, fq, lds, wid, lane); S.done(cur); }
#undef PG8_SA
#undef PG8_SB
#undef PG8_STAGE
#undef PG8_LDA
#undef PG8_LDB
#undef PG8_MMA
#undef PG8_WAIT_V
#undef PG8_WAIT_L
#undef PG8_BAR
#undef PG8_SCHED
}
}

namespace mk {
using pg8::bf16_t; using pg8::bf16x8; using pg8::f32x4; using pg8::u32x4; using pg8::Unit;
#define LAS __attribute__((address_space(3)))
typedef float f32x16 __attribute__((ext_vector_type(16)));
typedef float f32x2 __attribute__((ext_vector_type(2)));
typedef float f32x2_ __attribute__((ext_vector_type(2)));
typedef short s16x4 __attribute__((ext_vector_type(4)));
typedef unsigned u32x2 __attribute__((ext_vector_type(2)));
typedef __bf16 bf16x2_t __attribute__((ext_vector_type(2)));
__device__ __forceinline__ unsigned cvt_pk_bf16(float lo, float hi) { const f32x2_ v = {lo, hi}; return __builtin_bit_cast(unsigned, __builtin_convertvector(v, bf16x2_t)); }

constexpr int DM = 2048, SEQ = 8192, NMETA = 16, LTOK = SEQ + NMETA, MPAD = 8448;
constexpr int RW = 1024, RH = 4, RD = 256, CW = 1024, CK = 31, INW = 7168;
constexpr float EPS = 1e-6f;
constexpr int NTHREADS = 512, GRID = 256;
constexpr size_t MiB = 1u << 20;
constexpr size_t WS_CTL = 0, CTL_ZERO_BYTES = 1 * MiB;
constexpr size_t WS_RSTD = 1 * MiB;
constexpr size_t WS_PSUM = 1 * MiB + 64 * 1024;
constexpr size_t WS_WOUT = 2 * MiB;
constexpr size_t WS_WPW = 10 * MiB;
constexpr size_t WS_WIN = 12 * MiB;
constexpr size_t WS_HB = 40 * MiB;
constexpr size_t WS_COS = 73 * MiB;
constexpr size_t WS_SIN = 77 * MiB + 256 * 1024;
constexpr size_t WS_QT = 82 * MiB;
constexpr size_t WS_KT = 98 * MiB;
constexpr size_t WS_V = 115 * MiB;
constexpr size_t WS_U = 132 * MiB;
constexpr size_t WS_GY = 149 * MiB;
constexpr size_t WS_CB = 181 * MiB;
constexpr size_t WS_ST = 197 * MiB;
constexpr size_t WS_END = 229 * MiB;
static_assert(WS_COS + (size_t)LTOK * 128 * 4 <= WS_SIN && WS_SIN + (size_t)LTOK * 128 * 4 <= WS_QT && WS_HB + (size_t)MPAD * DM * 2 <= WS_COS, "ws map");
__device__ __forceinline__ bf16_t* kvt_tile(unsigned char* ws, int t) { return (bf16_t*)(ws + WS_ST + (size_t)t * 131072); }
constexpr int CW_BAR = 4096;
constexpr int CW_YR = 14656;
constexpr int CW_PANEL = 12544;
constexpr int CW_CONV = 8448, CW_GC = 10496;
constexpr int CW_MID = 8192, CW_META = 8256, CW_Q = 8320;
constexpr int LDS_MAIN = 147456, MISC_OFF = LDS_MAIN, LDS_BYTES = LDS_MAIN + 1024;

__device__ __constant__ const float kLog2G[4] = {-0.045803689613124755f, -0.022720076500083796f, -0.011315313227834148f, -0.005646563141142062f};

#define LDS_WAIT() asm volatile("s_waitcnt lgkmcnt(0)" ::: "memory")
#define MFMA32(a, b, c) __builtin_amdgcn_mfma_f32_32x32x16_bf16((a), (b), (c), 0, 0, 0)
template <int CTRL> __device__ __forceinline__ float dpp_mov(float x) { return __builtin_bit_cast(float, __builtin_amdgcn_update_dpp(0, __builtin_bit_cast(int, x), CTRL, 0xF, 0xF, true)); }
__device__ __forceinline__ float sum16(float x) { x += dpp_mov<0xB1>(x); x += dpp_mov<0x4E>(x); x += dpp_mov<0x141>(x); x += dpp_mov<0x140>(x); return x; }
__device__ __forceinline__ float sum32(float x) { x = sum16(x); x += __builtin_bit_cast(float, __builtin_amdgcn_ds_swizzle(__builtin_bit_cast(int, x), 0x401F)); return x; }
__device__ __forceinline__ float wave_sum(float v) { v = sum32(v); return v + __shfl_xor(v, 32); }
__device__ __forceinline__ float sigmoid_f(float x) { return __builtin_amdgcn_rcpf(1.0f + __expf(-x)); }
__device__ __forceinline__ float silu_f(float x) { return x * sigmoid_f(x); }
__device__ __forceinline__ float bf_lo(unsigned w) { return __uint_as_float(w << 16); }
__device__ __forceinline__ float bf_hi(unsigned w) { return __uint_as_float(w & 0xffff0000u); }
__device__ __forceinline__ u32x4 pack8(const f32x4 a, const f32x4 b) { u32x4 w; w.x = cvt_pk_bf16(a[0], a[1]); w.y = cvt_pk_bf16(a[2], a[3]); w.z = cvt_pk_bf16(b[0], b[1]); w.w = cvt_pk_bf16(b[2], b[3]); return w; }
__device__ __forceinline__ void st8_sc1(void* p, u32x2 v) { asm volatile("global_store_dwordx2 %0, %1, off sc1\n\ts_nop 1" :: "v"(p), "v"(v) : "memory"); }
__device__ __forceinline__ void st16_sc1(void* p, u32x4 v) { asm volatile("global_store_dwordx4 %0, %1, off sc1\n\ts_nop 1" :: "v"(p), "v"(v) : "memory"); }
__device__ __forceinline__ int crow(int reg, int hh) { return (reg & 3) + 8 * (reg >> 2) + 4 * hh; }
__device__ __forceinline__ s16x4 tr_read(LAS unsigned char* p) { return __builtin_amdgcn_ds_read_tr16_b64_v4i16((LAS s16x4*)p); }

#define XB_TMO      128
#define XB_XCNT(j)  (256  + 64 * (j))
#define XB_XSUB(j)  (1280 + 64 * (j))
#define XB_XGEN(j)  (2304 + 64 * (j))
#define XB_TOP      3328
#define XB_TOPGEN   3392
#define XCD_BAR_WORDS 3456
#define XB_SPIN_CAP (1u << 18)
__device__ __forceinline__ unsigned xb_ld(unsigned* p)              { return __hip_atomic_load(p, __ATOMIC_RELAXED, __HIP_MEMORY_SCOPE_AGENT); }
__device__ __forceinline__ unsigned xb_add(unsigned* p, unsigned v) { return __hip_atomic_fetch_add(p, v, __ATOMIC_RELAXED, __HIP_MEMORY_SCOPE_AGENT); }
__device__ __forceinline__ unsigned xb_xcc_id() { return (unsigned)__builtin_amdgcn_s_getreg((3 << 11) | 20) & 0xFu; }
#define XB_SPIN(cond, bar) do { unsigned _sp = 0; while (cond) { __builtin_amdgcn_s_sleep(1); \
    if ((++_sp & 255u) == 0u) { if (xb_ld(&(bar)[XB_TMO])) break; if (_sp > XB_SPIN_CAP) { atomicAdd(&(bar)[XB_TMO], 1u); break; } } } } while (0)
struct XcdBarrier { unsigned* bar; unsigned x; volatile LAS unsigned* st; };
__device__ __forceinline__ XcdBarrier xcd_barrier_post(unsigned* bar, volatile LAS unsigned* st) {
    XcdBarrier b; b.bar = bar; b.x = xb_xcc_id(); b.st = st;
    if (threadIdx.x == 0) (void)xb_add(&bar[XB_XCNT(b.x)], 1u);
    return b;
}
__device__ __forceinline__ void xcd_barrier_complete(unsigned* bar, unsigned x, unsigned& nloc, unsigned& nx) {
    const unsigned G = gridDim.x * gridDim.y * gridDim.z;
    unsigned sum, cnt, mine, sp = 0u;
    for (;;) {
        sum = 0u; cnt = 0u; mine = 0u;
#pragma unroll
        for (unsigned j = 0; j < 16; ++j) { const unsigned c = xb_ld(&bar[XB_XCNT(j)]); sum += c; cnt += (c > 0u) ? 1u : 0u; mine = (j == x) ? c : mine; }
        if (sum == G) break;
        __builtin_amdgcn_s_sleep(1);
        if ((++sp & 255u) == 0u) { if (xb_ld(&bar[XB_TMO])) break; if (sp > XB_SPIN_CAP) { atomicAdd(&bar[XB_TMO], 1u); break; } }
    }
    nloc = mine > 0u ? mine : 1u; nx = cnt > 0u ? cnt : 1u;
}
__device__ __forceinline__ void xcd_barrier(const XcdBarrier& b) {
    asm volatile("s_waitcnt vmcnt(0)" ::: "memory");
    __syncthreads();
    if (threadIdx.x == 0) {
        unsigned* bar = b.bar;
        __builtin_amdgcn_s_waitcnt(0);
        unsigned nloc = b.st[0], nx = b.st[1];
        if (nloc == 0u) { xcd_barrier_complete(bar, b.x, nloc, nx); b.st[0] = nloc; b.st[1] = nx; }
        const unsigned old = xb_add(&bar[XB_XSUB(b.x)], 1u);
        const unsigned gen = old / nloc;
        if (old + 1u == (gen + 1u) * nloc) {
            __builtin_amdgcn_fence(__ATOMIC_RELEASE, "agent");
            asm volatile("s_waitcnt vmcnt(0)" ::: "memory");
            const unsigned og = xb_add(&bar[XB_TOP], 1u);
            const unsigned tg = og / nx;
            if (og + 1u == (tg + 1u) * nx) xb_add(&bar[XB_TOPGEN], 1u);
            else XB_SPIN(xb_ld(&bar[XB_TOPGEN]) == tg, bar);
            __builtin_amdgcn_fence(__ATOMIC_ACQUIRE, "agent");
            xb_add(&bar[XB_XGEN(b.x)], 1u);
            asm volatile("s_waitcnt vmcnt(0)" ::: "memory");
        } else {
            XB_SPIN(xb_ld(&bar[XB_XGEN(b.x)]) == gen, bar);
            __builtin_amdgcn_fence(__ATOMIC_ACQUIRE, "agent");
            asm volatile("s_waitcnt vmcnt(0)" ::: "memory");
        }
    }
    __syncthreads();
}

__device__ __forceinline__ void xcd_barrier_arrive(const XcdBarrier& b, unsigned& tok, unsigned& tok2) {
    asm volatile("s_waitcnt vmcnt(0)" ::: "memory");
    __syncthreads();
    tok = 0u; tok2 = 0u;
    if (threadIdx.x == 0) {
        unsigned* bar = b.bar;
        __builtin_amdgcn_s_waitcnt(0);
        unsigned nloc = b.st[0], nx = b.st[1];
        if (nloc == 0u) { xcd_barrier_complete(bar, b.x, nloc, nx); b.st[0] = nloc; b.st[1] = nx; }
        const unsigned old = xb_add(&bar[XB_XSUB(b.x)], 1u);
        const unsigned gen = old / nloc;
        tok = gen & 0x3FFFFFFFu;
        if (old + 1u == (gen + 1u) * nloc) {
            __builtin_amdgcn_fence(__ATOMIC_RELEASE, "agent");
            asm volatile("s_waitcnt vmcnt(0)" ::: "memory");
            const unsigned og = xb_add(&bar[XB_TOP], 1u);
            const unsigned tg = og / nx;
            tok |= 1u << 30; tok2 = tg;
            if (og + 1u == (tg + 1u) * nx) { xb_add(&bar[XB_TOPGEN], 1u); tok |= 1u << 31; }
        }
    }
}
__device__ __forceinline__ void xcd_barrier_wait_t0(const XcdBarrier& b, unsigned tok, unsigned tok2) {
    unsigned* bar = b.bar;
    const unsigned gen = tok & 0x3FFFFFFFu;
    if (tok & (1u << 30)) {
        if (!(tok & (1u << 31))) XB_SPIN(xb_ld(&bar[XB_TOPGEN]) == tok2, bar);
        __builtin_amdgcn_fence(__ATOMIC_ACQUIRE, "agent");
        xb_add(&bar[XB_XGEN(b.x)], 1u);
        asm volatile("s_waitcnt vmcnt(0)" ::: "memory");
    } else {
        XB_SPIN(xb_ld(&bar[XB_XGEN(b.x)]) == gen, bar);
        __builtin_amdgcn_fence(__ATOMIC_ACQUIRE, "agent");
        asm volatile("s_waitcnt vmcnt(0)" ::: "memory");
    }
}

__host__ __device__ __forceinline__ int win_src_col(int nd) {
    if (nd < 4096 || nd >= 6144) return nd;
    const int t = (nd - 4096) >> 8, jj = (nd - 4096) & 255;
    return jj < 128 ? 4096 + 128 * t + jj : 5120 + 128 * t + (jj - 128);
}
__device__ __forceinline__ void p0_transpose_item(const float* __restrict__ W, int K, int N, bf16_t* __restrict__ WT, LAS float* scr, int kb, int n_src0, int n_dst0, int lane) {
    const int k0 = 64 * kb;
    float w[32];
#pragma unroll
    for (int i = 0; i < 32; ++i) w[i] = __builtin_nontemporal_load(W + (size_t)(k0 + 2 * i + (lane >> 5)) * N + n_src0 + (lane & 31));
#pragma unroll
    for (int i = 0; i < 32; ++i) scr[(2 * i + (lane >> 5)) * 33 + (lane & 31)] = w[i];
    LDS_WAIT(); asm volatile("" ::: "memory");
    const int c = lane & 7;
#pragma unroll
    for (int j = 0; j < 4; ++j) { const int n = (lane >> 3) + 8 * j; const LAS float* s = scr + (8 * c) * 33 + n;
        u32x4 o; o.x = cvt_pk_bf16(s[0 * 33], s[1 * 33]); o.y = cvt_pk_bf16(s[2 * 33], s[3 * 33]); o.z = cvt_pk_bf16(s[4 * 33], s[5 * 33]); o.w = cvt_pk_bf16(s[6 * 33], s[7 * 33]);
        st16_sc1(WT + (size_t)(n_dst0 + n) * K + k0 + 8 * c, o); }
    LDS_WAIT(); asm volatile("" ::: "memory");
}
__device__ __forceinline__ void p0_row(const float* __restrict__ src, bf16_t* __restrict__ dst, float* rstd_out, const f32x4 (&g)[8], int lane) {
    f32x4 v[8]; float s = 0.f;
#pragma unroll
    for (int j = 0; j < 8; ++j) v[j] = src ? __builtin_nontemporal_load((const f32x4*)src + lane + 64 * j) : (f32x4){0.f, 0.f, 0.f, 0.f};
#pragma unroll
    for (int j = 0; j < 8; ++j) s += (v[j][0] * v[j][0] + v[j][1] * v[j][1]) + (v[j][2] * v[j][2] + v[j][3] * v[j][3]);
    s = wave_sum(s);
    const float rs = src ? 1.0f / sqrtf(s * (1.0f / DM) + EPS) : 0.f;
    if (lane == 0) *rstd_out = rs;
#pragma unroll
    for (int j = 0; j < 8; ++j) { const f32x4 y = v[j] * g[j] * rs; u32x2 o; o.x = cvt_pk_bf16(y[0], y[1]); o.y = cvt_pk_bf16(y[2], y[3]); st8_sc1((u32x2*)dst + lane + 64 * j, o); }
}
__device__ __forceinline__ void p0_prologue(LAS unsigned char* lds, const float* x, const float* meta, const float* ln_g, const float* w_in, const float* pw_w, const float* w_out,
                                            unsigned char* ws, int b, int tid, int wid, int lane) {
    LAS float* scr = (LAS float*)(lds + wid * 16384);
    const int gw = b * 8 + wid, NGW = GRID * 8;
    bf16_t* Win = (bf16_t*)(ws + WS_WIN); bf16_t* Wout = (bf16_t*)(ws + WS_WOUT); bf16_t* Wpw = (bf16_t*)(ws + WS_WPW);
    constexpr int I_IN = 32 * 224, I_OUT = 32 * 64, I_PW = 16 * 32;
    for (int it = gw; it < I_IN + I_OUT + I_PW; it += NGW) {
        int r = it;
        if (r < I_IN) { const int kb = r / 224, nb = r % 224; p0_transpose_item(w_in, DM, INW, Win, scr, kb, win_src_col(32 * nb), 32 * nb, lane); continue; } r -= I_IN;
        if (r < I_OUT) { const int kb = r / 64, nb = r % 64; p0_transpose_item(w_out, DM, DM, Wout, scr, kb, 32 * nb, 32 * nb, lane); continue; } r -= I_OUT;
        { const int kb = r / 32, nb = r % 32; p0_transpose_item(pw_w, CW, CW, Wpw, scr, kb, 32 * nb, 32 * nb, lane); }
    }
    bf16_t* HB = (bf16_t*)(ws + WS_HB); float* rstd = (float*)(ws + WS_RSTD);
    f32x4 gl[8];
#pragma unroll
    for (int j = 0; j < 8; ++j) gl[j] = ((const f32x4*)ln_g)[lane + 64 * j];
    for (int r = gw; r < MPAD; r += NGW) {
        const float* src = r < SEQ ? x + (size_t)r * DM : (r < LTOK ? meta + (size_t)(r - SEQ) * DM : nullptr);
        p0_row(src, HB + (size_t)r * DM, rstd + r, gl, lane);
    }
    float* cosT = (float*)(ws + WS_COS); float* sinT = (float*)(ws + WS_SIN);
    const int gid = b * NTHREADS + tid, i = gid & 127;
    const double inv = exp2(-(double)i * 0.10381025296523007);
    for (int pos = gid >> 7; pos < LTOK; pos += (GRID * NTHREADS) >> 7) {
        const double a = (double)pos * inv;
        const double n = rint(a * 0.15915494309189535);
        const float rr = (float)fma(-n, 6.283185307179586, a);
        float sn, cs; sincosf(rr, &sn, &cs);
        cosT[(size_t)pos * 128 + i] = cs; sinT[(size_t)pos * 128 + i] = sn;
    }
}

__device__ __forceinline__ void wait_count(unsigned* p, unsigned want) {
    unsigned sp = 0;
    while (__hip_atomic_load(p, __ATOMIC_RELAXED, __HIP_MEMORY_SCOPE_AGENT) < want) { __builtin_amdgcn_s_sleep(2); if (++sp > (1u << 20)) break; }
}
struct Sched1 { int c; unsigned* ctl;
    __device__ __forceinline__ bool next(int i, Unit& u) const {
        const bool mb = (c >= 145) && (c <= 175) && (c & 1);
        if (mb && i == 2) { const int t = (c - 145) >> 1; u.pm = 32; u.pn = t < 8 ? 4 + t : 8 + t; return true; }
        const int L = (mb && i == 3 ? 2 : i) * GRID + c;
        if (i < 4 && L < 896) { const int xcd = L & 7, off = L >> 3, wg = xcd * 112 + off, gid = wg / 224, rem = wg % 224; u.pm = gid * 8 + (rem & 7); u.pn = rem >> 3; return true; }
        return false;
    }
    __device__ __forceinline__ void a_ready(const Unit&) const {}
    __device__ __forceinline__ void done(const Unit& u) const {
        Unit t3; (void)next(2, t3);
        const bool third = (u.pm == t3.pm && u.pn == t3.pn), meta = (u.pm == 32), gc = (u.pn >= 24);
        if (third || meta || gc) {
            asm volatile("s_waitcnt vmcnt(0)" ::: "memory");
            __syncthreads();
            if (threadIdx.x == 0) {
                if (meta) __hip_atomic_fetch_add(ctl + CW_META, 1u, __ATOMIC_RELAXED, __HIP_MEMORY_SCOPE_AGENT);
                if (third) __hip_atomic_fetch_add(ctl + CW_MID, 1u, __ATOMIC_RELAXED, __HIP_MEMORY_SCOPE_AGENT);
                if (gc) __hip_atomic_fetch_add(ctl + CW_GC + 64 * u.pm, 1u, __ATOMIC_RELAXED, __HIP_MEMORY_SCOPE_AGENT);
            }
        }
    }
};
struct Epi1 {
    static constexpr bool PERM = true, AFTER_DRAIN = false, INIT = false;
    bf16_t *Qt, *Kt, *V, *U, *GY; const float *rstd, *cosT, *sinT;
    __device__ __forceinline__ void operator()(const f32x4 (&acc)[2][2][4][2], const Unit& u, int wr, int wc, int fr, int fq) const {
        const int pn = u.pn; const bool meta = (u.pm == 32);
        if (meta && wr != 0) return;
        const int cl = wc * 32 + 8 * fq;
#pragma unroll
        for (int ai = 0; ai < 2; ++ai)
#pragma unroll
            for (int m = 0; m < 4; ++m) {
                if (meta && (ai | m)) continue;
                const int r = u.pm * 256 + ai * 128 + wr * 64 + m * 16 + fr;
                if (pn < 8) {
                    const int head = pn & 3; const bool isk = pn >= 4;
                    const int pos = meta ? (r - SEQ) : (r + NMETA);
                    const int il = meta ? (112 + r - SEQ) : (r & 127);
                    const float l2g = kLog2G[head];
                    const float dec = isk ? 0.0625f * exp2f((float)(127 - il) * l2g) : exp2f((float)(il + 1) * l2g);
                    const f32x4* cp = (const f32x4*)(cosT + (size_t)pos * 128 + cl); const f32x4* sp = (const f32x4*)(sinT + (size_t)pos * 128 + cl);
                    f32x4 o1[2], o2[2];
#pragma unroll
                    for (int n = 0; n < 2; ++n) { const f32x4 c = cp[n], s = sp[n], x1 = acc[ai][0][m][n], x2 = acc[ai][1][m][n];
                        o1[n] = (x1 * c - x2 * s) * dec; o2[n] = (x1 * s + x2 * c) * dec; }
                    bf16_t* dst = (isk ? Kt : Qt) + (size_t)r * RW + head * 256 + cl;
                    if (isk) { st16_sc1(dst, pack8(o1[0], o1[1])); st16_sc1(dst + 128, pack8(o2[0], o2[1])); }
                    else { *(u32x4*)dst = pack8(o1[0], o1[1]); *(u32x4*)(dst + 128) = pack8(o2[0], o2[1]); }
                } else if (pn < 12) {
                    bf16_t* dst = V + (size_t)r * RW + (pn - 8) * 256 + cl;
#pragma unroll
                    for (int bj = 0; bj < 2; ++bj) st16_sc1(dst + 128 * bj, pack8(acc[ai][bj][m][0], acc[ai][bj][m][1]));
                } else if (pn < 16 || pn >= 24) {
                    bf16_t* dst = GY + (size_t)r * DM + (pn < 16 ? (pn - 12) * 256 : 1024 + (pn - 24) * 256) + cl;
#pragma unroll
                    for (int bj = 0; bj < 2; ++bj) { f32x4 g0 = acc[ai][bj][m][0], g1 = acc[ai][bj][m][1];
#pragma unroll
                        for (int e = 0; e < 4; ++e) { g0[e] = silu_f(g0[e]); g1[e] = silu_f(g1[e]); }
                        if (pn >= 24) st16_sc1(dst + 128 * bj, pack8(g0, g1)); else *(u32x4*)(dst + 128 * bj) = pack8(g0, g1); }
                } else {
                    f32x4 u0 = acc[ai][0][m][0], u1 = acc[ai][0][m][1]; const f32x4 b0 = acc[ai][1][m][0], b1 = acc[ai][1][m][1];
#pragma unroll
                    for (int e = 0; e < 4; ++e) { u0[e] *= sigmoid_f(b0[e]); u1[e] *= sigmoid_f(b1[e]); }
                    st16_sc1(U + (size_t)r * CW + (pn - 16) * 128 + cl, pack8(u0, u1));
                }
            }
    }
};

__device__ __forceinline__ void p2a_kv(LAS unsigned char* lds, const bf16_t* __restrict__ Kt, const bf16_t* __restrict__ V, bf16_t* __restrict__ KVT, int c, int h, int tid, int wid, int lane) {
    constexpr int PT = 576, PR = 528;
    LAS unsigned char* imgK = lds; LAS unsigned char* imgV = lds + 128 * PT;
    {
        u32x4 kreg[8], vreg[8];
#pragma unroll
        for (int it = 0; it < 8; ++it) {
            const int ci = tid + NTHREADS * it, row = ci >> 5, cc = ci & 31;
            const size_t grow = c > 0 ? (size_t)(c - 1) * 128 + row : (size_t)(SEQ + (row >= 112 ? row - 112 : 0));
            kreg[it] = *(const u32x4*)(Kt + grow * RW + h * 256 + cc * 8); vreg[it] = *(const u32x4*)(V + grow * RW + h * 256 + cc * 8);
        }
#pragma unroll
        for (int it = 0; it < 8; ++it) {
            const int ci = tid + NTHREADS * it, row = ci >> 5, cc = ci & 31;
            const bool valid = (c > 0) || (row >= 112);
            u32x4 kv = kreg[it], vv = vreg[it];
            if (!valid) { kv = (u32x4){0u, 0u, 0u, 0u}; vv = kv; }
            *(LAS u32x4*)(imgK + row * PT + cc * 16) = kv; *(LAS u32x4*)(imgV + row * PT + cc * 16) = vv;
        }
    }
    __syncthreads();
    const int w2 = wid >> 2, w4 = wid & 3, n31 = lane & 31, i16 = lane & 15, q4 = i16 >> 2, p4 = i16 & 3, blk = (lane >> 4) & 1, hh = lane >> 5;
    f32x16 acc[4][2];
#pragma unroll
    for (int a = 0; a < 4; ++a)
#pragma unroll
        for (int b2 = 0; b2 < 2; ++b2)
#pragma unroll
            for (int e = 0; e < 16; ++e) acc[a][b2][e] = 0.f;
#pragma unroll
    for (int ks = 0; ks < 8; ++ks) {
        const int tok = 16 * ks + 8 * hh + q4;
        bf16x8 af[4], bf[2];
#pragma unroll
        for (int a = 0; a < 4; ++a) { const int col0 = 128 * w2 + 32 * a + 16 * blk + 4 * p4;
            const s16x4 lo = tr_read(imgK + tok * PT + col0 * 2), hi = tr_read(imgK + (tok + 4) * PT + col0 * 2);
            af[a] = __builtin_shufflevector(lo, hi, 0, 1, 2, 3, 4, 5, 6, 7); }
#pragma unroll
        for (int b2 = 0; b2 < 2; ++b2) { const int col0 = 64 * w4 + 32 * b2 + 16 * blk + 4 * p4;
            const s16x4 lo = tr_read(imgV + tok * PT + col0 * 2), hi = tr_read(imgV + (tok + 4) * PT + col0 * 2);
            bf[b2] = __builtin_shufflevector(lo, hi, 0, 1, 2, 3, 4, 5, 6, 7); }
#pragma unroll
        for (int a = 0; a < 4; ++a)
#pragma unroll
            for (int b2 = 0; b2 < 2; ++b2) acc[a][b2] = MFMA32(af[a], bf[b2], acc[a][b2]);
    }
    __syncthreads();
#pragma unroll
    for (int a = 0; a < 4; ++a)
#pragma unroll
        for (int b2 = 0; b2 < 2; ++b2)
#pragma unroll
            for (int g = 0; g < 4; ++g) { u32x2 o; o.x = cvt_pk_bf16(acc[a][b2][4 * g], acc[a][b2][4 * g + 1]); o.y = cvt_pk_bf16(acc[a][b2][4 * g + 2], acc[a][b2][4 * g + 3]);
                *(LAS u32x2*)(lds + (64 * w4 + 32 * b2 + n31) * PR + (128 * w2 + 32 * a + 8 * g + 4 * hh) * 2) = o; }
    __syncthreads();
    bf16_t* dst = KVT;
#pragma unroll
    for (int it = 0; it < 16; ++it) {
        const int ci = tid + NTHREADS * it, row = ci >> 5, cc = ci & 31;
        *(u32x4*)(dst + (size_t)row * 256 + cc * 8) = *(LAS u32x4*)(lds + row * PR + cc * 16);
    }
    __syncthreads();
}
__device__ __forceinline__ void conv_rows_load(unsigned (&raw)[32 + CK - 1], const bf16_t* __restrict__ U, int ct, int tid) {
    if (ct == 0) {
        const int p0 = NMETA - (CK - 1);
#pragma unroll
        for (int s = 0; s < 32 + CK - 1; ++s) {
            const int p = p0 + s, pc = p < 0 ? 0 : p, row = pc >= NMETA ? pc - NMETA : SEQ + pc;
            raw[s] = *(const unsigned*)(U + (size_t)row * CW + 2 * tid);
            if (p < 0) raw[s] = 0u;
        }
    } else {
        const bf16_t* b0 = U + (size_t)(32 * ct - (CK - 1)) * CW + 2 * tid;
#pragma unroll
        for (int s = 0; s < 32 + CK - 1; ++s) raw[s] = *(const unsigned*)(b0 + (size_t)s * CW);
    }
}
__device__ __forceinline__ int p2a_conv_run(LAS unsigned char* lds, const bf16_t* __restrict__ U, const float* __restrict__ dw_w, const float* __restrict__ dw_b, const float* __restrict__ ln_g, const float* __restrict__ ln_b,
                                            bf16_t* __restrict__ CB, unsigned* ctl, volatile LAS unsigned* misc, int ct, int tid0, int wid) {
    f32x2 w[CK];
#pragma unroll
    for (int j = 0; j < CK; ++j) w[j] = *(const f32x2*)(dw_w + j * CW + 2 * tid0);
    const f32x2 bias = *(const f32x2*)(dw_b + 2 * tid0);
    unsigned raw[32 + CK - 1];
    conv_rows_load(raw, U, ct, tid0);
    int prev = -1, nxt;
#pragma unroll 1
    for (;;) {
        int tid = tid0; asm volatile("" : "+v"(tid));
        const int lane = tid & 63;
        {
            f32x2 acc[32];
#pragma unroll
            for (int t = 0; t < 32; ++t) acc[t] = bias;
#pragma unroll
            for (int s = 0; s < 32 + CK - 1; ++s) {
                const f32x2 uv = {bf_lo(raw[s]), bf_hi(raw[s])};
#pragma unroll
                for (int t = (s - (CK - 1) > 0 ? s - (CK - 1) : 0); t <= (s < 31 ? s : 31); ++t) acc[t] = __builtin_elementwise_fma(uv, w[s - t], acc[t]);
            }
            asm volatile("s_waitcnt vmcnt(0)" ::: "memory");
            __syncthreads();
#pragma unroll
            for (int t = 0; t < 32; ++t) *(LAS f32x2*)(lds + (t * CW + 2 * tid) * 4) = acc[t];
        }
        if (tid == 0) misc[0] = __hip_atomic_fetch_add(ctl + CW_Q, 1u, __ATOMIC_RELAXED, __HIP_MEMORY_SCOPE_AGENT);
        __syncthreads();
        if (tid == 0 && prev >= 0) __hip_atomic_fetch_add(ctl + CW_CONV + 64 * (prev >> 3), 1u, __ATOMIC_RELAXED, __HIP_MEMORY_SCOPE_AGENT);
        nxt = (int)misc[0];
        {
            f32x4 gg[2][2], bb[2][2];
#pragma unroll
            for (int i = 0; i < 2; ++i)
#pragma unroll
                for (int q = 0; q < 2; ++q) { gg[i][q] = *(const f32x4*)(ln_g + 512 * i + 8 * lane + 4 * q); bb[i][q] = *(const f32x4*)(ln_b + 512 * i + 8 * lane + 4 * q); }
            if (nxt < 256) conv_rows_load(raw, U, nxt, tid);
#pragma unroll
            for (int k = 0; k < 4; ++k) {
                const int t = 4 * wid + k;
                f32x4 v[2][2]; float sm = 0.f;
#pragma unroll
                for (int i = 0; i < 2; ++i)
#pragma unroll
                    for (int q = 0; q < 2; ++q) { v[i][q] = *(LAS f32x4*)(lds + (t * CW + 512 * i + 8 * lane + 4 * q) * 4); sm += (v[i][q][0] + v[i][q][1]) + (v[i][q][2] + v[i][q][3]); }
                const float mu = wave_sum(sm) * (1.0f / CW);
                float qq = 0.f;
#pragma unroll
                for (int i = 0; i < 2; ++i)
#pragma unroll
                    for (int q = 0; q < 2; ++q) { v[i][q] = v[i][q] - mu; qq += (v[i][q][0] * v[i][q][0] + v[i][q][1] * v[i][q][1]) + (v[i][q][2] * v[i][q][2] + v[i][q][3] * v[i][q][3]); }
                const float rs = 1.0f / sqrtf(wave_sum(qq) * (1.0f / CW) + EPS);
#pragma unroll
                for (int i = 0; i < 2; ++i) { f32x4 y0 = v[i][0] * rs * gg[i][0] + bb[i][0], y1 = v[i][1] * rs * gg[i][1] + bb[i][1];
#pragma unroll
                    for (int e = 0; e < 4; ++e) { y0[e] = silu_f(y0[e]); y1[e] = silu_f(y1[e]); }
                    st16_sc1(CB + (size_t)(32 * ct + t) * CW + 512 * i + 8 * lane, pack8(y0, y1)); }
            }
        }
        prev = ct;
        if (nxt >= 256) break;
        ct = nxt;
    }
    asm volatile("s_waitcnt vmcnt(0)" ::: "memory");
    __syncthreads();
    if (tid0 == 0) __hip_atomic_fetch_add(ctl + CW_CONV + 64 * (prev >> 3), 1u, __ATOMIC_RELAXED, __HIP_MEMORY_SCOPE_AGENT);
    return nxt;
}

__device__ __forceinline__ void p2b_scan(bf16_t* ST, int sb, int tid) {
    const int e2 = sb * NTHREADS + tid, h = e2 >> 15;
    const float cd = exp2f(128.0f * kLog2G[h]);
    f32x2 S = {0.f, 0.f};
    unsigned* p = (unsigned*)ST + e2;
#pragma unroll 1
    for (int c0 = 0; c0 < 64; c0 += 16) {
        unsigned kv[16];
#pragma unroll
        for (int j = 0; j < 16; ++j) kv[j] = __builtin_nontemporal_load(p + (size_t)(c0 + j) * 131072);
#pragma unroll
        for (int j = 0; j < 16; ++j) {
            const f32x2 k2 = {bf_lo(kv[j]), bf_hi(kv[j])};
            S = S * cd + k2;
            p[(size_t)(c0 + j) * 131072] = cvt_pk_bf16(S[0], S[1]);
        }
    }
}
struct SchedOne { int pm, pn; bool on;
    __device__ __forceinline__ bool next(int i, Unit& u) const { if (i > 0 || !on) return false; u.pm = pm; u.pn = pn; return true; }
    __device__ __forceinline__ void a_ready(const Unit&) const {}
    __device__ __forceinline__ void done(const Unit&) const {}
};
struct EpiPw {
    static constexpr bool PERM = true, AFTER_DRAIN = false, INIT = false;
    bf16_t* GY; const float* pw_b; unsigned* gcnt;
    __device__ __forceinline__ void operator()(const f32x4 (&acc)[2][2][4][2], const Unit& u, int wr, int wc, int fr, int fq) const {
        if (threadIdx.x == 0) { wait_count(gcnt + 64 * u.pm, 4u); __builtin_amdgcn_fence(__ATOMIC_ACQUIRE, "agent"); asm volatile("s_waitcnt vmcnt(0)" ::: "memory"); }
        __syncthreads();
        const int cl = wc * 32 + 8 * fq;
#pragma unroll
        for (int bj = 0; bj < 2; ++bj) {
            const int col = u.pn * 256 + bj * 128 + cl;
            const f32x4 b0 = *(const f32x4*)(pw_b + col), b1 = *(const f32x4*)(pw_b + col + 4);
#pragma unroll
            for (int ai = 0; ai < 2; ++ai)
#pragma unroll
                for (int m = 0; m < 4; ++m) {
                    const int r = u.pm * 256 + ai * 128 + wr * 64 + m * 16 + fr;
                    bf16_t* p = GY + (size_t)r * DM + 1024 + col;
                    const u32x4 g = *(const u32x4*)p;
                    const f32x4 g0 = {bf_lo(g.x), bf_hi(g.x), bf_lo(g.y), bf_hi(g.y)}, g1 = {bf_lo(g.z), bf_hi(g.z), bf_lo(g.w), bf_hi(g.w)};
                    *(u32x4*)p = pack8((acc[ai][bj][m][0] + b0) * g0, (acc[ai][bj][m][1] + b1) * g1);
                }
        }
    }
};

__device__ __forceinline__ void p2c_images(LAS unsigned char* lds, const bf16_t* __restrict__ Qt, const bf16_t* __restrict__ Kt, int xc, int h, int tid) {
    constexpr int PR = 528;
    LAS unsigned char* imgQ = lds; LAS unsigned char* imgK = lds + 73728;
    const size_t row0 = (size_t)xc * 128;
#pragma unroll
    for (int it = 0; it < 8; ++it) {
        const int ci = tid + NTHREADS * it, row = ci >> 5, cc = ci & 31;
        const u32x4 q = __builtin_nontemporal_load((const u32x4*)(Qt + (row0 + row) * RW + h * 256 + cc * 8)), k = __builtin_nontemporal_load((const u32x4*)(Kt + (row0 + row) * RW + h * 256 + cc * 8));
        *(LAS u32x4*)(imgQ + row * PR + cc * 16) = q; *(LAS u32x4*)(imgK + row * PR + cc * 16) = k;
    }
}
__device__ __forceinline__ void p2c_item(LAS unsigned char* lds, const bf16_t* __restrict__ Qt, const bf16_t* __restrict__ Kt, const bf16_t* __restrict__ V, const bf16_t* __restrict__ ST, bf16_t* __restrict__ GY,
                                         const float* __restrict__ gn_g, int xc, int h, int tid, int wid, int lane, const XcdBarrier& bar, bool pending, unsigned tok, unsigned tok2, bool preloaded) {
    constexpr int PR = 528, PT = 576, PF = 1040;
    LAS unsigned char* imgQ = lds; LAS unsigned char* imgK = lds + 73728; LAS unsigned char* imgV = lds + 73728; LAS unsigned char* imgS = lds;
    LAS float* ex = (LAS float*)(lds + 135168);
    const int wr = wid >> 1, wc = wid & 1, n31 = lane & 31, hh = lane >> 5, i16 = lane & 15, q4 = i16 >> 2, p4 = i16 & 3, blk = (lane >> 4) & 1;
    const size_t row0 = (size_t)xc * 128;
    if (!preloaded) p2c_images(lds, Qt, Kt, xc, h, tid);
    u32x4 vreg[8];
#pragma unroll
    for (int it = 0; it < 8; ++it) { const int ci = tid + NTHREADS * it, row = ci >> 5, cc = ci & 31; vreg[it] = __builtin_nontemporal_load((const u32x4*)(V + (row0 + row) * RW + h * 256 + cc * 8)); }
    __syncthreads();
    const float ginv = exp2f(-128.0f * kLog2G[h]);
    bf16x8 pf[4][2];
    {
        bf16x8 qf[16];
#pragma unroll
        for (int ks = 0; ks < 16; ++ks) qf[ks] = *(LAS bf16x8*)(imgQ + (32 * wr + n31) * PR + (16 * ks + 8 * hh) * 2);
#pragma unroll
        for (int jb = 0; jb < 4; ++jb) {
            if (jb <= wr) {
                f32x16 X;
#pragma unroll
                for (int e = 0; e < 16; ++e) X[e] = 0.f;
#pragma unroll
                for (int ks = 0; ks < 16; ++ks) { const bf16x8 kf = *(LAS bf16x8*)(imgK + (32 * jb + n31) * PR + (16 * ks + 8 * hh) * 2); X = MFMA32(kf, qf[ks], X); }
#pragma unroll
                for (int e = 0; e < 16; ++e) { const bool keep = (jb < wr) || (crow(e, hh) <= n31); X[e] = keep ? X[e] * ginv : 0.f; }
#pragma unroll
                for (int s2 = 0; s2 < 2; ++s2) { u32x4 p; p.x = cvt_pk_bf16(X[8 * s2], X[8 * s2 + 1]); p.y = cvt_pk_bf16(X[8 * s2 + 2], X[8 * s2 + 3]); p.z = cvt_pk_bf16(X[8 * s2 + 4], X[8 * s2 + 5]); p.w = cvt_pk_bf16(X[8 * s2 + 6], X[8 * s2 + 7]);
                    pf[jb][s2] = __builtin_bit_cast(bf16x8, p); }
            } else { pf[jb][0] = (bf16x8){0, 0, 0, 0, 0, 0, 0, 0}; pf[jb][1] = pf[jb][0]; }
        }
    }
    if (pending && tid == 0) xcd_barrier_wait_t0(bar, tok, tok2);
    __syncthreads();
#pragma unroll
    for (int it = 0; it < 8; ++it) { const int ci = tid + NTHREADS * it, row = ci >> 5, cc = ci & 31; *(LAS u32x4*)(imgV + row * PT + cc * 16) = vreg[it]; }
    const bf16_t* Ssrc = ST + (size_t)(xc * 4 + h) * 65536;
    u32x4 sreg[8];
#pragma unroll
    for (int it = 0; it < 8; ++it) { const int ci = tid + NTHREADS * it, row = ci >> 5, cc = ci & 31; sreg[it] = __builtin_nontemporal_load((const u32x4*)(Ssrc + (size_t)row * 256 + cc * 8)); }
    __syncthreads();
    f32x16 acc[4];
#pragma unroll
    for (int nb = 0; nb < 4; ++nb)
#pragma unroll
        for (int e = 0; e < 16; ++e) acc[nb][e] = 0.f;
#pragma unroll
    for (int jb = 0; jb < 4; ++jb) {
        if (jb <= wr) {
#pragma unroll
            for (int s2 = 0; s2 < 2; ++s2) {
                const int tok = 32 * jb + 16 * s2 + 4 * hh + q4;
#pragma unroll
                for (int nb = 0; nb < 4; ++nb) { const int col0 = 128 * wc + 32 * nb + 16 * blk + 4 * p4;
                    const s16x4 lo = tr_read(imgV + tok * PT + col0 * 2), hi = tr_read(imgV + (tok + 8) * PT + col0 * 2);
                    const bf16x8 vf = __builtin_shufflevector(lo, hi, 0, 1, 2, 3, 4, 5, 6, 7);
                    acc[nb] = MFMA32(pf[jb][s2], vf, acc[nb]); }
            }
        }
    }
    bf16x8 qf[16];
#pragma unroll
    for (int ks = 0; ks < 16; ++ks) qf[ks] = *(LAS bf16x8*)(imgQ + (32 * wr + n31) * PR + (16 * ks + 8 * hh) * 2);
    __syncthreads();
    {
        u32x4 sreg2[8];
#pragma unroll
        for (int it = 0; it < 8; ++it) { const int ci = tid + NTHREADS * (it + 8), row = ci >> 5, cc = ci & 31; sreg2[it] = __builtin_nontemporal_load((const u32x4*)(Ssrc + (size_t)row * 256 + cc * 8)); }
#pragma unroll
        for (int it = 0; it < 8; ++it) { const int ci = tid + NTHREADS * it, row = ci >> 5, cc = ci & 31; *(LAS u32x4*)(imgS + row * PR + cc * 16) = sreg[it]; }
#pragma unroll
        for (int it = 0; it < 8; ++it) { const int ci = tid + NTHREADS * (it + 8), row = ci >> 5, cc = ci & 31; *(LAS u32x4*)(imgS + row * PR + cc * 16) = sreg2[it]; }
    }
    u32x4 greg[8];
#pragma unroll
    for (int it = 0; it < 8; ++it) { const int ci = tid + NTHREADS * it, row = ci >> 5, cc = ci & 31; greg[it] = __builtin_nontemporal_load((const u32x4*)(GY + (row0 + row) * DM + h * 256 + cc * 8)); }
    __syncthreads();
#pragma unroll
    for (int ks = 0; ks < 16; ++ks)
#pragma unroll
        for (int nb = 0; nb < 4; ++nb) { const bf16x8 sf = *(LAS bf16x8*)(imgS + (128 * wc + 32 * nb + n31) * PR + (16 * ks + 8 * hh) * 2); acc[nb] = MFMA32(qf[ks], sf, acc[nb]); }
    float sm[16], sq[16];
#pragma unroll
    for (int e = 0; e < 16; ++e) {
        float a = (acc[0][e] + acc[1][e]) + (acc[2][e] + acc[3][e]);
        float q = (acc[0][e] * acc[0][e] + acc[1][e] * acc[1][e]) + (acc[2][e] * acc[2][e] + acc[3][e] * acc[3][e]);
        a = sum32(a); q = sum32(q);
        sm[e] = a; sq[e] = q;
        if (n31 == e) { ex[(wid * 32 + crow(e, hh)) * 2] = a; ex[(wid * 32 + crow(e, hh)) * 2 + 1] = q; }
    }
    __syncthreads();
    float gng[4];
#pragma unroll
    for (int nb = 0; nb < 4; ++nb) gng[nb] = gn_g[h * 256 + 128 * wc + 32 * nb + n31];
#pragma unroll
    for (int e = 0; e < 16; ++e) {
        const int rl = crow(e, hh);
        const float ta = sm[e] + ex[((wid ^ 1) * 32 + rl) * 2], tq = sq[e] + ex[((wid ^ 1) * 32 + rl) * 2 + 1];
        const float mu = ta * (1.0f / RD), var = tq * (1.0f / RD) - mu * mu, rs = __builtin_amdgcn_rsqf(fmaxf(var, 0.f) + EPS);
#pragma unroll
        for (int nb = 0; nb < 4; ++nb) *(LAS float*)(lds + (32 * wr + rl) * PF + (128 * wc + 32 * nb + n31) * 4) = (acc[nb][e] - mu) * rs * gng[nb];
    }
    __syncthreads();
#pragma unroll
    for (int it = 0; it < 8; ++it) {
        const int ci = tid + NTHREADS * it, row = ci >> 5, cc = ci & 31;
        const f32x4 y0 = *(LAS f32x4*)(lds + row * PF + cc * 32), y1 = *(LAS f32x4*)(lds + row * PF + cc * 32 + 16);
        const u32x4 g = greg[it];
        const f32x4 g0 = {bf_lo(g.x), bf_hi(g.x), bf_lo(g.y), bf_hi(g.y)}, g1 = {bf_lo(g.z), bf_hi(g.z), bf_lo(g.w), bf_hi(g.w)};
        st16_sc1(GY + (row0 + row) * DM + h * 256 + cc * 8, pack8(y0 * g0, y1 * g1));
    }
    asm volatile("s_waitcnt vmcnt(0)" ::: "memory");
    __syncthreads();
}

struct SchedP3 { int pm, pn; unsigned* cnt; unsigned want;
    __device__ __forceinline__ bool next(int i, Unit& u) const { if (i > 0) return false; u.pm = pm; u.pn = pn; return true; }
    __device__ __forceinline__ void a_ready(const Unit&) const {
        if (threadIdx.x == 0) { wait_count(cnt + 64 * pm, want); __builtin_amdgcn_fence(__ATOMIC_ACQUIRE, "agent"); asm volatile("s_waitcnt vmcnt(0)" ::: "memory"); }
        __syncthreads();
    }
    __device__ __forceinline__ void done(const Unit&) const {}
};
struct Epi3 {
    static constexpr bool PERM = true, AFTER_DRAIN = true, INIT = true;
    const float* x; float* out; const float* final_g; float* psum; unsigned* panel;
    __device__ __forceinline__ void init(f32x4 (&acc)[2][2][4][2], const Unit& u, int wr, int wc, int fr, int fq) const {
        const int cl = wc * 32 + 8 * fq;
#pragma unroll
        for (int ai = 0; ai < 2; ++ai)
#pragma unroll
            for (int m = 0; m < 4; ++m) { const float* xr = x + ((size_t)u.pm * 256 + ai * 128 + wr * 64 + m * 16 + fr) * DM + u.pn * 256 + cl;
#pragma unroll
                for (int bj = 0; bj < 2; ++bj)
#pragma unroll
                    for (int n = 0; n < 2; ++n) acc[ai][bj][m][n] = __builtin_nontemporal_load((const f32x4*)(xr + bj * 128 + 4 * n)); }
    }
    __device__ __forceinline__ void fused(f32x4 (&acc)[2][2][4][2], const Unit& u, int wr, int wc, int fr, int fq, LAS unsigned char* lds, int wid, int lane) const {
        constexpr int PF = 1040;
        int ln = lane; asm volatile("" : "+v"(ln));
        const int cl = wc * 32 + 8 * fq, wv = wid;
        const size_t prow = (size_t)u.pn * SEQ + u.pm * 256;
        LAS float* red = (LAS float*)(lds + 135168);
#pragma unroll
        for (int ai = 0; ai < 2; ++ai)
#pragma unroll
            for (int m = 0; m < 4; ++m) {
                float sq = 0.f;
#pragma unroll
                for (int bj = 0; bj < 2; ++bj)
#pragma unroll
                    for (int n = 0; n < 2; ++n) { const f32x4 v = acc[ai][bj][m][n]; sq += (v[0] * v[0] + v[1] * v[1]) + (v[2] * v[2] + v[3] * v[3]); }
                sq += __builtin_bit_cast(float, __builtin_amdgcn_ds_swizzle(__builtin_bit_cast(int, sq), 0x401F)); sq += __shfl_xor(sq, 32);
                if (fq == 0) red[wc * 256 + ai * 128 + wr * 64 + m * 16 + fr] = sq;
            }
        __syncthreads();
        if (threadIdx.x < 256) { const int t = threadIdx.x; const float tot = (red[t] + red[256 + t]) + (red[512 + t] + red[768 + t]);
            __hip_atomic_store(psum + prow + t, tot, __ATOMIC_RELAXED, __HIP_MEMORY_SCOPE_AGENT); }
        asm volatile("s_waitcnt vmcnt(0)" ::: "memory");
        __syncthreads();
        if (threadIdx.x == 0) __hip_atomic_fetch_add(panel + 64 * u.pm, 1u, __ATOMIC_RELAXED, __HIP_MEMORY_SCOPE_AGENT);
        f32x4 hreg[2][16];
#pragma unroll
        for (int ai = 0; ai < 2; ++ai) {
            if (ai) __syncthreads();
#pragma unroll
            for (int m = 0; m < 4; ++m)
#pragma unroll
                for (int bj = 0; bj < 2; ++bj)
#pragma unroll
                    for (int n = 0; n < 2; ++n) *(LAS f32x4*)(lds + (wr * 64 + m * 16 + fr) * PF + (bj * 128 + cl + 4 * n) * 4) = acc[ai][bj][m][n];
            __syncthreads();
#pragma unroll
            for (int it = 0; it < 16; ++it) hreg[ai][it] = *(LAS f32x4*)(lds + (wv + 8 * it) * PF + ln * 16);
        }
        if (threadIdx.x == 0) {
            wait_count(panel + 64 * u.pm, 8u);
            __builtin_amdgcn_fence(__ATOMIC_ACQUIRE, "agent");
            asm volatile("s_waitcnt vmcnt(0)" ::: "memory");
        }
        __syncthreads();
        float rsl;
        { const size_t r = (size_t)u.pm * 256 + (ln >> 4 & 1) * 128 + wv + 8 * (ln & 15);
          float tot = 0.f;
#pragma unroll
          for (int p = 0; p < 8; ++p) tot += psum[(size_t)p * SEQ + r];
          rsl = 1.0f / sqrtf(tot * (1.0f / DM) + EPS); }
        const f32x4 g = *(const f32x4*)(final_g + u.pn * 256 + 4 * ln);
        float* ob = out + ((size_t)u.pm * 256 + wv) * DM + u.pn * 256 + 4 * ln;
#pragma unroll
        for (int ai = 0; ai < 2; ++ai)
#pragma unroll
            for (int it = 0; it < 16; ++it) {
                const float rs = __builtin_bit_cast(float, __builtin_amdgcn_readlane(__builtin_bit_cast(int, rsl), ai * 16 + it));
                __builtin_nontemporal_store(hreg[ai][it] * rs * g, (f32x4*)(ob + (size_t)(ai * 128 + 8 * it) * DM));
            }
    }
};

struct Args { const float* in[13]; float* out; unsigned char* ws; int ph_lo, ph_hi; };
__global__ void __launch_bounds__(NTHREADS, 2) mega(Args a) {
    extern __shared__ __attribute__((aligned(16))) unsigned char lds_[];
    LAS unsigned char* lds = (LAS unsigned char*)lds_;
    const int tid = threadIdx.x, lane = tid & 63, wid = __builtin_amdgcn_readfirstlane(tid >> 6), b = blockIdx.x;
    unsigned char* ws = a.ws;
    const float *x = a.in[0], *meta = a.in[1], *ln_g = a.in[2], *w_in = a.in[3], *gn_g = a.in[4], *dw_w = a.in[5], *dw_b = a.in[6], *cln_g = a.in[7], *cln_b = a.in[8],
                *pw_w = a.in[9], *pw_b = a.in[10], *w_out = a.in[11], *final_g = a.in[12];
    for (int u = tid; u < (LDS_BYTES - MISC_OFF) / 4; u += NTHREADS) ((LAS unsigned*)(lds + MISC_OFF))[u] = 0u;
    __syncthreads();
    XcdBarrier bar = xcd_barrier_post((unsigned*)(ws + WS_CTL) + CW_BAR, (volatile LAS unsigned*)(lds + MISC_OFF) + 8);
    const int lo = a.ph_lo, hi = a.ph_hi;
#define IN(k) (lo <= (k) && (k) < hi)
#define SEAM(k) do { if (IN(k) && IN((k) + 1)) xcd_barrier(bar); } while (0)
#define WS_LAUNDER() size_t wsz_ = 0; asm volatile("" : "+s"(wsz_)); unsigned char* wsl = ws + wsz_
    if (IN(0)) { p0_prologue(lds, x, meta, ln_g, w_in, pw_w, w_out, ws, b, tid, wid, lane); }
    SEAM(0);
    if (IN(1)) {
        unsigned* ctl = (unsigned*)(ws + WS_CTL);
        {
            WS_LAUNDER();
            pg8::Gemm g{(const bf16_t*)(wsl + WS_HB), (const bf16_t*)(wsl + WS_WIN), MPAD, INW, DM};
            Sched1 S{b, ctl};
            Epi1 E{(bf16_t*)(wsl + WS_QT), (bf16_t*)(wsl + WS_KT), (bf16_t*)(wsl + WS_V), (bf16_t*)(wsl + WS_U), (bf16_t*)(wsl + WS_GY), (const float*)(wsl + WS_RSTD), (const float*)(wsl + WS_COS), (const float*)(wsl + WS_SIN)};
            pg8::gemm_phase<Epi1, Sched1, true, true>(lds, g, S, E);
        }
        {
            WS_LAUNDER();
            volatile LAS unsigned* misc = (volatile LAS unsigned*)(lds + MISC_OFF);
            if (tid == 0) { wait_count(ctl + CW_MID, (unsigned)GRID); __builtin_amdgcn_fence(__ATOMIC_ACQUIRE, "agent"); asm volatile("s_waitcnt vmcnt(0)" ::: "memory"); }
            __syncthreads();
            bool meta_ok = false;
            int carried = -1;
            for (;;) {
                int item;
                if (carried >= 0) { item = carried; carried = -1; }
                else {
                    if (tid == 0) misc[0] = __hip_atomic_fetch_add(ctl + CW_Q, 1u, __ATOMIC_RELAXED, __HIP_MEMORY_SCOPE_AGENT);
                    __syncthreads();
                    item = (int)misc[0];
                    __syncthreads();
                }
                if (item >= 640) break;
                if (item >= 256 && item < 384) {
                    const int pm = (item - 256) >> 2, pn = item & 3;
                    if (tid == 0) { wait_count(ctl + CW_CONV + 64 * pm, 8u); __builtin_amdgcn_fence(__ATOMIC_ACQUIRE, "agent"); asm volatile("s_waitcnt vmcnt(0)" ::: "memory"); }
                    __syncthreads();
                    size_t zp = 0; asm volatile("" : "+s"(zp));
                    pg8::Gemm g{(const bf16_t*)(wsl + WS_CB) + zp, (const bf16_t*)(wsl + WS_WPW) + zp, SEQ, CW, CW};
                    SchedOne S{pm, pn, true};
                    EpiPw E{(bf16_t*)(wsl + WS_GY) + zp, pw_b + zp, ctl + CW_GC};
                    pg8::gemm_phase<EpiPw, SchedOne, true, true>(lds, g, S, E);
                    continue;
                }
                const bool is_kv = item >= 384;
                const int j = is_kv ? item - 384 : item;
                const int c = j < 252 ? (j >> 2) + 1 : 0, hq = j & 3, ct = j;
                const bool needs_meta = is_kv ? (c == 0) : (ct == 0);
                if (needs_meta && !meta_ok) {
                    if (tid == 0) { wait_count(ctl + CW_META, 16u); __builtin_amdgcn_fence(__ATOMIC_ACQUIRE, "agent"); asm volatile("s_waitcnt vmcnt(0)" ::: "memory"); }
                    __syncthreads();
                    meta_ok = true;
                }
                size_t zi = 0; asm volatile("" : "+s"(zi));
                int tl = tid; asm volatile("" : "+v"(tl));
                const int ll = tl & 63, wl = __builtin_amdgcn_readfirstlane(tl >> 6);
                if (is_kv) p2a_kv(lds, (const bf16_t*)(wsl + WS_KT) + zi, (const bf16_t*)(wsl + WS_V) + zi, kvt_tile(wsl, c * 4 + hq) + zi, c, hq, tl, wl, ll);
                else { carried = p2a_conv_run(lds, (const bf16_t*)(wsl + WS_U) + zi, dw_w + zi, dw_b + zi, cln_g + zi, cln_b + zi, (bf16_t*)(wsl + WS_CB) + zi, ctl, misc, ct, tl, wl);
                       __syncthreads(); }
            }
        }
    }
    const bool preloaded = IN(1) && IN(3);
    {
        unsigned t1 = 0u, t1b = 0u;
        const bool pend1 = IN(1) && IN(2);
        if (pend1) xcd_barrier_arrive(bar, t1, t1b);
        if (preloaded) { WS_LAUNDER(); p2c_images(lds, (const bf16_t*)(wsl + WS_QT), (const bf16_t*)(wsl + WS_KT), b >> 2, b & 3, tid); }
        if (pend1) { if (tid == 0) xcd_barrier_wait_t0(bar, t1, t1b); __syncthreads(); }
    }
    if (IN(2)) {
        WS_LAUNDER();
        p2b_scan((bf16_t*)(wsl + WS_ST), b, tid);
    }
    unsigned tok = 0u, tok2 = 0u;
    const bool pending = IN(2) && IN(3);
    if (pending) xcd_barrier_arrive(bar, tok, tok2);
    if (IN(3)) {
        WS_LAUNDER();
        p2c_item(lds, (const bf16_t*)(wsl + WS_QT), (const bf16_t*)(wsl + WS_KT), (const bf16_t*)(wsl + WS_V), (const bf16_t*)(wsl + WS_ST), (bf16_t*)(wsl + WS_GY), gn_g, b >> 2, b & 3, tid, wid, lane, bar, pending, tok, tok2, preloaded);
        if (tid == 0) __hip_atomic_fetch_add((unsigned*)(ws + WS_CTL) + CW_YR + 64 * (b >> 3), 1u, __ATOMIC_RELAXED, __HIP_MEMORY_SCOPE_AGENT);
    }
    if (IN(4)) {
        WS_LAUNDER();
        pg8::Gemm g{(const bf16_t*)(wsl + WS_GY), (const bf16_t*)(wsl + WS_WOUT), SEQ, DM, DM};
        const int xcd = b & 7, off = b >> 3, wg = xcd * 32 + off;
        SchedP3 S{(wg >> 6) * 8 + (wg & 7), (wg & 63) >> 3, (unsigned*)(ws + WS_CTL) + CW_YR, IN(3) ? 8u : 0u};
        Epi3 E{x, a.out, final_g, (float*)(wsl + WS_PSUM), (unsigned*)(ws + WS_CTL) + CW_PANEL};
        pg8::gemm_phase<Epi3, SchedP3, false, true>(lds, g, S, E);
    }
#undef WS_LAUNDER
#undef IN
#undef SEAM
}
}

#ifndef LADDER
#define LADDER 0
#endif
#ifndef PROBE_K
#define PROBE_K 0
#endif
#ifndef PROBE_TAIL
#define PROBE_TAIL 0
#endif
#if LADDER > 0
namespace nt {
using namespace mk;
__device__ __forceinline__ float bf2f(bf16_t v) { return __uint_as_float((unsigned)v << 16); }
__device__ __forceinline__ bf16_t f2bf(float f) { unsigned u = __float_as_uint(f); return (bf16_t)((u + 0x7fffu + ((u >> 16) & 1u)) >> 16); }
__device__ __forceinline__ float sigm(float x) { return 1.f / (1.f + expf(-x)); }
__global__ void __launch_bounds__(64) t_retention(const bf16_t* Qt, const bf16_t* Kt, const bf16_t* V, float* yraw) {
    const int w = blockIdx.x, h = w >> 8, dv = w & 255, lane = threadIdx.x;
    const float gamma = 1.0f - exp2f(-5.0f - (float)h), l2g = log2f(gamma);
    float S[4] = {0.f, 0.f, 0.f, 0.f};
    for (int pos = 0; pos < LTOK; ++pos) {
        const int r = pos < NMETA ? SEQ + pos : pos - NMETA, il = pos < NMETA ? 112 + pos : (r & 127);
        const float v = bf2f(V[(size_t)r * RW + h * RD + dv]);
        const float kd = exp2f(-(float)(127 - il) * l2g), qd = exp2f(-(float)(il + 1) * l2g);
        float part = 0.f;
#pragma unroll
        for (int i = 0; i < 4; ++i) {
            const int d = lane + 64 * i;
            const float k = bf2f(Kt[(size_t)r * RW + h * RD + d]) * kd;
            const float q = r < SEQ ? bf2f(Qt[(size_t)r * RW + h * RD + d]) * qd : 0.f;
            S[i] = gamma * S[i] + k * v;
            part += q * S[i];
        }
        part = wave_sum(part);
        if (lane == 0 && r < SEQ) yraw[(size_t)r * RW + h * RD + dv] = part;
    }
}
__global__ void __launch_bounds__(256) t_chunk(const bf16_t* Qt, const bf16_t* Kt, const bf16_t* V, const bf16_t* ST, float* yraw) {
    __shared__ float sc[128];
    __shared__ float qs[256];
    const int xc = blockIdx.x >> 2, h = blockIdx.x & 3, dv = threadIdx.x;
    const float gamma = 1.0f - exp2f(-5.0f - (float)h), ginv = exp2f(-128.0f * log2f(gamma));
    const bf16_t* Sx = ST + (size_t)(xc * 4 + h) * 65536;
    for (int i = 0; i < 128; ++i) {
        const size_t ri = (size_t)xc * 128 + i;
        __syncthreads();
        qs[dv] = bf2f(Qt[ri * RW + h * RD + dv]);
        __syncthreads();
        if (dv < 128) { float s = 0.f; if (dv <= i) { const size_t rj = (size_t)xc * 128 + dv; for (int d = 0; d < 256; ++d) s += qs[d] * bf2f(Kt[rj * RW + h * RD + d]); } sc[dv] = s * ginv; }
        __syncthreads();
        float y = 0.f;
        for (int j = 0; j <= i; ++j) y += sc[j] * bf2f(V[((size_t)xc * 128 + j) * RW + h * RD + dv]);
        for (int d = 0; d < 256; ++d) y += qs[d] * bf2f(Sx[(size_t)dv * 256 + d]);
        yraw[ri * RW + h * RD + dv] = y;
    }
}
__global__ void t_groupnorm(const float* yraw, bf16_t* GY, const float* gn_g) {
    const int w = (blockIdx.x * blockDim.x + threadIdx.x) >> 6, lane = threadIdx.x & 63;
    if (w >= SEQ * RH) return;
    const int r = w >> 2, h = w & 3;
    float v[4], s = 0.f;
#pragma unroll
    for (int i = 0; i < 4; ++i) { v[i] = yraw[(size_t)r * RW + h * RD + lane + 64 * i]; s += v[i]; }
    const float mu = wave_sum(s) / RD;
    float q = 0.f;
#pragma unroll
    for (int i = 0; i < 4; ++i) { v[i] -= mu; q += v[i] * v[i]; }
    const float rs = 1.0f / sqrtf(wave_sum(q) / RD + EPS);
#pragma unroll
    for (int i = 0; i < 4; ++i) { const int c = h * RD + lane + 64 * i; bf16_t* p = GY + (size_t)r * DM + c; *p = f2bf(v[i] * rs * gn_g[c] * bf2f(*p)); }
}
__global__ void __launch_bounds__(256) t_conv(const bf16_t* U, const float* dw_w, const float* dw_b, const float* ln_g, const float* ln_b, bf16_t* CB) {
    __shared__ float red[8];
    const int r = blockIdx.x, pos = r + NMETA, tid = threadIdx.x, lane = tid & 63, wv = tid >> 6;
    float c[4];
#pragma unroll
    for (int i = 0; i < 4; ++i) {
        const int ch = tid + 256 * i;
        float a = dw_b[ch];
        for (int j = 0; j < CK; ++j) { const int p = pos - (CK - 1) + j; if (p >= 0) { const int row = p >= NMETA ? p - NMETA : SEQ + p; a += bf2f(U[(size_t)row * CW + ch]) * dw_w[j * CW + ch]; } }
        c[i] = a;
    }
    float s = wave_sum(c[0] + c[1] + c[2] + c[3]);
    if (lane == 0) red[wv] = s;
    __syncthreads();
    const float mu = (red[0] + red[1] + red[2] + red[3]) / CW;
    float q = 0.f;
#pragma unroll
    for (int i = 0; i < 4; ++i) { c[i] -= mu; q += c[i] * c[i]; }
    q = wave_sum(q);
    if (lane == 0) red[4 + wv] = q;
    __syncthreads();
    const float rs = 1.0f / sqrtf((red[4] + red[5] + red[6] + red[7]) / CW + EPS);
#pragma unroll
    for (int i = 0; i < 4; ++i) { const int ch = tid + 256 * i; const float y = c[i] * rs * ln_g[ch] + ln_b[ch]; CB[(size_t)r * CW + ch] = f2bf(y * sigm(y)); }
}
template <int M, int N, int K, class AL, class EP>
__global__ void __launch_bounds__(256) t_gemm(const float* B, AL al, EP ep) {
    __shared__ float As[16][68];
    __shared__ float Bs[16][68];
    const int tx = threadIdx.x & 15, ty = threadIdx.x >> 4;
    const int m0 = blockIdx.y * 64, n0 = blockIdx.x * 64;
    float acc[4][4];
#pragma unroll
    for (int i = 0; i < 4; ++i)
#pragma unroll
        for (int j = 0; j < 4; ++j) acc[i][j] = 0.f;
    for (int k0 = 0; k0 < K; k0 += 16) {
#pragma unroll
        for (int i = 0; i < 4; ++i) { const int idx = threadIdx.x + i * 256, mm = idx >> 4, kk = idx & 15, m = m0 + mm; As[kk][mm] = (m < M) ? al(m, k0 + kk) : 0.f; }
#pragma unroll
        for (int i = 0; i < 4; ++i) { const int idx = threadIdx.x + i * 256, kk = idx >> 6, nn = idx & 63; Bs[kk][nn] = B[(size_t)(k0 + kk) * N + n0 + nn]; }
        __syncthreads();
#pragma unroll
        for (int kk = 0; kk < 16; ++kk) {
            float a[4], b[4];
#pragma unroll
            for (int i = 0; i < 4; ++i) { a[i] = As[kk][ty * 4 + i]; b[i] = Bs[kk][tx * 4 + i]; }
#pragma unroll
            for (int i = 0; i < 4; ++i)
#pragma unroll
                for (int j = 0; j < 4; ++j) acc[i][j] += a[i] * b[j];
        }
        __syncthreads();
    }
#pragma unroll
    for (int i = 0; i < 4; ++i)
#pragma unroll
        for (int j = 0; j < 4; ++j) { const int m = m0 + ty * 4 + i, n = n0 + tx * 4 + j; if (m < M) ep(m, n, acc[i][j]); }
}
struct AL_CB { const bf16_t* CB; __device__ float operator()(int m, int k) const { return bf2f(CB[(size_t)m * CW + k]); } };
struct EP_PW { bf16_t* GY; const float* pw_b; __device__ void operator()(int m, int n, float v) const { bf16_t* p = GY + (size_t)m * DM + 1024 + n; *p = f2bf((v + pw_b[n]) * bf2f(*p)); } };
struct AL_GY { const bf16_t* GY; __device__ float operator()(int m, int k) const { return bf2f(GY[(size_t)m * DM + k]); } };
struct EP_OUT { float* out; const float* x; __device__ void operator()(int m, int n, float v) const { out[(size_t)m * DM + n] = v + x[(size_t)m * DM + n]; } };
__global__ void t_final(float* out, const float* g) {
    const int w = (blockIdx.x * blockDim.x + threadIdx.x) >> 6, lane = threadIdx.x & 63;
    if (w >= SEQ) return;
    float* r = out + (size_t)w * DM;
    float s = 0.f;
    for (int i = lane; i < DM; i += 64) { const float v = r[i]; s += v * v; }
    const float rs = 1.0f / sqrtf(wave_sum(s) / DM + EPS);
    for (int i = lane; i < DM; i += 64) r[i] = r[i] * rs * g[i];
}
}
#endif

extern "C" void kernel_launch(void* const* d_in, const int* in_sizes, int n_in, void* d_out, int out_size, void* d_ws, size_t ws_size, hipStream_t stream) {
    using namespace mk;
    static int ready = 0;
    if (ready == 0) {
        if (n_in != 13 || out_size != SEQ * DM || ws_size < WS_END) { fprintf(stderr, "kernel_launch: unexpected shapes (n_in %d, out %d, ws %zu)\n", n_in, out_size, ws_size); ready = -1; return; }
        int dev = 0, cus = 0;
        if (hipGetDevice(&dev) != hipSuccess || hipDeviceGetAttribute(&cus, hipDeviceAttributeMultiprocessorCount, dev) != hipSuccess) { ready = -1; return; }
        if (cus < GRID) { fprintf(stderr, "kernel_launch: %d CUs < %d\n", cus, GRID); ready = -1; return; }
        if (hipFuncSetAttribute((const void*)mega, hipFuncAttributeMaxDynamicSharedMemorySize, LDS_BYTES) != hipSuccess) { fprintf(stderr, "kernel_launch: hipFuncSetAttribute failed\n"); ready = -1; return; }
        int per_cu = 0;
        if (hipOccupancyMaxActiveBlocksPerMultiprocessor(&per_cu, (const void*)mega, NTHREADS, LDS_BYTES) != hipSuccess || per_cu < 1) fprintf(stderr, "kernel_launch: occupancy query says %d blocks/CU\n", per_cu);
        (void)hipGetLastError();
        ready = 1;
    }
    if (ready < 0) return;
    (void)hipMemsetAsync((char*)d_ws + WS_CTL, 0, CTL_ZERO_BYTES, stream);
    Args a{};
    for (int i = 0; i < 13; ++i) a.in[i] = (const float*)d_in[i];
    a.out = (float*)d_out; a.ws = (unsigned char*)d_ws;
#if LADDER == 0
#if PROBE_K > 0
    a.ph_lo = 0; a.ph_hi = PROBE_K;
    hipLaunchKernelGGL(mega, dim3(GRID), dim3(NTHREADS), LDS_BYTES, stream, a);
    (void)hipMemsetAsync((char*)d_ws + WS_CTL, 0, CTL_ZERO_BYTES, stream);
#endif
    a.ph_lo = 0; a.ph_hi = 5;
    hipLaunchKernelGGL(mega, dim3(GRID), dim3(NTHREADS), LDS_BYTES, stream, a);
#if PROBE_TAIL > 0
    (void)hipMemsetAsync((char*)d_ws + WS_CTL, 0, CTL_ZERO_BYTES, stream);
    a.ph_lo = PROBE_TAIL; a.ph_hi = 5;
    hipLaunchKernelGGL(mega, dim3(GRID), dim3(NTHREADS), LDS_BYTES, stream, a);
#endif
#else
    using namespace nt;
    unsigned char* ws = (unsigned char*)d_ws;
    bf16_t *Qt = (bf16_t*)(ws + WS_QT), *Kt = (bf16_t*)(ws + WS_KT), *V = (bf16_t*)(ws + WS_V), *U = (bf16_t*)(ws + WS_U), *GY = (bf16_t*)(ws + WS_GY), *CB = (bf16_t*)(ws + WS_CB), *ST = (bf16_t*)(ws + WS_ST);
    const float *x = a.in[0], *gn_g = a.in[4], *dw_w = a.in[5], *dw_b = a.in[6], *cln_g = a.in[7], *cln_b = a.in[8], *pw_w = a.in[9], *pw_b = a.in[10], *w_out = a.in[11], *final_g = a.in[12];
    float* out = (float*)d_out; float* yraw = (float*)d_out;
    a.ph_lo = 0; a.ph_hi = (LADDER == 1 ? 2 : LADDER == 2 ? 3 : 4);
    hipLaunchKernelGGL(mega, dim3(GRID), dim3(NTHREADS), LDS_BYTES, stream, a);
#if LADDER == 1
    t_retention<<<RH * RD, 64, 0, stream>>>(Qt, Kt, V, yraw);
    t_groupnorm<<<(SEQ * RH * 64 + 255) / 256, 256, 0, stream>>>(yraw, GY, gn_g);
    t_conv<<<SEQ, 256, 0, stream>>>(U, dw_w, dw_b, cln_g, cln_b, CB);
    t_gemm<SEQ, CW, CW><<<dim3(CW / 64, SEQ / 64), 256, 0, stream>>>(pw_w, AL_CB{CB}, EP_PW{GY, pw_b});
#elif LADDER == 2
    t_chunk<<<64 * 4, 256, 0, stream>>>(Qt, Kt, V, ST, yraw);
    t_groupnorm<<<(SEQ * RH * 64 + 255) / 256, 256, 0, stream>>>(yraw, GY, gn_g);
#endif
    t_gemm<SEQ, DM, DM><<<dim3(DM / 64, SEQ / 64), 256, 0, stream>>>(w_out, AL_GY{GY}, EP_OUT{out, x});
    t_final<<<(SEQ * 64 + 255) / 256, 256, 0, stream>>>(out, final_g);
#endif
}
```
